# Optimizing an MI355X kernel written in HIP

```python
import jax, jax.numpy as jnp
from jax import lax
import numpy as np


D_MODEL = 2048
BATCH = 1
SEQ = 16384
DEPTH = 4
DEC_BATCH = 2
DEC_SEQ = 16384
PAST_LEN = 128

HEAD_DIM = 128
A_Q_HEADS = 16
A_KV_HEADS = 4
B_GROUPS = ((128, 1), (512, 4), (2048, 16))
N_B_GROUPS = 3
B_HEADS = 8
MEM_LEN = 256
C_HEADS = 4
D_FF = 4 * D_MODEL
GRID_W = 64
ROPE_THETA = 10000.0
EPS = 1e-6
Q_BLOCK = 128
N_MIXERS = 2
N_A_LAYERS = (DEPTH + 1) // 2
N_B_LAYERS = DEPTH // 2

kernel_name = 'hybrid_axial_gqa_dilated_window_encoder'


def rms_norm(x, g):
    xf = x.astype(jnp.float32)
    y = xf * lax.rsqrt(jnp.mean(xf * xf, axis=-1, keepdims=True) + EPS)
    return (y * g.astype(jnp.float32)).astype(x.dtype)


def rotate_half(x):
    x1, x2 = jnp.split(x, 2, axis=-1)
    return jnp.concatenate([-x2, x1], axis=-1)


def rope_angles(pos, dim):
    inv = ROPE_THETA ** (-jnp.arange(0, dim, 2, dtype=jnp.float32) / dim)
    ang = pos[:, None] * inv[None, :]
    return jnp.concatenate([ang, ang], axis=-1)


def apply_rope(x, cos, sin):
    shape = (cos.shape[0],) + (1,) * (x.ndim - 3) + (cos.shape[1],)
    c = cos.reshape(shape)
    s = sin.reshape(shape)
    return (x * c + rotate_half(x) * s).astype(x.dtype)


def apply_axial(x, tabs):
    cr, sr, cc, sc = tabs
    half = HEAD_DIM // 2
    return jnp.concatenate([apply_rope(x[..., :half], cr, sr), apply_rope(x[..., half:], cc, sc)], axis=-1)


def mixer_a(h, wqkv, q_gain, k_gain, wo, tabs):
    bsz, S, _ = h.shape
    nq = A_Q_HEADS * HEAD_DIM
    nkv = A_KV_HEADS * HEAD_DIM
    qkv = h @ wqkv
    q = qkv[..., :nq].reshape(bsz, S, A_Q_HEADS, HEAD_DIM)
    k = qkv[..., nq:nq + nkv].reshape(bsz, S, A_KV_HEADS, HEAD_DIM)
    v = qkv[..., nq + nkv:].reshape(bsz, S, A_KV_HEADS, HEAD_DIM)
    q = apply_axial(rms_norm(q, q_gain), tabs)
    k = apply_axial(rms_norm(k, k_gain), tabs)
    grp = A_Q_HEADS // A_KV_HEADS
    nb = S // Q_BLOCK
    qb = jnp.moveaxis(q.reshape(bsz, nb, Q_BLOCK, A_KV_HEADS, grp, HEAD_DIM), 1, 0)
    scale = HEAD_DIM ** -0.5

    def block(qi):
        s = jnp.einsum('bqkgd,bskd->bkgqs', qi, k, preferred_element_type=jnp.float32) * scale
        p = jax.nn.softmax(s, axis=-1)
        return jnp.einsum('bkgqs,bskd->bqkgd', p.astype(v.dtype), v)

    o = lax.map(block, qb)
    o = jnp.moveaxis(o, 0, 1).reshape(bsz, S, nq)
    return o @ wo


def mixer_b(h, wqkv, wo, cos, sin):
    bsz, S, _ = h.shape
    qkv = (h @ wqkv).reshape(bsz, S, 3, N_B_GROUPS, B_HEADS, HEAD_DIM)
    q = apply_rope(qkv[:, :, 0], cos, sin)
    k = apply_rope(qkv[:, :, 1], cos, sin)
    v = qkv[:, :, 2]
    nb = S // Q_BLOCK
    qb = jnp.moveaxis(q.reshape(bsz, nb, Q_BLOCK, N_B_GROUPS, B_HEADS, HEAD_DIM), 1, 0)
    starts = jnp.arange(nb, dtype=jnp.int32) * Q_BLOCK
    scale = HEAD_DIM ** -0.5

    def block(args):
        qi, t0 = args
        tq = t0 + jnp.arange(Q_BLOCK, dtype=jnp.int32)
        outs, lses = [], []
        for g, (win, dil) in enumerate(B_GROUPS):
            side = win // (2 * dil)
            rel = dil * jnp.arange(-side, side + 1, dtype=jnp.int32)
            idx = tq[:, None] + rel[None, :]
            valid = (idx >= 0) & (idx < S)
            idxc = jnp.clip(idx, 0, S - 1)
            kg = jnp.take(k[:, :, g], idxc, axis=1)
            vg = jnp.take(v[:, :, g], idxc, axis=1)
            s = jnp.einsum('bqhd,bqjhd->bhqj', qi[:, :, g], kg, preferred_element_type=jnp.float32) * scale
            s = jnp.where(valid[None, None], s, -jnp.inf)
            m = jnp.max(s, axis=-1, keepdims=True)
            p = jnp.exp(s - m)
            l = jnp.sum(p, axis=-1, keepdims=True)
            o = jnp.einsum('bhqj,bqjhd->bhqd', p / l, vg.astype(jnp.float32))
            outs.append(o)
            lses.append((m + jnp.log(l))[..., 0])
        w = jax.nn.softmax(jnp.stack(lses, 0), axis=0)
        o = jnp.einsum('gbhq,gbhqd->bqhd', w, jnp.stack(outs, 0))
        return o.astype(h.dtype)

    o = lax.map(block, (qb, starts))
    o = jnp.moveaxis(o, 0, 1).reshape(bsz, S, B_HEADS * HEAD_DIM)
    return o @ wo


def cross_attn(h, mem_n, wq, wkv, wo):
    bsz, S, _ = h.shape
    M = mem_n.shape[1]
    q = (h @ wq).reshape(bsz, S, C_HEADS, HEAD_DIM)
    kv = (mem_n @ wkv).reshape(bsz, M, 2, C_HEADS, HEAD_DIM)
    k, v = kv[:, :, 0], kv[:, :, 1]
    s = jnp.einsum('bqhd,bmhd->bhqm', q, k, preferred_element_type=jnp.float32) * (HEAD_DIM ** -0.5)
    p = jax.nn.softmax(s, axis=-1)
    o = jnp.einsum('bhqm,bmhd->bqhd', p.astype(v.dtype), v)
    return o.reshape(bsz, S, C_HEADS * HEAD_DIM) @ wo


def sq_relu_mlp(h, w_up, w_down):
    return jnp.square(jax.nn.relu(h @ w_up)) @ w_down


def trunk(x, mem, norm_mix, a_wqkv, a_q_gain, a_k_gain, a_wo, b_wqkv, b_wo,
          norm_cross, norm_mem, c_wq, c_wkv, c_wo, norm_mlp, w_up, w_down, final_norm):
    S = x.shape[1]
    rows = S // GRID_W
    row = jnp.repeat(jnp.arange(rows, dtype=jnp.float32), GRID_W)
    col = jnp.tile(jnp.arange(GRID_W, dtype=jnp.float32), rows)
    ar = rope_angles(row, HEAD_DIM // 2)
    ac = rope_angles(col, HEAD_DIM // 2)
    tabs = (jnp.cos(ar), jnp.sin(ar), jnp.cos(ac), jnp.sin(ac))
    a1 = rope_angles(jnp.arange(S, dtype=jnp.float32), HEAD_DIM)
    cos1, sin1 = jnp.cos(a1), jnp.sin(a1)
    for i in range(DEPTH):
        hn = rms_norm(x, norm_mix[i])
        j = i // N_MIXERS
        if i % N_MIXERS == 0:
            x = x + mixer_a(hn, a_wqkv[j], a_q_gain[j], a_k_gain[j], a_wo[j], tabs)
        else:
            x = x + mixer_b(hn, b_wqkv[j], b_wo[j], cos1, sin1)
        x = x + cross_attn(rms_norm(x, norm_cross[i]), rms_norm(mem, norm_mem[i]), c_wq[i], c_wkv[i], c_wo[i])
        x = x + sq_relu_mlp(rms_norm(x, norm_mlp[i]), w_up[i], w_down[i])
    return rms_norm(x, final_norm)


def setup_inputs(seed: int = 0) -> dict:
    key = jax.random.key(seed)
    ks = jax.random.split(key, 24)
    f32 = jnp.float32
    D = D_MODEL
    HD = HEAD_DIM

    def w(k, shape, fan_in):
        return jax.random.normal(k, shape, f32) * (fan_in ** -0.5)

    def gain(k, shape):
        return 1.0 + 0.02 * jax.random.normal(k, shape, f32)

    a_cols = (A_Q_HEADS + 2 * A_KV_HEADS) * HD
    b_cols = 3 * N_B_GROUPS * B_HEADS * HD
    return {
        'x_prompt': jax.random.normal(ks[0], (BATCH, SEQ, D), f32),
        'x_sample': jax.random.normal(ks[1], (DEC_BATCH, DEC_SEQ, D), f32),
        'mem_prompt': jax.random.normal(ks[2], (BATCH, MEM_LEN, D), f32),
        'mem_sample': jax.random.normal(ks[3], (DEC_BATCH, MEM_LEN, D), f32),
        'norm_mix': gain(ks[4], (DEPTH, D)),
        'a_wqkv': w(ks[5], (N_A_LAYERS, D, a_cols), D),
        'a_q_gain': gain(ks[6], (N_A_LAYERS, HD)),
        'a_k_gain': gain(ks[7], (N_A_LAYERS, HD)),
        'a_wo': w(ks[8], (N_A_LAYERS, A_Q_HEADS * HD, D), A_Q_HEADS * HD),
        'b_wqkv': w(ks[9], (N_B_LAYERS, D, b_cols), D),
        'b_wo': w(ks[10], (N_B_LAYERS, B_HEADS * HD, D), B_HEADS * HD),
        'norm_cross': gain(ks[11], (DEPTH, D)),
        'norm_mem': gain(ks[12], (DEPTH, D)),
        'c_wq': w(ks[13], (DEPTH, D, C_HEADS * HD), D),
        'c_wkv': w(ks[14], (DEPTH, D, 2 * C_HEADS * HD), D),
        'c_wo': w(ks[15], (DEPTH, C_HEADS * HD, D), C_HEADS * HD),
        'norm_mlp': gain(ks[16], (DEPTH, D)),
        'w_up': w(ks[17], (DEPTH, D, D_FF), D),
        'w_down': w(ks[18], (DEPTH, D_FF, D), D_FF),
        'final_norm': gain(ks[19], (D,)),
    }


def reference(x_prompt, x_sample, mem_prompt, mem_sample, norm_mix, a_wqkv, a_q_gain, a_k_gain, a_wo,
              b_wqkv, b_wo, norm_cross, norm_mem, c_wq, c_wkv, c_wo, norm_mlp, w_up, w_down, final_norm):
    y_prompt = trunk(x_prompt, mem_prompt, norm_mix, a_wqkv, a_q_gain, a_k_gain, a_wo, b_wqkv, b_wo,
                     norm_cross, norm_mem, c_wq, c_wkv, c_wo, norm_mlp, w_up, w_down, final_norm)
    y_sample = trunk(x_sample, mem_sample, norm_mix, a_wqkv, a_q_gain, a_k_gain, a_wo, b_wqkv, b_wo,
                     norm_cross, norm_mem, c_wq, c_wkv, c_wo, norm_mlp, w_up, w_down, final_norm)
    return (y_prompt, y_sample)
```

```cpp
#include <hip/hip_runtime.h>
#include <cstdio>
#include <cstdint>
namespace pg8 {
#define PG8_LAS __attribute__((address_space(3)))
typedef unsigned short bf16_t;
typedef short bf16x8 __attribute__((ext_vector_type(8)));
typedef float f32x4 __attribute__((ext_vector_type(4)));
typedef unsigned u32x4 __attribute__((ext_vector_type(4)));
constexpr int BM = 256, BK = 64, HALF = 128, HTB = HALF * BK * 2  , STAGE_BYTES = 8 * HTB, NXCD = 8, WGM = 8;

__host__ __device__ __forceinline__ int lds_byte(int r, int c) { const int st = (r >> 4) * 2 + (c >> 5), rr = r & 15, cc = c & 31, ob = rr * 64 + cc * 2; return st * 1024 + (ob ^ (((ob >> 9) & 1) << 5)); }
__host__ __device__ __forceinline__ void stage_rc(int b, int& R, int& C) { const int st = b / 1024, sb = b % 1024, swz = sb ^ (((sb >> 9) & 1) << 5); R = (st >> 1) * 16 + swz / 64; C = (st & 1) * 32 + (swz % 64) / 2; }
__host__ __device__ __forceinline__ int perm32(int rho) { const int n = rho >> 4, i = rho & 15; return 8 * (i >> 2) + 4 * n + (i & 3); }

struct Unit { int pm, pn; };
struct Gemm { const bf16_t* A; const bf16_t* Bt; int M, N, K; };

struct StaticOrder {
    int nM, nN, nwg, G, c;
    __host__ __device__ void init(int M, int N, int G_, int c_) { nM = M / BM; nN = N / BM; nwg = nM * nN; G = G_; c = c_; }
    __host__ __device__ bool next(int i, Unit& u) const {
        const long L = (long)i * G + c; if (L >= nwg) return false;
        int wgid = (int)L; { const int q = nwg / NXCD, r = nwg % NXCD, xcd = wgid % NXCD, off = wgid / NXCD; wgid = (xcd < r ? xcd * (q + 1) : r * (q + 1) + (xcd - r) * q) + off; }
        const int nig = WGM * nN, gid = wgid / nig, fm = gid * WGM, gsz = (nM - fm) < WGM ? (nM - fm) : WGM;
        u.pm = fm + ((wgid % nig) % gsz); u.pn = (wgid % nig) / gsz; return true;
    }
    __device__ __forceinline__ void a_ready(const Unit&) const {}
    __device__ __forceinline__ void done(const Unit&) const {}
};

__device__ __forceinline__ unsigned cvt_pk_bf16(float lo, float hi) { unsigned r; asm volatile("v_cvt_pk_bf16_f32 %0, %1, %2" : "=v"(r) : "v"(lo), "v"(hi)); return r; }
typedef float f32x2 __attribute__((ext_vector_type(2)));
__device__ __forceinline__ f32x2 gelu_pk(f32x2 v) {
    const f32x2 av = __builtin_elementwise_abs(v), d = av * 0.2316418882f + 1.0f;
    f32x2 t; t.x = __builtin_amdgcn_rcpf(d.x); t.y = __builtin_amdgcn_rcpf(d.y);
    f32x2 q = t * 0.5307027145f + (-0.7265760135f); q = q * t + 0.7107068705f; q = q * t + (-0.142248368f); q = q * t + 0.127414796f; q = q * t;
    const f32x2 s = (v * v) * (-0.72134752044f);
    f32x2 e; e.x = __builtin_amdgcn_exp2f(s.x); e.y = __builtin_amdgcn_exp2f(s.y);
    const f32x2 m = v * (q * e), r = v - m;
    f32x2 o; o.x = v.x < 0.f ? m.x : r.x; o.y = v.y < 0.f ? m.y : r.y; return o;
}

template <int ACT  > struct EpiBf16 {
    static constexpr bool PERM = true, AFTER_DRAIN = false; static_assert(ACT == 0 || ACT == 1, "EpiBf16: ACT is 0 (none) or 1 (gelu_pk)");
    bf16_t* O; int ldc; const float* bias; int split_cols; size_t split_stride; float scale0;
    __device__ __forceinline__ void operator()(const f32x4 (&acc)[2][2][4][2], const Unit& u, int wr, int wc, int fr, int fq) const {
        const int row0 = u.pm * BM + wr * 64 + fr; int colt = u.pn * BM; bf16_t* base = O;
        float sc = 1.f; if (split_cols) { const int t = colt / split_cols; base += (size_t)t * split_stride; colt -= t * split_cols; if (t == 0) sc = scale0; }
        const int col0 = colt + wc * 32 + 8 * fq, bcol0 = u.pn * BM + wc * 32 + 8 * fq;
        f32x4 bv[2][2];
#pragma unroll
        for (int bj = 0; bj < 2; ++bj)
#pragma unroll
            for (int n = 0; n < 2; ++n) bv[bj][n] = bias ? *(const f32x4*)(bias + bcol0 + bj * HALF + 4 * n) : (f32x4){0.f, 0.f, 0.f, 0.f};
#pragma unroll
        for (int ai = 0; ai < 2; ++ai)
#pragma unroll
            for (int m = 0; m < 4; ++m) { bf16_t* rowp = base + (size_t)(row0 + ai * HALF + m * 16) * ldc + col0;
#pragma unroll
                for (int bj = 0; bj < 2; ++bj) { f32x4 v0 = acc[ai][bj][m][0] + bv[bj][0], v1 = acc[ai][bj][m][1] + bv[bj][1];
                    if (ACT == 1) { f32x2 a = gelu_pk((f32x2){v0[0], v0[1]}), b = gelu_pk((f32x2){v0[2], v0[3]}), c = gelu_pk((f32x2){v1[0], v1[1]}), d = gelu_pk((f32x2){v1[2], v1[3]});
                        v0 = (f32x4){a.x, a.y, b.x, b.y}; v1 = (f32x4){c.x, c.y, d.x, d.y}; }
                    v0 = v0 * sc; v1 = v1 * sc; u32x4 w; w.x = cvt_pk_bf16(v0[0], v0[1]); w.y = cvt_pk_bf16(v0[2], v0[3]); w.z = cvt_pk_bf16(v1[0], v1[1]); w.w = cvt_pk_bf16(v1[2], v1[3]);
                    *(u32x4*)(rowp + bj * HALF) = w; } }
    }
};

template <int MODE> struct EpiB {
    static constexpr bool PERM = true, AFTER_DRAIN = false;
    bf16_t* O; int ldc; int pn_mod; bf16_t* O2; bf16_t* O3;
    __device__ __forceinline__ void operator()(const f32x4 (&acc)[2][2][4][2], const Unit& u, int wr, int wc, int fr, int fq) const {
        const int row0 = u.pm * BM + wr * 64 + fr;
        bf16_t* base = O; int ld = ldc, colt = 0, shift = 0;
        if constexpr (MODE == 0 || MODE == 3) { colt = (u.pn % pn_mod) * BM; }
        if constexpr (MODE == 1) {
            if (u.pn < 8) { base = O; ld = 2048; colt = u.pn * BM; }
            else if (u.pn < 10) { base = O2; ld = 512; colt = (u.pn - 8) * BM; }
            else { base = O3; ld = 512; colt = (u.pn - 10) * BM; }
        }
        if constexpr (MODE == 2) {
            const int which = u.pn / 12, g = (u.pn % 12) / 4; colt = (u.pn % 4) * BM; ld = 1024; shift = 2 * g;
            base = O + (size_t)(which * 3 + g) * ((size_t)16384 * 1024);
        }
        const int col0 = colt + wc * 32 + 8 * fq;
#pragma unroll
        for (int ai = 0; ai < 2; ++ai)
#pragma unroll
            for (int m = 0; m < 4; ++m) {
                int r = row0 + ai * HALF + m * 16;
                if constexpr (MODE == 2) r = ((r & ((1 << shift) - 1)) << (14 - shift)) + (r >> shift);
                bf16_t* rowp = base + (size_t)r * ld + col0;
#pragma unroll
                for (int bj = 0; bj < 2; ++bj) { f32x4 v0 = acc[ai][bj][m][0], v1 = acc[ai][bj][m][1];
                    if constexpr (MODE == 3) {
#pragma unroll
                        for (int e = 0; e < 4; ++e) { const float a = fmaxf(v0[e], 0.f), b = fmaxf(v1[e], 0.f); v0[e] = a * a; v1[e] = b * b; }
                    }
                    u32x4 w; w.x = cvt_pk_bf16(v0[0], v0[1]); w.y = cvt_pk_bf16(v0[2], v0[3]); w.z = cvt_pk_bf16(v1[0], v1[1]); w.w = cvt_pk_bf16(v1[2], v1[3]);
                    *(u32x4*)(rowp + bj * HALF) = w; }
            }
    }
};
struct EpiRes {
    static constexpr bool PERM = false, AFTER_DRAIN = false;
    float* X; int ldc; int row_off;
    __device__ __forceinline__ void operator()(const f32x4 (&acc)[2][2][4][2], const Unit& u, int wr, int wc, int fr, int fq) const {
        const int row0 = row_off + u.pm * BM + wr * 64 + fr, col0 = u.pn * BM + wc * 32 + 4 * fq;
#pragma unroll
        for (int ai = 0; ai < 2; ++ai)
#pragma unroll
            for (int m = 0; m < 4; ++m) { float* rowp = X + (size_t)(row0 + ai * HALF + m * 16) * ldc + col0;
                f32x4 xv[2][2];
#pragma unroll
                for (int bj = 0; bj < 2; ++bj)
#pragma unroll
                    for (int n = 0; n < 2; ++n) xv[bj][n] = *(const f32x4*)(rowp + bj * HALF + n * 16);
#pragma unroll
                for (int bj = 0; bj < 2; ++bj)
#pragma unroll
                    for (int n = 0; n < 2; ++n) *(f32x4*)(rowp + bj * HALF + n * 16) = xv[bj][n] + acc[ai][bj][m][n]; }
    }
};
struct GroupedOrder {
    int G, c;
    __host__ __device__ void init(int G_, int c_) { G = G_; c = c_; }
    __host__ __device__ bool next(int i, Unit& u) const {
        const int L = i * G + c; if (L >= 48) return false;
        const int layer = L / 12, rem = L % 12; u.pm = layer * 3 + rem % 3; u.pn = layer * 4 + rem / 3; return true;
    }
    __device__ __forceinline__ void a_ready(const Unit&) const {}
    __device__ __forceinline__ void done(const Unit&) const {}
};
template <class Epi, class Sched, bool ALIGN_EPI = false, bool SP2 = false>
__device__ __forceinline__ void gemm_phase(PG8_LAS unsigned char* lds, const Gemm g, const Sched& S, const Epi& E, const int tid) {
    const int wid = __builtin_amdgcn_readfirstlane(tid >> 6), lane = tid & 63, wr = wid >> 2, wc = wid & 3, fr = lane & 15, fq = lane >> 4;
    const int K = g.K, nt = K / BK;
    unsigned voffA[2], voffB[2];
#pragma unroll
    for (int i = 0; i < 2; ++i) { int R, C; stage_rc(tid * 16 + i * 8192, R, C); const int Rb = Epi::PERM ? ((R & ~31) + perm32(R & 31)) : R;
        voffA[i] = (unsigned)(R * K + C) * 2u; voffB[i] = (unsigned)(Rb * K + C) * 2u; }
    const size_t kstep = (size_t)(BK * 2);
    const size_t hstep = (size_t)HALF * K * 2;
    const size_t tstep = 2 * hstep;
    const unsigned ldsw = (unsigned)wid * 1024u;
    const int aoff = lds_byte(wr * 64 + fr, fq * 8), boff = lds_byte(wc * 32 + fr, fq * 8);
#define PG8_SA(b, h) (((b) * 2 + (h)) * HTB)
#define PG8_SB(b, h) ((4 + (b) * 2 + (h)) * HTB)
#define PG8_STAGE(bufoff, gbase, voff) do { _Pragma("unroll") for (int _i = 0; _i < 2; ++_i) \
        __builtin_amdgcn_global_load_lds((const unsigned*)((const char*)(gbase) + (voff)[_i]), (PG8_LAS unsigned*)(lds + (bufoff) + ldsw + _i * 8192), 16, 0, 0); } while (0)
#define PG8_LDA(dst, b, h) do { _Pragma("unroll") for (int m = 0; m < 4; ++m) _Pragma("unroll") for (int k = 0; k < 2; ++k) dst[m][k] = *(const PG8_LAS bf16x8*)(lds + PG8_SA(b, h) + aoff + m * 2048 + k * 1024); } while (0)
#define PG8_LDB(dst, b, h) do { _Pragma("unroll") for (int n = 0; n < 2; ++n) _Pragma("unroll") for (int k = 0; k < 2; ++k) dst[n][k] = *(const PG8_LAS bf16x8*)(lds + PG8_SB(b, h) + boff + n * 2048 + k * 1024); } while (0)
#define PG8_MMA(ai, bj, At, Bt) do { __builtin_amdgcn_s_setprio(1); _Pragma("unroll") for (int m = 0; m < 4; ++m) _Pragma("unroll") for (int n = 0; n < 2; ++n) _Pragma("unroll") for (int k = 0; k < 2; ++k) \
        acc[ai][bj][m][n] = __builtin_amdgcn_mfma_f32_16x16x32_bf16(Bt[n][k], At[m][k], acc[ai][bj][m][n], 0, 0, 0); __builtin_amdgcn_s_setprio(0); } while (0)
#define PG8_WAIT_V(n) asm volatile("s_waitcnt vmcnt(" #n ")" ::: "memory")
#define PG8_WAIT_L(n) asm volatile("s_waitcnt lgkmcnt(" #n ")" ::: "memory")
#define PG8_BAR __builtin_amdgcn_s_barrier()
#define PG8_SCHED __builtin_amdgcn_sched_barrier(0)
    Unit cur, nxt; int ui = 0;
    if (!S.next(0, cur)) return;
    f32x4 acc[2][2][4][2];
#pragma unroll
    for (int a = 0; a < 2; ++a)
#pragma unroll
        for (int b = 0; b < 2; ++b)
#pragma unroll
            for (int m = 0; m < 4; ++m)
#pragma unroll
                for (int n = 0; n < 2; ++n) acc[a][b][m][n] = (f32x4){0.f, 0.f, 0.f, 0.f};
    bf16x8 At[4][2], B0[2][2], B1[2][2];
    const char* cA = (const char*)g.A + (size_t)cur.pm * tstep; const char* cB = (const char*)g.Bt + (size_t)cur.pn * tstep;
    S.a_ready(cur);
    if constexpr (SP2) {
        PG8_STAGE(PG8_SB(0, 0), cB, voffB); PG8_STAGE(PG8_SB(0, 1), cB + hstep, voffB); PG8_STAGE(PG8_SA(0, 0), cA, voffA); PG8_STAGE(PG8_SA(0, 1), cA + hstep, voffA);
        if (wr == 1) PG8_BAR;
        PG8_WAIT_V(2); PG8_BAR;
        PG8_STAGE(PG8_SB(1, 0), cB + kstep, voffB); PG8_STAGE(PG8_SA(1, 0), cA + kstep, voffA); PG8_STAGE(PG8_SB(1, 1), cB + hstep + kstep, voffB);
        PG8_WAIT_V(6); PG8_BAR;
    } else {
        PG8_STAGE(PG8_SB(0, 0), cB, voffB); PG8_STAGE(PG8_SA(0, 0), cA, voffA); PG8_STAGE(PG8_SB(0, 1), cB + hstep, voffB); PG8_STAGE(PG8_SA(0, 1), cA + hstep, voffA);
        if (wr == 1) PG8_BAR;
        PG8_WAIT_V(4); PG8_BAR;
        PG8_STAGE(PG8_SB(1, 0), cB + kstep, voffB); PG8_STAGE(PG8_SA(1, 0), cA + kstep, voffA); PG8_STAGE(PG8_SB(1, 1), cB + hstep + kstep, voffB);
        PG8_WAIT_V(6); PG8_BAR;
    }
    for (;;) {
        const bool has_next = S.next(ui + 1, nxt);
        const char* nA = has_next ? (const char*)g.A + (size_t)nxt.pm * tstep : cA; const char* nB = has_next ? (const char*)g.Bt + (size_t)nxt.pn * tstep : cB;
        for (int t = 0; t < nt; t += 2) {
            const bool last = (t == nt - 2);
            const char* a1 = cA + (size_t)(t + 1) * kstep;
            const char* a2 = last ? nA : cA + (size_t)(t + 2) * kstep; const char* b2 = last ? nB : cB + (size_t)(t + 2) * kstep;
            const char* a3 = a2 + kstep; const char* b3 = b2 + kstep;
            if (last && has_next) S.a_ready(nxt);
            if constexpr (SP2) {
            PG8_LDB(B0, 0, 0); PG8_LDB(B1, 0, 1); PG8_SCHED; PG8_LDA(At, 0, 0); PG8_STAGE(PG8_SA(1, 1), a1 + hstep, voffA);
            PG8_WAIT_V(8); PG8_WAIT_L(0); PG8_BAR; PG8_MMA(0, 0, At, B0); PG8_MMA(0, 1, At, B1); PG8_BAR; PG8_SCHED;
            PG8_LDA(At, 0, 1); PG8_STAGE(PG8_SB(0, 0), b2, voffB); PG8_STAGE(PG8_SB(0, 1), b2 + hstep, voffB); PG8_STAGE(PG8_SA(0, 0), a2, voffA);
            PG8_WAIT_V(8); PG8_WAIT_L(0); PG8_BAR; PG8_MMA(1, 0, At, B0); PG8_MMA(1, 1, At, B1); PG8_BAR; PG8_SCHED;
            PG8_LDB(B0, 1, 0); PG8_LDB(B1, 1, 1); PG8_SCHED; PG8_LDA(At, 1, 0); PG8_STAGE(PG8_SA(0, 1), a2 + hstep, voffA);
            PG8_WAIT_V(8); PG8_WAIT_L(0); PG8_BAR; PG8_MMA(0, 0, At, B0); PG8_MMA(0, 1, At, B1); PG8_BAR; PG8_SCHED;
            PG8_LDA(At, 1, 1); PG8_STAGE(PG8_SB(1, 0), b3, voffB); PG8_STAGE(PG8_SB(1, 1), b3 + hstep, voffB); PG8_STAGE(PG8_SA(1, 0), a3, voffA);
            PG8_WAIT_V(8); PG8_WAIT_L(0); PG8_BAR; PG8_MMA(1, 0, At, B0); PG8_MMA(1, 1, At, B1); PG8_BAR; PG8_SCHED;
            } else {
            PG8_LDB(B0, 0, 0); PG8_SCHED; PG8_LDA(At, 0, 0); PG8_STAGE(PG8_SA(1, 1), a1 + hstep, voffA);
            PG8_WAIT_L(8); PG8_BAR; PG8_WAIT_L(0); PG8_MMA(0, 0, At, B0); PG8_BAR; PG8_SCHED;
            PG8_LDB(B1, 0, 1); PG8_STAGE(PG8_SB(0, 0), b2, voffB);
            PG8_BAR; PG8_WAIT_L(0); PG8_MMA(0, 1, At, B1); PG8_BAR;
            PG8_LDA(At, 0, 1); PG8_STAGE(PG8_SA(0, 0), a2, voffA);
            PG8_BAR; PG8_WAIT_L(0); PG8_MMA(1, 0, At, B0); PG8_BAR; PG8_SCHED;
            PG8_STAGE(PG8_SB(0, 1), b2 + hstep, voffB);
            PG8_WAIT_V(6); PG8_BAR; PG8_MMA(1, 1, At, B1); PG8_BAR;
            PG8_LDB(B0, 1, 0); PG8_SCHED; PG8_LDA(At, 1, 0); PG8_STAGE(PG8_SA(0, 1), a2 + hstep, voffA);
            PG8_WAIT_L(8); PG8_BAR; PG8_WAIT_L(0); PG8_MMA(0, 0, At, B0); PG8_BAR; PG8_SCHED;
            PG8_LDB(B1, 1, 1); PG8_STAGE(PG8_SB(1, 0), b3, voffB);
            PG8_BAR; PG8_WAIT_L(0); PG8_MMA(0, 1, At, B1); PG8_BAR;
            PG8_LDA(At, 1, 1); PG8_STAGE(PG8_SA(1, 0), a3, voffA);
            PG8_BAR; PG8_WAIT_L(0); PG8_MMA(1, 0, At, B0); PG8_BAR; PG8_SCHED;
            PG8_STAGE(PG8_SB(1, 1), b3 + hstep, voffB);
            PG8_WAIT_V(6); PG8_BAR; PG8_MMA(1, 1, At, B1); PG8_BAR;
            }
        }
        if constexpr (ALIGN_EPI) { if (wr == 0) PG8_BAR; }
        if constexpr (!Epi::AFTER_DRAIN) { E(acc, cur, wr, wc, fr, fq); S.done(cur); }
        if (!has_next) break;
#pragma unroll
        for (int a = 0; a < 2; ++a)
#pragma unroll
            for (int b = 0; b < 2; ++b)
#pragma unroll
                for (int m = 0; m < 4; ++m)
#pragma unroll
                    for (int n = 0; n < 2; ++n) acc[a][b][m][n] = (f32x4){0.f, 0.f, 0.f, 0.f};
        cur = nxt; cA = nA; cB = nB; ++ui;
        if constexpr (ALIGN_EPI) { if (wr == 1) PG8_BAR; }
    }
    PG8_WAIT_V(0);
    if constexpr (!ALIGN_EPI) { if (wr == 0) PG8_BAR; }
    PG8_BAR;
    if constexpr (Epi::AFTER_DRAIN) { E.fused(acc, cur, wr, wc, fr, fq, lds, wid, lane); S.done(cur); }
#undef PG8_SA
#undef PG8_SB
#undef PG8_STAGE
#undef PG8_LDA
#undef PG8_LDB
#undef PG8_MMA
#undef PG8_WAIT_V
#undef PG8_WAIT_L
#undef PG8_BAR
#undef PG8_SCHED
}
}

namespace da {
using bf16 = unsigned short;
constexpr int   D = 128, NW = 8, QBLK = 32, KVBLK = 64;
constexpr float SCALE = 0.088388347648318440f;
constexpr float THR = 8.f;
constexpr size_t SHM_V = KVBLK * D * 2, SHM_K = KVBLK * D * 2, SHM_ATTN = 2 * SHM_V + 2 * SHM_K + NW * 64 * 4;
using bf16x8 = __attribute__((ext_vector_type(8))) short;
using s16x4  = __attribute__((ext_vector_type(4))) short;
using f32x16 = __attribute__((ext_vector_type(16))) float;
using u32x4  = __attribute__((ext_vector_type(4))) unsigned;
#define KSWZ(row, colB) ((row) * 256 + ((colB) ^ (((row) & 7) << 4)))
#define SBAR() __builtin_amdgcn_sched_barrier(0)
__device__ __forceinline__ int crow(int r, int hi) { return (r & 3) + 8 * (r >> 2) + 4 * hi; }
__device__ __forceinline__ unsigned cvtpk(float lo, float hi) {
  unsigned r; asm volatile("v_cvt_pk_bf16_f32 %0, %1, %2" : "=v"(r) : "v"(lo), "v"(hi)); return r;
}
__device__ __forceinline__ bf16x8 ld8(const bf16* p) { return *reinterpret_cast<const bf16x8*>(p); }

__device__ __forceinline__ void partialSM(f32x16& p0, f32x16& p1, float& m_reg, float& mn, float& alpha) {
  constexpr float C = SCALE * 1.4426950408889634f;
  float pmax = p0[0]; for (int r = 1; r < 16; ++r) pmax = fmaxf(pmax, p0[r]); for (int r = 0; r < 16; ++r) pmax = fmaxf(pmax, p1[r]);
  { auto rr = __builtin_amdgcn_permlane32_swap(__float_as_uint(pmax), __float_as_uint(pmax), false, false);
    pmax = fmaxf(__uint_as_float(rr[0]), __uint_as_float(rr[1])); }
  if (__builtin_expect(__all(pmax - m_reg <= THR / SCALE), 1)) { mn = m_reg; alpha = 1.f; }
  else { mn = fmaxf(m_reg, pmax); alpha = __builtin_amdgcn_exp2f((m_reg - mn) * C); m_reg = mn; }
  float mnC = -mn * C;
  for (int r = 0; r < 16; ++r) p0[r] = fmaf(p0[r], C, mnC); for (int r = 0; r < 16; ++r) p1[r] = fmaf(p1[r], C, mnC);
  for (int r = 0; r < 16; ++r) p0[r] = __builtin_amdgcn_exp2f(p0[r]);
}
#define PK4(P, BASE, OUT) do { unsigned a0 = cvtpk(P[BASE + 0], P[BASE + 1]), a1 = cvtpk(P[BASE + 2], P[BASE + 3]);   \
    unsigned b0 = cvtpk(P[BASE + 4], P[BASE + 5]), b1 = cvtpk(P[BASE + 6], P[BASE + 7]);                              \
    auto r0 = __builtin_amdgcn_permlane32_swap(a0, b0, false, false); auto r1 = __builtin_amdgcn_permlane32_swap(a1, b1, false, false); \
    u32x4 w = {r0[0], r1[0], r0[1], r1[1]}; OUT = *reinterpret_cast<bf16x8*>(&w); } while (0)
__device__ __forceinline__ void finishSM(f32x16& p0, f32x16& p1, float alpha, float& l_reg, bf16x8& pa0, bf16x8& pa1, bf16x8& pa2, bf16x8& pa3) {
  for (int r = 0; r < 16; ++r) p1[r] = __builtin_amdgcn_exp2f(p1[r]);
  float ps = 0; for (int r = 0; r < 16; ++r) ps += p0[r]; for (int r = 0; r < 16; ++r) ps += p1[r];
  { auto rr = __builtin_amdgcn_permlane32_swap(__float_as_uint(ps), __float_as_uint(ps), false, false);
    ps = __uint_as_float(rr[0]) + __uint_as_float(rr[1]); }
  l_reg = l_reg * alpha + ps;
  PK4(p0, 0, pa0); PK4(p0, 8, pa1); PK4(p1, 0, pa2); PK4(p1, 8, pa3);
}
__device__ __forceinline__ void qkt(f32x16& p0, f32x16& p1, const bf16* Ks, const bf16x8* qr, int r32, int hi) {
  p0 = f32x16{}; p1 = f32x16{};
  for (int d0 = 0; d0 < 8; ++d0) { int cb = (d0 * 16 + hi * 8) * 2;
    bf16x8 b0 = *reinterpret_cast<const bf16x8*>((const char*)Ks + KSWZ(r32, cb));
    bf16x8 b1 = *reinterpret_cast<const bf16x8*>((const char*)Ks + KSWZ(32 + r32, cb));
    p0 = __builtin_amdgcn_mfma_f32_32x32x16_bf16(b0, qr[d0], p0, 0, 0, 0);
    p1 = __builtin_amdgcn_mfma_f32_32x32x16_bf16(b1, qr[d0], p1, 0, 0, 0); }
}
__device__ __forceinline__ int v_st(int k, int c) { const int kk = (k & ~0xC) | ((k & 4) << 1) | ((k & 8) >> 1); return ((kk >> 3) * 4 + (c >> 5)) * 512 + ((kk & 7) * 32 + (c & 31)) * 2; }
__device__ __forceinline__ int v_rd_base(int lane) { return ((lane & 3) << 3) | (((lane >> 2) & 3) << 6) | (((lane >> 4) & 1) << 5) | (((lane >> 5) & 1) << 8); }
constexpr int v_rd_off(int d0, int ks, int half) { return d0 * 512 + ks * 4096 + half * 2048; }
template <int OFF> __device__ __forceinline__ s16x4 tr_read(int vb) {
  s16x4 r; asm volatile("ds_read_b64_tr_b16 %0, %1 offset:%2" : "=&v"(r) : "v"(vb), "i"(OFF) : "memory"); return r;
}
template <int D0> __device__ __forceinline__ void pv_one(f32x16& od, int vb, bf16x8 pa0, bf16x8 pa1, bf16x8 pa2, bf16x8 pa3) {
  const s16x4 l0 = tr_read<v_rd_off(D0, 0, 0)>(vb), h0 = tr_read<v_rd_off(D0, 0, 1)>(vb), l1 = tr_read<v_rd_off(D0, 1, 0)>(vb), h1 = tr_read<v_rd_off(D0, 1, 1)>(vb);
  const s16x4 l2 = tr_read<v_rd_off(D0, 2, 0)>(vb), h2 = tr_read<v_rd_off(D0, 2, 1)>(vb), l3 = tr_read<v_rd_off(D0, 3, 0)>(vb), h3 = tr_read<v_rd_off(D0, 3, 1)>(vb);
  asm volatile("s_waitcnt lgkmcnt(0)" ::: "memory"); SBAR();
#define PK(L, H) (bf16x8){L[0], L[1], L[2], L[3], H[0], H[1], H[2], H[3]}
  od = __builtin_amdgcn_mfma_f32_32x32x16_bf16(pa0, PK(l0, h0), od, 0, 0, 0);
  od = __builtin_amdgcn_mfma_f32_32x32x16_bf16(pa1, PK(l1, h1), od, 0, 0, 0);
  od = __builtin_amdgcn_mfma_f32_32x32x16_bf16(pa2, PK(l2, h2), od, 0, 0, 0);
  od = __builtin_amdgcn_mfma_f32_32x32x16_bf16(pa3, PK(l3, h3), od, 0, 0, 0);
#undef PK
}
__device__ __forceinline__ void pv_d0(f32x16* o, int vb, bf16x8 pa0, bf16x8 pa1, bf16x8 pa2, bf16x8 pa3) {
  pv_one<0>(o[0], vb, pa0, pa1, pa2, pa3); pv_one<1>(o[1], vb, pa0, pa1, pa2, pa3); pv_one<2>(o[2], vb, pa0, pa1, pa2, pa3); pv_one<3>(o[3], vb, pa0, pa1, pa2, pa3);
}

template <int LDQ, int LDK, int LDO>
__device__ __forceinline__ void attn_dense_body(const bf16* Qb, const bf16* __restrict__ Kh, const bf16* __restrict__ Vh, bf16* Ob, int seq, char* lds, const int wave_s) {
  int lane; asm volatile("v_mbcnt_lo_u32_b32 %0, -1, 0\n\tv_mbcnt_hi_u32_b32 %0, -1, %0" : "=v"(lane));
  const int wid = wave_s, tid = wave_s * 64 + lane, r32 = lane & 31, hi = lane >> 5;
  bf16* V_lds = (bf16*)lds; bf16* K_lds = (bf16*)(lds + 2 * SHM_V);
  float* ws = (float*)(lds + 2 * SHM_V + 2 * SHM_K) + wid * 64; float* li_l = ws; float* al_l = ws + 32;
  float m_reg = -1e30f, l_reg = 0; f32x16 o[4] = {}; bf16x8 qr[8];
  const bf16* Qw = Qb + (long)(wid * QBLK + r32) * LDQ + hi * 8;
#pragma unroll
  for (int d0 = 0; d0 < 8; ++d0) qr[d0] = ld8(Qw + d0 * 16);
  const int sr = tid >> 4, sc = (tid & 15) * 8, vst0 = v_st(sr, sc), vst1 = v_st(32 + sr, sc);
  const int vb0 = (int)(uintptr_t)V_lds + v_rd_base(lane);
  struct { bf16x8 vs0, vs1, ks0, ks1; } sr_[2];
#define SLOAD(i, k0) do { sr_[i].vs0 = ld8(&Vh[(long)((k0) + sr) * LDK + sc]); sr_[i].vs1 = ld8(&Vh[(long)((k0) + 32 + sr) * LDK + sc]); \
    sr_[i].ks0 = ld8(&Kh[(long)((k0) + sr) * LDK + sc]); sr_[i].ks1 = ld8(&Kh[(long)((k0) + 32 + sr) * LDK + sc]); } while (0)
#define SWRITE(b, i) do { *(bf16x8*)((char*)V_lds + (b) * SHM_V + vst0) = sr_[i].vs0;          \
    *(bf16x8*)((char*)V_lds + (b) * SHM_V + vst1) = sr_[i].vs1; int kc = sc * 2;               \
    *(bf16x8*)((char*)K_lds + (b) * SHM_K + KSWZ(sr, kc)) = sr_[i].ks0;                       \
    *(bf16x8*)((char*)K_lds + (b) * SHM_K + KSWZ(32 + sr, kc)) = sr_[i].ks1; } while (0)
#define SWAIT() asm volatile("s_waitcnt vmcnt(4)" ::: "memory")
#define RESC(a) do { if (__any((a) < 1.f)) { if (hi == 0) al_l[r32] = (a); asm volatile("s_waitcnt lgkmcnt(0)" ::: "memory"); \
    for (int d = 0; d < 4; ++d) for (int r = 0; r < 16; ++r) o[d][r] *= al_l[crow(r, hi)]; } } while (0)
  f32x16 pA0, pA1, pB0, pB1; float mnA, mnB, alA, alB; bf16x8 pa0, pa1, pa2, pa3; const int NT = seq / KVBLK;
  constexpr int SE = 0, SO = 1;
  SLOAD(SE, 0); asm volatile("s_waitcnt vmcnt(0)" ::: "memory"); SWRITE(0, SE); __syncthreads();
  qkt(pA0, pA1, K_lds, qr, r32, hi); partialSM(pA0, pA1, m_reg, mnA, alA);
  SLOAD(SO, KVBLK); if (2 < NT) SLOAD(SE, 2 * KVBLK);
  SWAIT(); SWRITE(1, SO); __syncthreads();
  for (int j = 1; j + 1 < NT; j += 2) {
    SBAR(); qkt(pB0, pB1, (bf16*)((char*)K_lds + SHM_K), qr, r32, hi);
    finishSM(pA0, pA1, alA, l_reg, pa0, pa1, pa2, pa3); SBAR();
    SLOAD(SO, (j + 2) * KVBLK); SBAR();
    pv_d0(o, vb0, pa0, pa1, pa2, pa3); partialSM(pB0, pB1, m_reg, mnB, alB);
    __syncthreads(); SWAIT(); SWRITE(0, SE);
    RESC(alB); __syncthreads();
    SBAR(); qkt(pA0, pA1, K_lds, qr, r32, hi);
    finishSM(pB0, pB1, alB, l_reg, pa0, pa1, pa2, pa3); SBAR();
    if (j + 3 < NT) SLOAD(SE, (j + 3) * KVBLK); SBAR();
    pv_d0(o, vb0 + (int)SHM_V, pa0, pa1, pa2, pa3); partialSM(pA0, pA1, m_reg, mnA, alA);
    __syncthreads(); SWAIT(); SWRITE(1, SO);
    RESC(alA); __syncthreads();
  }
  SBAR(); qkt(pB0, pB1, (bf16*)((char*)K_lds + SHM_K), qr, r32, hi);
  finishSM(pA0, pA1, alA, l_reg, pa0, pa1, pa2, pa3); SBAR();
  pv_d0(o, vb0, pa0, pa1, pa2, pa3); partialSM(pB0, pB1, m_reg, mnB, alB);
  __syncthreads(); RESC(alB);
  finishSM(pB0, pB1, alB, l_reg, pa0, pa1, pa2, pa3); SBAR();
  pv_d0(o, vb0 + (int)SHM_V, pa0, pa1, pa2, pa3);
  if (hi == 0) li_l[r32] = l_reg; asm volatile("s_waitcnt lgkmcnt(0)" ::: "memory");
  int lane2; asm volatile("v_mbcnt_lo_u32_b32 %0, -1, 0\n\tv_mbcnt_hi_u32_b32 %0, -1, %0" : "=v"(lane2));
  const int r32b = lane2 & 31, hib = lane2 >> 5;
  float rli[16];
#pragma unroll
  for (int r = 0; r < 16; ++r) rli[r] = __builtin_amdgcn_rcpf(li_l[crow(r, hib)]);
  bf16* Ow = Ob + (long)(wid * QBLK) * LDO + r32b;
#pragma unroll
  for (int r = 0; r < 16; ++r) { int orow = crow(r, hib);
    for (int d0 = 0; d0 < 4; ++d0) Ow[(long)orow * LDO + d0 * 32] = (bf16)(cvtpk(o[d0][r] * rli[r], 0.f) & 0xffffu); }
  __syncthreads();
#undef SLOAD
#undef SWRITE
#undef SWAIT
#undef RESC
}
}

namespace ba {
using namespace da;
constexpr float C2 = SCALE * 1.4426950408889634f;
__device__ __forceinline__ void battn_unit(const bf16* __restrict__ Q, const bf16* __restrict__ K, const bf16* __restrict__ V, bf16* __restrict__ OG, float* __restrict__ LSE,
                                           int p0, int seg_lo, int seg_hi, int h, char* vlds, float* scr, int lane) {
  const int r32 = lane & 31, hi = lane >> 5;
  bf16x8 qr[8];
  { const bf16* qrow = Q + (size_t)(p0 + r32) * 1024 + h * 128 + hi * 8;
#pragma unroll
    for (int d0 = 0; d0 < 8; ++d0) qr[d0] = ld8(qrow + d0 * 16); }
  f32x16 o[4] = {}; float m_reg = -1e30f, l_reg = 0.f;
  const int vb = (int)(uintptr_t)vlds + v_rd_base(lane);
  const int qi = p0 + r32;
#pragma unroll 1
  for (int step = 0; step < 3; ++step) {
    const int kt = step == 0 ? 1 : (step == 1 ? 0 : 2);
    const int k0 = p0 - 64 + 64 * kt;
    if (k0 + 64 <= seg_lo || k0 >= seg_hi) continue;
#pragma unroll
    for (int qt = 0; qt < 4; ++qt) {
      bf16x8 vv[4];
#pragma unroll
      for (int i = 0; i < 4; ++i) { const int key = 4 * (qt * 4 + i) + (lane >> 4); int row = k0 + key; row = row < seg_lo ? seg_lo : (row >= seg_hi ? seg_hi - 1 : row);
        vv[i] = ld8(V + (size_t)row * 1024 + h * 128 + (lane & 15) * 8); }
#pragma unroll
      for (int i = 0; i < 4; ++i) { const int key = 4 * (qt * 4 + i) + (lane >> 4);
        *(bf16x8*)(vlds + v_st(key, (lane & 15) * 8)) = vv[i]; }
    }
    f32x16 s0 = {}, s1 = {};
    { int kr0 = k0 + r32, kr1 = k0 + 32 + r32;
      kr0 = kr0 < seg_lo ? seg_lo : (kr0 >= seg_hi ? seg_hi - 1 : kr0); kr1 = kr1 < seg_lo ? seg_lo : (kr1 >= seg_hi ? seg_hi - 1 : kr1);
      const bf16* kp0 = K + (size_t)kr0 * 1024 + h * 128 + hi * 8; const bf16* kp1 = K + (size_t)kr1 * 1024 + h * 128 + hi * 8;
#pragma unroll
      for (int dh = 0; dh < 2; ++dh) {
        bf16x8 kb0[4], kb1[4];
#pragma unroll
        for (int d0 = 0; d0 < 4; ++d0) { kb0[d0] = ld8(kp0 + (dh * 4 + d0) * 16); kb1[d0] = ld8(kp1 + (dh * 4 + d0) * 16); }
#pragma unroll
        for (int d0 = 0; d0 < 4; ++d0) { s0 = __builtin_amdgcn_mfma_f32_32x32x16_bf16(kb0[d0], qr[dh * 4 + d0], s0, 0, 0, 0); s1 = __builtin_amdgcn_mfma_f32_32x32x16_bf16(kb1[d0], qr[dh * 4 + d0], s1, 0, 0, 0); }
      } }
#pragma unroll
    for (int r = 0; r < 16; ++r) { const int ka = k0 + crow(r, hi), kb = ka + 32;
      const bool oka = (ka >= seg_lo) & (ka < seg_hi) & (ka - qi <= 64) & (qi - ka <= 64);
      const bool okb = (kb >= seg_lo) & (kb < seg_hi) & (kb - qi <= 64) & (qi - kb <= 64);
      s0[r] = oka ? s0[r] : -1e30f; s1[r] = okb ? s1[r] : -1e30f; }
    float pmax = s0[0];
#pragma unroll
    for (int r = 1; r < 16; ++r) pmax = fmaxf(pmax, s0[r]);
#pragma unroll
    for (int r = 0; r < 16; ++r) pmax = fmaxf(pmax, s1[r]);
    { auto rr = __builtin_amdgcn_permlane32_swap(__float_as_uint(pmax), __float_as_uint(pmax), false, false);
      pmax = fmaxf(__uint_as_float(rr[0]), __uint_as_float(rr[1])); }
    const float mn = fmaxf(m_reg, pmax), alpha = __builtin_amdgcn_exp2f((m_reg - mn) * C2), mnC = -mn * C2; m_reg = mn;
    float ps = 0.f;
#pragma unroll
    for (int r = 0; r < 16; ++r) { s0[r] = __builtin_amdgcn_exp2f(fmaf(s0[r], C2, mnC)); s1[r] = __builtin_amdgcn_exp2f(fmaf(s1[r], C2, mnC)); ps += s0[r] + s1[r]; }
    { auto rr = __builtin_amdgcn_permlane32_swap(__float_as_uint(ps), __float_as_uint(ps), false, false);
      ps = __uint_as_float(rr[0]) + __uint_as_float(rr[1]); }
    l_reg = l_reg * alpha + ps;
    bf16x8 pa0, pa1, pa2, pa3;
    PK4(s0, 0, pa0); PK4(s0, 8, pa1); PK4(s1, 0, pa2); PK4(s1, 8, pa3);
    if (hi == 0) scr[r32] = alpha;
    asm volatile("s_waitcnt lgkmcnt(0)" ::: "memory");
#pragma unroll
    for (int d = 0; d < 4; ++d)
#pragma unroll
      for (int r = 0; r < 16; ++r) o[d][r] *= scr[crow(r, hi)];
    pv_d0(o, vb, pa0, pa1, pa2, pa3);
  }
  if (hi == 0) scr[32 + r32] = l_reg;
  asm volatile("s_waitcnt lgkmcnt(0)" ::: "memory");
  float rli[16];
#pragma unroll
  for (int r = 0; r < 16; ++r) rli[r] = __builtin_amdgcn_rcpf(scr[32 + crow(r, hi)]);
  bf16* Ow = OG + (size_t)p0 * 1024 + h * 128;
#pragma unroll
  for (int r = 0; r < 16; ++r) { const int orow = crow(r, hi);
#pragma unroll
    for (int d0 = 0; d0 < 4; ++d0) Ow[(size_t)orow * 1024 + d0 * 32 + r32] = (bf16)(cvtpk(o[d0][r] * rli[r], 0.f) & 0xffffu); }
  if (hi == 0) LSE[(size_t)(p0 + r32) * 8 + h] = m_reg * SCALE + __builtin_amdgcn_logf(l_reg) * 0.6931471805599453f;
}
}
#define GAS __attribute__((address_space(1)))
#define LAS __attribute__((address_space(3)))
typedef unsigned short bf16;
typedef unsigned v4u __attribute__((ext_vector_type(4)));
typedef float f32x4 __attribute__((ext_vector_type(4)));
typedef short bf16x8 __attribute__((ext_vector_type(8)));
typedef GAS unsigned gu32;
typedef GAS unsigned long long gu64;
#define RLX_AGENT __ATOMIC_RELAXED, __HIP_MEMORY_SCOPE_AGENT
#define LDS_WAIT() asm volatile("s_waitcnt lgkmcnt(0)" ::: "memory")
#define VM_WAIT() asm volatile("s_waitcnt vmcnt(0)" ::: "memory")
__device__ __forceinline__ unsigned long long rt() { return __builtin_amdgcn_s_memrealtime(); }
__device__ __forceinline__ unsigned f2bf(float f) { unsigned u = __builtin_bit_cast(unsigned, f); return (u + 0x7fffu + ((u >> 16) & 1u)) >> 16; }
__device__ __forceinline__ unsigned pk2(float lo, float hi) { return f2bf(lo) | (f2bf(hi) << 16); }

#define XB_TMO      128
#define XB_XCNT(j)  (256  + 64 * (j))
#define XB_XSUB(j)  (1280 + 64 * (j))
#define XB_XGEN(j)  (2304 + 64 * (j))
#define XB_TOP      3328
#define XB_TOPGEN   3392
#define XCD_BAR_WORDS 3456
#define XB_SPIN_CAP (1u << 18)

__device__ __forceinline__ unsigned xb_ld(unsigned* p)              { return __hip_atomic_load(p, __ATOMIC_RELAXED, __HIP_MEMORY_SCOPE_AGENT); }
__device__ __forceinline__ unsigned xb_add(unsigned* p, unsigned v) { return __hip_atomic_fetch_add(p, v, __ATOMIC_RELAXED, __HIP_MEMORY_SCOPE_AGENT); }
__device__ __forceinline__ unsigned xb_xcc_id() { return (unsigned)__builtin_amdgcn_s_getreg((3 << 11) | 20) & 0xFu; }
#define XB_SPIN(cond, bar) do { unsigned _sp = 0; while (cond) { __builtin_amdgcn_s_sleep(1); \
    if ((++_sp & 255u) == 0u) { if (xb_ld(&(bar)[XB_TMO])) break; if (_sp > XB_SPIN_CAP) { atomicAdd(&(bar)[XB_TMO], 1u); break; } } } } while (0)

struct XcdBarrier {
    unsigned* bar; unsigned x;
    volatile LAS unsigned* st;
};

__device__ __forceinline__ XcdBarrier xcd_barrier_post(unsigned* bar, volatile LAS unsigned* st) {
    XcdBarrier b; b.bar = bar; b.x = xb_xcc_id(); b.st = st;
    if (threadIdx.x == 0) (void)xb_add(&bar[XB_XCNT(b.x)], 1u);
    return b;
}
__device__ __forceinline__ void xcd_barrier_complete(unsigned* bar, unsigned x, unsigned& nloc, unsigned& nx) {
    const unsigned G = gridDim.x * gridDim.y * gridDim.z;
    unsigned sum, cnt, mine, sp = 0u;
    for (;;) {
        sum = 0u; cnt = 0u; mine = 0u;
#pragma unroll
        for (unsigned j = 0; j < 16; ++j) { const unsigned c = xb_ld(&bar[XB_XCNT(j)]); sum += c; cnt += (c > 0u) ? 1u : 0u; mine = (j == x) ? c : mine; }
        if (sum == G) break;
        __builtin_amdgcn_s_sleep(1);
        if ((++sp & 255u) == 0u) { if (xb_ld(&bar[XB_TMO])) break; if (sp > XB_SPIN_CAP) { atomicAdd(&bar[XB_TMO], 1u); break; } }
    }
    nloc = mine > 0u ? mine : 1u; nx = cnt > 0u ? cnt : 1u;
}

__device__ __forceinline__ void xcd_barrier(const XcdBarrier& b) {
    asm volatile("s_waitcnt vmcnt(0)" ::: "memory");
    __syncthreads();
    if (threadIdx.x == 0) {
        unsigned* bar = b.bar;
        __builtin_amdgcn_s_waitcnt(0);
        unsigned nloc = b.st[0], nx = b.st[1];
        if (nloc == 0u) { xcd_barrier_complete(bar, b.x, nloc, nx); b.st[0] = nloc; b.st[1] = nx; }
        const unsigned old = xb_add(&bar[XB_XSUB(b.x)], 1u);
        const unsigned gen = old / nloc;
        if (old + 1u == (gen + 1u) * nloc) {
            __builtin_amdgcn_fence(__ATOMIC_RELEASE, "agent");
            asm volatile("s_waitcnt vmcnt(0)" ::: "memory");
            const unsigned og = xb_add(&bar[XB_TOP], 1u);
            const unsigned tg = og / nx;
            if (og + 1u == (tg + 1u) * nx) xb_add(&bar[XB_TOPGEN], 1u);
            else XB_SPIN(xb_ld(&bar[XB_TOPGEN]) == tg, bar);
            __builtin_amdgcn_fence(__ATOMIC_ACQUIRE, "agent");
            xb_add(&bar[XB_XGEN(b.x)], 1u);
            asm volatile("s_waitcnt vmcnt(0)" ::: "memory");
        } else {
            XB_SPIN(xb_ld(&bar[XB_XGEN(b.x)]) == gen, bar);
            __builtin_amdgcn_fence(__ATOMIC_ACQUIRE, "agent");
            asm volatile("s_waitcnt vmcnt(0)" ::: "memory");
        }
    }
    __syncthreads();
}

constexpr int DM = 2048, SEQ = 16384, NSEQ = 3, MTOK = NSEQ * SEQ, HD = 128, DFF = 8192, MEMR = 768, DEPTH = 4;
constexpr float EPS = 1e-6f;
constexpr int NWAVES = 8;
#ifndef PHMASK
#define PHMASK 0xFFFFFFu
#endif
#define PH(n) (((PHMASK) >> (n)) & 1u)
constexpr size_t MiB = 1u << 20;
constexpr size_t WS_CTL = 0, CTL_ZERO_BYTES = 1 * MiB;
constexpr size_t WS_COS1 = 1 * MiB, WS_SIN1 = 5 * MiB;
constexpr size_t WS_AXT = 9 * MiB;
constexpr size_t WS_MEMN = 10 * MiB;
constexpr size_t WS_CKVT = 22 * MiB;
constexpr size_t WS_CKV = 38 * MiB;
constexpr size_t WS_WQKV = 44 * MiB;
constexpr size_t WS_WO = 80 * MiB;
constexpr size_t WS_CWQ = 88 * MiB, WS_CWO = 90 * MiB;
constexpr size_t WS_WUP = 92 * MiB, WS_WDN = 124 * MiB;
constexpr size_t WS_HN = 156 * MiB;
constexpr size_t WS_QKV = 348 * MiB;
constexpr size_t WS_BIG = 636 * MiB;
constexpr size_t WS_END = 892 * MiB;
constexpr size_t BIG_OB = 0, BIG_OG = 96 * MiB, BIG_LSE = 192 * MiB;
constexpr int CW_BAR = 4096;
constexpr int RING_BYTES = 131072;
constexpr int LDSCTL_OFF = RING_BYTES, MISC_OFF = LDSCTL_OFF + 320;
constexpr int PTAB_OFF = RING_BYTES + 512;
constexpr int BSCR_OFF = RING_BYTES + 1024;
constexpr int LDS_BYTES = 147456;

__device__ __forceinline__ float shflx(float v, int mask, int lane) { return __builtin_bit_cast(float, __builtin_amdgcn_ds_bpermute((lane ^ mask) << 2, __builtin_bit_cast(int, v))); }
__device__ __forceinline__ float wave_sum(float v, int lane) {
#pragma unroll
    for (int o = 1; o < 64; o <<= 1) v += shflx(v, o, lane);
    return v;
}
__device__ __forceinline__ void transpose_item(const float* W, int K, int N, bf16* WT, LAS float* scr, int item, int lane) {
    const int nblk = N / 32, kb = item / nblk, nb = item % nblk, k0 = 64 * kb, n0 = 32 * nb;
#pragma unroll 8
    for (int i = 0; i < 32; ++i) { const int kk = 2 * i + (lane >> 5); scr[kk * 33 + (lane & 31)] = W[(size_t)(k0 + kk) * N + n0 + (lane & 31)]; }
    LDS_WAIT(); asm volatile("" ::: "memory");
    const int c = lane & 7;
#pragma unroll
    for (int j = 0; j < 4; ++j) { const int n = (lane >> 3) + 8 * j; const LAS float* s = scr + (8 * c) * 33 + n;
        v4u o; o.x = pk2(s[0 * 33], s[1 * 33]); o.y = pk2(s[2 * 33], s[3 * 33]); o.z = pk2(s[4 * 33], s[5 * 33]); o.w = pk2(s[6 * 33], s[7 * 33]);
        *(GAS v4u*)(WT + (size_t)(n0 + n) * K + k0 + 8 * c) = o; }
    LDS_WAIT(); asm volatile("" ::: "memory");
}
__device__ __forceinline__ void transpose_all(const float* W, int K, int N, bf16* WT, LAS float* scr, int gw, int NGW, int lane) {
    const int nitems = (K / 64) * (N / 32);
    for (int it = gw; it < nitems; it += NGW) transpose_item(W, K, N, WT, scr, it, lane);
}
__device__ __forceinline__ void rms_row_bf16(const float* xrow, const float* gain, bf16* orow, float* copy, int lane) {
    const GAS f32x4* xr = (const GAS f32x4*)xrow + lane; const GAS f32x4* gr = (const GAS f32x4*)gain + lane;
    f32x4 v[8]; float s = 0.f;
#pragma unroll
    for (int j = 0; j < 8; ++j) { v[j] = xr[64 * j]; s += (v[j].x * v[j].x + v[j].y * v[j].y) + (v[j].z * v[j].z + v[j].w * v[j].w); }
    const float rstd = 1.0f / sqrtf(wave_sum(s, lane) * (1.f / DM) + EPS);
    if (copy) { GAS f32x4* c4 = (GAS f32x4*)copy + lane;
#pragma unroll
        for (int j = 0; j < 8; ++j) c4[64 * j] = v[j]; }
    GAS unsigned long long* o8 = (GAS unsigned long long*)orow + lane;
#pragma unroll
    for (int j = 0; j < 8; ++j) { const f32x4 g = gr[64 * j];
        o8[64 * j] = (unsigned long long)pk2(v[j].x * rstd * g.x, v[j].y * rstd * g.y) | ((unsigned long long)pk2(v[j].z * rstd * g.z, v[j].w * rstd * g.w) << 32); }
}
__device__ __forceinline__ void rms_row_f32_inplace(float* xrow, const float* gain, int lane) {
    GAS f32x4* xr = (GAS f32x4*)xrow + lane; const GAS f32x4* gr = (const GAS f32x4*)gain + lane;
    f32x4 v[8]; float s = 0.f;
#pragma unroll
    for (int j = 0; j < 8; ++j) { v[j] = xr[64 * j]; s += (v[j].x * v[j].x + v[j].y * v[j].y) + (v[j].z * v[j].z + v[j].w * v[j].w); }
    const float rstd = 1.0f / sqrtf(wave_sum(s, lane) * (1.f / DM) + EPS);
#pragma unroll
    for (int j = 0; j < 8; ++j) { const f32x4 g = gr[64 * j]; xr[64 * j] = v[j] * rstd * g; }
}
__device__ __forceinline__ float bf2f(unsigned short b) { return __builtin_bit_cast(float, (unsigned)b << 16); }
typedef unsigned short us8 __attribute__((ext_vector_type(8)));

typedef const __attribute__((address_space(4))) unsigned long long* kargp_t;
#define P_IN(i) ((const float*)(const GAS float*)kp[(i)])
#define PHASE_PTRS kargp_t kp = (kargp_t)__builtin_amdgcn_kernarg_segment_ptr(); asm volatile("" : "+s"(kp)); unsigned char* ws = (unsigned char*)(GAS unsigned char*)kp[21]; \
    const float* x_prompt = P_IN(0); const float* x_sample = P_IN(1); const float* mem_prompt = P_IN(2); const float* mem_sample = P_IN(3); \
    const float* norm_mix = P_IN(4); const float* a_wqkv = P_IN(5); const float* a_q_gain = P_IN(6); const float* a_k_gain = P_IN(7); const float* a_wo = P_IN(8); \
    const float* b_wqkv = P_IN(9); const float* b_wo = P_IN(10); const float* norm_cross = P_IN(11); const float* norm_mem = P_IN(12); \
    const float* c_wq = P_IN(13); const float* c_wkv = P_IN(14); const float* c_wo = P_IN(15); const float* norm_mlp = P_IN(16); \
    const float* w_up = P_IN(17); const float* w_down = P_IN(18); const float* final_norm = P_IN(19); \
    float* X = (float*)(GAS float*)kp[20]; \
    float* COS1 = (float*)(ws + WS_COS1); float* SIN1 = (float*)(ws + WS_SIN1); float* AXT = (float*)(ws + WS_AXT); \
    bf16* MEMN = (bf16*)(ws + WS_MEMN); bf16* CKVT = (bf16*)(ws + WS_CKVT); bf16* CKV = (bf16*)(ws + WS_CKV); \
    bf16* WQKV = (bf16*)(ws + WS_WQKV); bf16* WO = (bf16*)(ws + WS_WO); bf16* CWQ = (bf16*)(ws + WS_CWQ); bf16* CWO = (bf16*)(ws + WS_CWO); \
    bf16* WUP = (bf16*)(ws + WS_WUP); bf16* WDN = (bf16*)(ws + WS_WDN); bf16* HN = (bf16*)(ws + WS_HN); \
    bf16* QKV = (bf16*)(ws + WS_QKV); bf16* HB = (bf16*)(ws + WS_BIG); \
    bf16* OB = (bf16*)(ws + WS_BIG + BIG_OB); bf16* OG = (bf16*)(ws + WS_BIG + BIG_OG); float* LSE = (float*)(ws + WS_BIG + BIG_LSE); \
    bf16* QA = QKV; bf16* KA = QKV + (size_t)MTOK * 2048; bf16* VA = KA + (size_t)MTOK * 512;
struct Args { const float* in[20]; float* out; unsigned char* ws; };
__global__ void __launch_bounds__(NWAVES * 64, 2) fwd_kernel(Args args) {
    extern __shared__ __attribute__((aligned(16))) unsigned char lds[];
    LAS unsigned char* ldsl = (LAS unsigned char*)lds;
    volatile LAS unsigned* MISC = (volatile LAS unsigned*)(ldsl + MISC_OFF);
    const int wave = __builtin_amdgcn_readfirstlane(threadIdx.x >> 6);
#define OPQ_LANE int lane, G = G_k, bx = bx_k; asm volatile("v_mbcnt_lo_u32_b32 %0, -1, 0\n\tv_mbcnt_hi_u32_b32 %0, -1, %0" : "=v"(lane)); asm volatile("" : "+s"(G), "+s"(bx)); const int tid = wave * 64 + lane; const int gw = bx * NWAVES + wave, NGW = G * NWAVES; LAS float* tscr = (LAS float*)(ldsl + wave * 16384)
    const int G_k = gridDim.x, bx_k = blockIdx.x;
    for (int u = threadIdx.x; u < (LDS_BYTES - LDSCTL_OFF) / 4; u += NWAVES * 64) ((LAS unsigned*)(ldsl + LDSCTL_OFF))[u] = 0u;
    __syncthreads();
    XcdBarrier bar = xcd_barrier_post((unsigned*)(args.ws + WS_CTL) + CW_BAR, MISC + 8);
#define GRID_BAR() do { XcdBarrier b2_ = bar; unsigned long long bp_ = (unsigned long long)bar.bar; asm volatile("" : "+s"(bp_), "+s"(b2_.x)); b2_.bar = (unsigned*)(GAS unsigned*)bp_; xcd_barrier(b2_); } while (0)


    if constexpr (PH(0))
    { OPQ_LANE; PHASE_PTRS;
        for (int e = bx * 512 + tid; e < SEQ * 64; e += G * 512) {
            const int t = e >> 6, i = e & 63;
            const double inv = exp2(-(double)i * (13.287712379549449 / 64.0));
            const double a = (double)t * inv, rev = a * 0.15915494309189535; const float fr = (float)(rev - floor(rev));
            COS1[e] = __builtin_amdgcn_cosf(fr); SIN1[e] = __builtin_amdgcn_sinf(fr);
        }
        for (int e = bx * 512 + tid; e < 320 * 32; e += G * 512) {
            const int p = e >> 5, i = e & 31; const int pos = p < 256 ? p : p - 256;
            const double inv = exp2(-(double)i * (13.287712379549449 / 32.0));
            const double a = (double)pos * inv, rev = a * 0.15915494309189535; const float fr = (float)(rev - floor(rev));
            const float c = __builtin_amdgcn_cosf(fr), s = __builtin_amdgcn_sinf(fr);
            if (p < 256) { AXT[p * 32 + i] = c; AXT[8192 + p * 32 + i] = s; } else { AXT[16384 + pos * 32 + i] = c; AXT[16384 + 2048 + pos * 32 + i] = s; }
        }
        for (int r = gw; r < DEPTH * MEMR; r += NGW) { const int l = r / MEMR, m = r % MEMR;
            const float* src = m < 256 ? mem_prompt + (size_t)m * DM : mem_sample + (size_t)(m - 256) * DM;
            rms_row_bf16(src, norm_mem + l * DM, MEMN + (size_t)r * DM, nullptr, lane); }
        for (int l = 0; l < DEPTH; ++l) transpose_all(c_wkv + (size_t)l * DM * 1024, DM, 1024, CKVT + (size_t)l * 1024 * DM, tscr, gw, NGW, lane);
    }

    for (int layer = 0; layer < DEPTH; ++layer) {
        const int j = layer >> 1; const bool isA = (layer & 1) == 0;
        if constexpr (PH(1))
        { OPQ_LANE; PHASE_PTRS;
            if (isA) { transpose_all(a_wqkv + (size_t)j * DM * 3072, DM, 3072, WQKV, tscr, gw, NGW, lane); transpose_all(a_wo + (size_t)j * DM * DM, DM, DM, WO, tscr, gw, NGW, lane); }
            else { transpose_all(b_wqkv + (size_t)j * DM * 9216, DM, 9216, WQKV, tscr, gw, NGW, lane); transpose_all(b_wo + (size_t)j * 1024 * DM, 1024, DM, WO, tscr, gw, NGW, lane); }
            transpose_all(c_wq + (size_t)layer * DM * 512, DM, 512, CWQ, tscr, gw, NGW, lane);
            transpose_all(c_wo + (size_t)layer * 512 * DM, 512, DM, CWO, tscr, gw, NGW, lane);
            transpose_all(w_up + (size_t)layer * DM * DFF, DM, DFF, WUP, tscr, gw, NGW, lane);
            transpose_all(w_down + (size_t)layer * DFF * DM, DFF, DM, WDN, tscr, gw, NGW, lane);
            if (layer == 0) {
                for (int m = gw; m < MTOK; m += NGW) { const float* src = m < SEQ ? x_prompt + (size_t)m * DM : x_sample + (size_t)(m - SEQ) * DM;
                    rms_row_bf16(src, norm_mix, HN + (size_t)m * DM, X + (size_t)m * DM, lane); }
            } else {
                for (int m = gw; m < MTOK; m += NGW) rms_row_bf16(X + (size_t)m * DM, norm_mix + layer * DM, HN + (size_t)m * DM, nullptr, lane);
            }
            GRID_BAR();
        }
        if (PH(2) && layer == 0) { OPQ_LANE; PHASE_PTRS;
            pg8::Gemm g{MEMN, CKVT, DEPTH * MEMR, DEPTH * 1024, DM}; pg8::GroupedOrder S; S.init(G, bx);
            pg8::EpiB<0> E{CKV, 1024, 4, nullptr, nullptr};
            pg8::gemm_phase<pg8::EpiB<0>, pg8::GroupedOrder, true, true>(ldsl, g, S, E, tid);
        }
        if (isA) {
            if constexpr (PH(3))
            { OPQ_LANE; PHASE_PTRS; pg8::Gemm g{HN, WQKV, MTOK, 3072, DM}; pg8::StaticOrder S; S.init(MTOK, 3072, G, bx);
              pg8::EpiB<1> E{QA, 2048, 1, KA, VA};
              pg8::gemm_phase<pg8::EpiB<1>, pg8::StaticOrder, true, true>(ldsl, g, S, E, tid); GRID_BAR(); }
            if constexpr (PH(4))
            { OPQ_LANE; PHASE_PTRS;
                const float* qg = a_q_gain + j * HD; const float* kg = a_k_gain + j * HD;
                const int jl = lane & 15, sub = lane >> 4;
                const long nq = (long)MTOK * 16, nk = (long)MTOK * 4;
                for (long hr4 = gw; hr4 < (nq + nk) / 4; hr4 += NGW) {
                    long hr = hr4 * 4 + sub; const bool isq = hr < nq; bf16* p; int tok; const float* gp;
                    if (isq) { p = QA + hr * 128; tok = (int)(hr >> 4); gp = qg; } else { hr -= nq; p = KA + hr * 128; tok = (int)(hr >> 2); gp = kg; }
                    const int t = tok & (SEQ - 1), prow = t >> 6, pcol = t & 63;
                    const us8 raw = *(const GAS us8*)(p + jl * 8);
                    float v[8]; float ss = 0.f;
#pragma unroll
                    for (int e = 0; e < 8; ++e) { v[e] = bf2f(raw[e]); ss += v[e] * v[e]; }
                    ss += shflx(ss, 1, lane); ss += shflx(ss, 2, lane); ss += shflx(ss, 4, lane); ss += shflx(ss, 8, lane);
                    const float rstd = 1.0f / sqrtf(ss * (1.f / 128.f) + EPS);
                    const float* ct = (jl < 8) ? AXT + prow * 32 + (jl & 3) * 8 : AXT + 16384 + pcol * 32 + (jl & 3) * 8;
                    const float* st = ct + ((jl < 8) ? 8192 : 2048);
                    const f32x4 g0 = *(const GAS f32x4*)(gp + jl * 8), g1 = *(const GAS f32x4*)(gp + jl * 8 + 4);
                    const f32x4 c0 = *(const GAS f32x4*)ct, c1 = *(const GAS f32x4*)(ct + 4), s0 = *(const GAS f32x4*)st, s1 = *(const GAS f32x4*)(st + 4);
                    const float sgn = (jl & 4) ? 1.f : -1.f;
                    float o[8];
#pragma unroll
                    for (int e = 0; e < 8; ++e) { const float y = v[e] * rstd * (e < 4 ? g0[e] : g1[e - 4]); const float pr = shflx(y, 4, lane);
                        const float c = e < 4 ? c0[e] : c1[e - 4], s = e < 4 ? s0[e] : s1[e - 4]; o[e] = y * c + sgn * pr * s; }
                    v4u w; w.x = pk2(o[0], o[1]); w.y = pk2(o[2], o[3]); w.z = pk2(o[4], o[5]); w.w = pk2(o[6], o[7]);
                    *(GAS v4u*)(p + jl * 8) = w;
                }
                GRID_BAR();
            }
            if constexpr (PH(5))
            { OPQ_LANE; PHASE_PTRS;
                for (int u = bx; u < NSEQ * 16 * 64; u += G) {
                    const int qb = u & 63, hg = (u >> 6) & 3, kvh = (u >> 8) & 3, b = u >> 10, h = kvh * 4 + hg;
                    bf16* Qb = QA + ((size_t)b * SEQ + (size_t)qb * 256) * 2048 + h * 128;
                    const bf16* Kh = KA + (size_t)b * SEQ * 512 + kvh * 128; const bf16* Vh = VA + (size_t)b * SEQ * 512 + kvh * 128;
                    da::attn_dense_body<2048, 512, 2048>(Qb, Kh, Vh, Qb, SEQ, (char*)lds, wave);
                }
                GRID_BAR();
            }
            if constexpr (PH(6))
            { OPQ_LANE; PHASE_PTRS; pg8::Gemm g{QA, WO, MTOK, DM, DM}; pg8::StaticOrder S; S.init(MTOK, DM, G, bx);
              pg8::EpiRes E{X, DM, 0};
              pg8::gemm_phase<pg8::EpiRes, pg8::StaticOrder, true, true>(ldsl, g, S, E, tid); GRID_BAR(); }
        } else {
            for (int sq = 0; sq < NSEQ; ++sq) {
                if constexpr (PH(7))
                { OPQ_LANE; PHASE_PTRS; pg8::Gemm g{HN + (size_t)sq * SEQ * DM, WQKV, SEQ, 9216, DM}; pg8::StaticOrder S; S.init(SEQ, 9216, G, bx);
                  pg8::EpiB<2> E{QKV, 1024, 1, nullptr, nullptr};
                  pg8::gemm_phase<pg8::EpiB<2>, pg8::StaticOrder, true, true>(ldsl, g, S, E, tid); GRID_BAR(); }
                if constexpr (PH(8))
                { OPQ_LANE; PHASE_PTRS;
                    const int jl = lane & 15, sub = lane >> 4;
                    const long nrows = 6L * SEQ * 8;
                    for (long hr4 = gw; hr4 < nrows / 4; hr4 += NGW) {
                        const long hr = hr4 * 4 + sub; const int blk = (int)(hr / ((long)SEQ * 8)), g = blk % 3; const int pp = (int)((hr >> 3) & (SEQ - 1));
                        const int shift = 2 * g, t = ((pp & ((SEQ >> shift) - 1)) << shift) + (pp >> (14 - shift));
                        bf16* p = QKV + hr * 128;
                        const us8 raw = *(const GAS us8*)(p + jl * 8);
                        const float* ct = COS1 + t * 64 + (jl & 7) * 8; const float* st = SIN1 + t * 64 + (jl & 7) * 8;
                        const f32x4 c0 = *(const GAS f32x4*)ct, c1 = *(const GAS f32x4*)(ct + 4), s0 = *(const GAS f32x4*)st, s1 = *(const GAS f32x4*)(st + 4);
                        const float sgn = (jl & 8) ? 1.f : -1.f;
                        float o[8];
#pragma unroll
                        for (int e = 0; e < 8; ++e) { const float y = bf2f(raw[e]); const float pr = shflx(y, 8, lane);
                            const float c = e < 4 ? c0[e] : c1[e - 4], s = e < 4 ? s0[e] : s1[e - 4]; o[e] = y * c + sgn * pr * s; }
                        v4u w; w.x = pk2(o[0], o[1]); w.y = pk2(o[2], o[3]); w.z = pk2(o[4], o[5]); w.w = pk2(o[6], o[7]);
                        *(GAS v4u*)(p + jl * 8) = w;
                    }
                    GRID_BAR();
                }
                if constexpr (PH(9))
                { OPQ_LANE; PHASE_PTRS;
                    char* vl = (char*)lds + wave * 16384; float* scr = (float*)((char*)lds + BSCR_OFF + wave * 256);
                    for (int u = gw; u < 3 * 8 * (SEQ / 32); u += NGW) {
                        const int tile = u & 511, gh = u >> 9, g = gh >> 3, h = gh & 7, p0 = tile * 32;
                        const int seglen = SEQ >> (2 * g), seg_lo = p0 & ~(seglen - 1), seg_hi = seg_lo + seglen;
                        const size_t blk = (size_t)SEQ * 1024;
                        ba::battn_unit(QKV + (size_t)g * blk, QKV + (size_t)(3 + g) * blk, QKV + (size_t)(6 + g) * blk, OG + (size_t)g * blk, LSE + (size_t)g * SEQ * 8,
                                       p0, seg_lo, seg_hi, h, vl, scr, lane);
                    }
                    GRID_BAR();
                }
                if constexpr (PH(10))
                { OPQ_LANE; PHASE_PTRS;
                    const int jl = lane & 15, sub = lane >> 4;
                    for (int r4 = gw; r4 < SEQ * 8 / 4; r4 += NGW) {
                        const int rr = r4 * 4 + sub, t = rr >> 3, h = rr & 7;
                        float ls[3]; us8 ov[3];
#pragma unroll
                        for (int g = 0; g < 3; ++g) { const int shift = 2 * g; const int pp = ((t & ((1 << shift) - 1)) << (14 - shift)) + (t >> shift);
                            ls[g] = LSE[(size_t)g * SEQ * 8 + (size_t)pp * 8 + h]; ov[g] = *(const GAS us8*)(OG + (size_t)g * SEQ * 1024 + (size_t)pp * 1024 + h * 128 + jl * 8); }
                        const float mx = fmaxf(ls[0], fmaxf(ls[1], ls[2]));
                        float w0 = __expf(ls[0] - mx), w1 = __expf(ls[1] - mx), w2 = __expf(ls[2] - mx); const float inv = 1.f / (w0 + w1 + w2); w0 *= inv; w1 *= inv; w2 *= inv;
                        float o[8];
#pragma unroll
                        for (int e = 0; e < 8; ++e) o[e] = w0 * bf2f(ov[0][e]) + w1 * bf2f(ov[1][e]) + w2 * bf2f(ov[2][e]);
                        v4u w; w.x = pk2(o[0], o[1]); w.y = pk2(o[2], o[3]); w.z = pk2(o[4], o[5]); w.w = pk2(o[6], o[7]);
                        *(GAS v4u*)(OB + ((size_t)sq * SEQ + t) * 1024 + h * 128 + jl * 8) = w;
                    }
                    GRID_BAR();
                }
            }
            if constexpr (PH(11))
            { OPQ_LANE; PHASE_PTRS; pg8::Gemm g{OB, WO, MTOK, DM, 1024}; pg8::StaticOrder S; S.init(MTOK, DM, G, bx);
              pg8::EpiRes E{X, DM, 0};
              pg8::gemm_phase<pg8::EpiRes, pg8::StaticOrder, true, true>(ldsl, g, S, E, tid); GRID_BAR(); }
        }
        if constexpr (PH(12))
        { OPQ_LANE; PHASE_PTRS; for (int m = gw; m < MTOK; m += NGW) rms_row_bf16(X + (size_t)m * DM, norm_cross + layer * DM, HN + (size_t)m * DM, nullptr, lane); GRID_BAR(); }
        if constexpr (PH(13))
        { OPQ_LANE; PHASE_PTRS; pg8::Gemm g{HN, CWQ, MTOK, 512, DM}; pg8::StaticOrder S; S.init(MTOK, 512, G, bx);
          pg8::EpiB<0> E{QKV, 512, 1 << 20, nullptr, nullptr};
          pg8::gemm_phase<pg8::EpiB<0>, pg8::StaticOrder, true, true>(ldsl, g, S, E, tid); GRID_BAR(); }
        if constexpr (PH(14))
        { OPQ_LANE; PHASE_PTRS;
            const bf16* ckv = CKV + (size_t)layer * MEMR * 1024;
            for (int u = bx; u < NSEQ * 4 * 64; u += G) {
                const int qb = u & 63, h = (u >> 6) & 3, b = u >> 8;
                bf16* Qb = QKV + ((size_t)b * SEQ + (size_t)qb * 256) * 512 + h * 128;
                const bf16* Kh = ckv + (size_t)b * 256 * 1024 + h * 128; const bf16* Vh = Kh + 512;
                da::attn_dense_body<512, 1024, 512>(Qb, Kh, Vh, Qb, 256, (char*)lds, wave);
            }
            GRID_BAR();
        }
        if constexpr (PH(15))
        { OPQ_LANE; PHASE_PTRS; pg8::Gemm g{QKV, CWO, MTOK, DM, 512}; pg8::StaticOrder S; S.init(MTOK, DM, G, bx);
          pg8::EpiRes E{X, DM, 0};
          pg8::gemm_phase<pg8::EpiRes, pg8::StaticOrder, true, true>(ldsl, g, S, E, tid); GRID_BAR(); }
        if constexpr (PH(16))
        { OPQ_LANE; PHASE_PTRS; for (int m = gw; m < MTOK; m += NGW) rms_row_bf16(X + (size_t)m * DM, norm_mlp + layer * DM, HN + (size_t)m * DM, nullptr, lane); GRID_BAR(); }
        for (int ch = 0; ch < NSEQ; ++ch) {
            if constexpr (PH(17))
            { OPQ_LANE; PHASE_PTRS; pg8::Gemm g{HN + (size_t)ch * SEQ * DM, WUP, SEQ, DFF, DM}; pg8::StaticOrder S; S.init(SEQ, DFF, G, bx);
              pg8::EpiB<3> E{HB, DFF, 1 << 20, nullptr, nullptr};
              pg8::gemm_phase<pg8::EpiB<3>, pg8::StaticOrder, true, true>(ldsl, g, S, E, tid); GRID_BAR(); }
            if constexpr (PH(18))
            { OPQ_LANE; PHASE_PTRS; pg8::Gemm g{HB, WDN, SEQ, DM, DFF}; pg8::StaticOrder S; S.init(SEQ, DM, G, bx);
              pg8::EpiRes E{X, DM, ch * SEQ};
              pg8::gemm_phase<pg8::EpiRes, pg8::StaticOrder, true, true>(ldsl, g, S, E, tid); GRID_BAR(); }
        }
    }
    if constexpr (PH(19)) { OPQ_LANE; PHASE_PTRS;
    for (int m = gw; m < MTOK; m += NGW) rms_row_f32_inplace(X + (size_t)m * DM, final_norm, lane); }
}

extern "C" void kernel_launch(void* const* d_in, const int* in_sizes, int n_in, void* d_out, int out_size, void* d_ws, size_t ws_size, hipStream_t stream) {
    static int grid = 0;
    if (grid == 0) {
        if (n_in != 20 || out_size != MTOK * DM || ws_size < WS_END) { fprintf(stderr, "kernel_launch: unexpected shapes: n_in %d out %d ws %zu (need %zu)\n", n_in, out_size, ws_size, (size_t)WS_END); grid = -1; return; }
        int dev = 0, cus = 0, per_cu = 0;
        if (hipGetDevice(&dev) != hipSuccess || hipDeviceGetAttribute(&cus, hipDeviceAttributeMultiprocessorCount, dev) != hipSuccess) { grid = -1; return; }
        if (hipFuncSetAttribute((const void*)fwd_kernel, hipFuncAttributeMaxDynamicSharedMemorySize, LDS_BYTES) != hipSuccess) { fprintf(stderr, "kernel_launch: hipFuncSetAttribute failed\n"); grid = -1; return; }
        if (hipOccupancyMaxActiveBlocksPerMultiprocessor(&per_cu, (const void*)fwd_kernel, NWAVES * 64, LDS_BYTES) != hipSuccess || per_cu < 1)
            fprintf(stderr, "kernel_launch: note: occupancy query reports %d workgroups per CU\n", per_cu);
        (void)hipGetLastError();
        grid = cus;
    }
    if (grid < 0) return;
    if (hipMemsetAsync((char*)d_ws + WS_CTL, 0, CTL_ZERO_BYTES, stream) != hipSuccess) { fprintf(stderr, "kernel_launch: memset failed\n"); return; }
    Args a{};
    for (int i = 0; i < 20; ++i) a.in[i] = (const float*)d_in[i];
    a.out = (float*)d_out; a.ws = (unsigned char*)d_ws;
    hipLaunchKernelGGL(fwd_kernel, dim3(grid), dim3(NWAVES * 64), LDS_BYTES, stream, a);
    const hipError_t le = hipPeekAtLastError();
    if (le != hipSuccess) fprintf(stderr, "kernel_launch: launch failed: %s\n", hipGetErrorName(le));
}
```

```cpp
#include <hip/hip_runtime.h>
#include <cstdio>
#include <cstdint>
namespace pg8 {
#define PG8_LAS __attribute__((address_space(3)))
typedef unsigned short bf16_t;
typedef short bf16x8 __attribute__((ext_vector_type(8)));
typedef float f32x4 __attribute__((ext_vector_type(4)));
typedef unsigned u32x4 __attribute__((ext_vector_type(4)));
constexpr int BM = 256, BK = 64, HALF = 128, HTB = HALF * BK * 2  , STAGE_BYTES = 8 * HTB, NXCD = 8, WGM = 4;

__host__ __device__ __forceinline__ int lds_byte(int r, int c) { const int st = (r >> 4) * 2 + (c >> 5), rr = r & 15, cc = c & 31, ob = rr * 64 + cc * 2; return st * 1024 + (ob ^ (((ob >> 9) & 1) << 5)); }
__host__ __device__ __forceinline__ void stage_rc(int b, int& R, int& C) { const int st = b / 1024, sb = b % 1024, swz = sb ^ (((sb >> 9) & 1) << 5); R = (st >> 1) * 16 + swz / 64; C = (st & 1) * 32 + (swz % 64) / 2; }
__host__ __device__ __forceinline__ int perm32(int rho) { const int n = rho >> 4, i = rho & 15; return 8 * (i >> 2) + 4 * n + (i & 3); }

struct Unit { int pm, pn; };
struct Gemm { const bf16_t* A; const bf16_t* Bt; int M, N, K; };

struct StaticOrder {
    int nM, nN, nwg, G, c, wgm;
    __host__ __device__ void init(int M, int N, int G_, int c_, int wgm_ = WGM) { nM = M / BM; nN = N / BM; nwg = nM * nN; G = G_; c = c_; wgm = wgm_; }
    __host__ __device__ bool next(int i, Unit& u) const {
        const long L = (long)i * G + c; if (L >= nwg) return false;
        int wgid = (int)L; { const int q = nwg / NXCD, r = nwg % NXCD, xcd = wgid % NXCD, off = wgid / NXCD; wgid = (xcd < r ? xcd * (q + 1) : r * (q + 1) + (xcd - r) * q) + off; }
        const int nig = wgm * nN, gid = wgid / nig, fm = gid * wgm, gsz = (nM - fm) < wgm ? (nM - fm) : wgm;
        u.pm = fm + ((wgid % nig) % gsz); u.pn = (wgid % nig) / gsz; return true;
    }
    __device__ __forceinline__ void a_ready(const Unit&) const {}
    __device__ __forceinline__ void done(const Unit&) const {}
};

__device__ __forceinline__ unsigned cvt_pk_bf16(float lo, float hi) { unsigned r; asm volatile("v_cvt_pk_bf16_f32 %0, %1, %2" : "=v"(r) : "v"(lo), "v"(hi)); return r; }
typedef float f32x2 __attribute__((ext_vector_type(2)));
__device__ __forceinline__ f32x2 gelu_pk(f32x2 v) {
    const f32x2 av = __builtin_elementwise_abs(v), d = av * 0.2316418882f + 1.0f;
    f32x2 t; t.x = __builtin_amdgcn_rcpf(d.x); t.y = __builtin_amdgcn_rcpf(d.y);
    f32x2 q = t * 0.5307027145f + (-0.7265760135f); q = q * t + 0.7107068705f; q = q * t + (-0.142248368f); q = q * t + 0.127414796f; q = q * t;
    const f32x2 s = (v * v) * (-0.72134752044f);
    f32x2 e; e.x = __builtin_amdgcn_exp2f(s.x); e.y = __builtin_amdgcn_exp2f(s.y);
    const f32x2 m = v * (q * e), r = v - m;
    f32x2 o; o.x = v.x < 0.f ? m.x : r.x; o.y = v.y < 0.f ? m.y : r.y; return o;
}

template <int ACT  > struct EpiBf16 {
    static constexpr bool PERM = true, AFTER_DRAIN = false; static_assert(ACT == 0 || ACT == 1, "EpiBf16: ACT is 0 (none) or 1 (gelu_pk)");
    bf16_t* O; int ldc; const float* bias; int split_cols; size_t split_stride; float scale0;
    __device__ __forceinline__ void operator()(const f32x4 (&acc)[2][2][4][2], const Unit& u, int wr, int wc, int fr, int fq) const {
        const int row0 = u.pm * BM + wr * 64 + fr; int colt = u.pn * BM; bf16_t* base = O;
        float sc = 1.f; if (split_cols) { const int t = colt / split_cols; base += (size_t)t * split_stride; colt -= t * split_cols; if (t == 0) sc = scale0; }
        const int col0 = colt + wc * 32 + 8 * fq, bcol0 = u.pn * BM + wc * 32 + 8 * fq;
        f32x4 bv[2][2];
#pragma unroll
        for (int bj = 0; bj < 2; ++bj)
#pragma unroll
            for (int n = 0; n < 2; ++n) bv[bj][n] = bias ? *(const f32x4*)(bias + bcol0 + bj * HALF + 4 * n) : (f32x4){0.f, 0.f, 0.f, 0.f};
#pragma unroll
        for (int ai = 0; ai < 2; ++ai)
#pragma unroll
            for (int m = 0; m < 4; ++m) { bf16_t* rowp = base + (size_t)(row0 + ai * HALF + m * 16) * ldc + col0;
#pragma unroll
                for (int bj = 0; bj < 2; ++bj) { f32x4 v0 = acc[ai][bj][m][0] + bv[bj][0], v1 = acc[ai][bj][m][1] + bv[bj][1];
                    if (ACT == 1) { f32x2 a = gelu_pk((f32x2){v0[0], v0[1]}), b = gelu_pk((f32x2){v0[2], v0[3]}), c = gelu_pk((f32x2){v1[0], v1[1]}), d = gelu_pk((f32x2){v1[2], v1[3]});
                        v0 = (f32x4){a.x, a.y, b.x, b.y}; v1 = (f32x4){c.x, c.y, d.x, d.y}; }
                    v0 = v0 * sc; v1 = v1 * sc; u32x4 w; w.x = cvt_pk_bf16(v0[0], v0[1]); w.y = cvt_pk_bf16(v0[2], v0[3]); w.z = cvt_pk_bf16(v1[0], v1[1]); w.w = cvt_pk_bf16(v1[2], v1[3]);
                    *(u32x4*)(rowp + bj * HALF) = w; } }
    }
};

template <int MODE> struct EpiB {
    static constexpr bool PERM = true, AFTER_DRAIN = false;
    bf16_t* O; int ldc; int pn_mod; bf16_t* O2; bf16_t* O3;
    const unsigned long long* SS;
    const float* cs; const float* sn;
    __device__ __forceinline__ void operator()(const f32x4 (&acc)[2][2][4][2], const Unit& u, int wr, int wc, int fr, int fq) const {
        const int row0 = u.pm * BM + wr * 64 + fr;
        bf16_t* base = O; int ld = ldc, colt = 0, shift = 0, which = 2;
        if constexpr (MODE == 0 || MODE == 3) { colt = (u.pn % pn_mod) * BM; }
        if constexpr (MODE == 1) {
            if (u.pn < 8) { base = O; ld = 2048; colt = u.pn * BM; }
            else if (u.pn < 10) { base = O2; ld = 512; colt = (u.pn - 8) * BM; }
            else { base = O3; ld = 512; colt = (u.pn - 10) * BM; }
        }
        if constexpr (MODE == 2) {
            which = u.pn / 12; const int g = (u.pn % 12) / 4; colt = (u.pn % 4) * BM; ld = 1024; shift = 2 * g;
            base = O + (size_t)(which * 3 + g) * ((size_t)16384 * 1024);
        }
        const int col0 = colt + wc * 32 + 8 * fq;
        const int rcol = colt + (wc >> 1) * 128 + (wc & 1) * 32 + 8 * fq, rdim = (wc & 1) * 32 + 8 * fq;
#pragma unroll
        for (int ai = 0; ai < 2; ++ai)
#pragma unroll
            for (int m = 0; m < 4; ++m) {
                int r = row0 + ai * HALF + m * 16;
                float rs = 1.f;
                if (SS) rs = __builtin_amdgcn_rsqf((float)SS[r] * (1.0f / (1048576.f * 2048.f)) + 1e-6f);
                const int t = r;
                if constexpr (MODE == 2) r = ((r & ((1 << shift) - 1)) << (14 - shift)) + (r >> shift);
                if (MODE == 2 && which < 2) {
                    const f32x4 c0 = *(const f32x4*)(cs + t * 64 + rdim), c1 = *(const f32x4*)(cs + t * 64 + rdim + 4), s0 = *(const f32x4*)(sn + t * 64 + rdim), s1 = *(const f32x4*)(sn + t * 64 + rdim + 4);
                    const f32x4 l0 = acc[ai][0][m][0] * rs, l1 = acc[ai][0][m][1] * rs, h0 = acc[ai][1][m][0] * rs, h1 = acc[ai][1][m][1] * rs;
                    const f32x4 ol0 = l0 * c0 - h0 * s0, ol1 = l1 * c1 - h1 * s1, oh0 = h0 * c0 + l0 * s0, oh1 = h1 * c1 + l1 * s1;
                    bf16_t* rowp = base + (size_t)r * ld + rcol;
                    u32x4 w; w.x = cvt_pk_bf16(ol0[0], ol0[1]); w.y = cvt_pk_bf16(ol0[2], ol0[3]); w.z = cvt_pk_bf16(ol1[0], ol1[1]); w.w = cvt_pk_bf16(ol1[2], ol1[3]);
                    *(u32x4*)rowp = w;
                    w.x = cvt_pk_bf16(oh0[0], oh0[1]); w.y = cvt_pk_bf16(oh0[2], oh0[3]); w.z = cvt_pk_bf16(oh1[0], oh1[1]); w.w = cvt_pk_bf16(oh1[2], oh1[3]);
                    *(u32x4*)(rowp + 64) = w;
                } else {
                bf16_t* rowp = base + (size_t)r * ld + col0;
#pragma unroll
                for (int bj = 0; bj < 2; ++bj) { f32x4 v0 = acc[ai][bj][m][0] * rs, v1 = acc[ai][bj][m][1] * rs;
                    if constexpr (MODE == 3) {
#pragma unroll
                        for (int e = 0; e < 4; ++e) { const float a = fmaxf(v0[e], 0.f), b = fmaxf(v1[e], 0.f); v0[e] = a * a; v1[e] = b * b; }
                    }
                    u32x4 w; w.x = cvt_pk_bf16(v0[0], v0[1]); w.y = cvt_pk_bf16(v0[2], v0[3]); w.z = cvt_pk_bf16(v1[0], v1[1]); w.w = cvt_pk_bf16(v1[2], v1[3]);
                    *(u32x4*)(rowp + bj * HALF) = w; }
                }
            }
    }
};
typedef _Float16 half2v __attribute__((ext_vector_type(2)));
__device__ __forceinline__ unsigned pk_half(float lo, float hi) { const half2v v = {(_Float16)lo, (_Float16)hi}; return __builtin_bit_cast(unsigned, v); }
struct EpiRes {
    static constexpr bool PERM = true, AFTER_DRAIN = false;
    bf16_t* XB; unsigned long long* SS; int ldc; int row_off;
    __device__ __forceinline__ void operator()(const f32x4 (&acc)[2][2][4][2], const Unit& u, int wr, int wc, int fr, int fq) const {
        const int row0 = row_off + u.pm * BM + wr * 64 + fr, col0 = u.pn * BM + wc * 32 + 8 * fq;
        const int lane = fq * 16 + fr;
#pragma unroll
        for (int ai = 0; ai < 2; ++ai)
#pragma unroll
            for (int m = 0; m < 4; ++m) { const int row = row0 + ai * HALF + m * 16; bf16_t* rowb = XB + (size_t)row * ldc + col0;
                u32x4 xo[2];
#pragma unroll
                for (int bj = 0; bj < 2; ++bj) xo[bj] = *(const u32x4*)(rowb + bj * HALF);
                float s = 0.f;
#pragma unroll
                for (int bj = 0; bj < 2; ++bj) { float v[8];
#pragma unroll
                    for (int e = 0; e < 4; ++e) { const unsigned wv = xo[bj][e]; const half2v h = __builtin_bit_cast(half2v, wv);
                        v[2 * e] = (float)h[0] + acc[ai][bj][m][e >> 1][(2 * e) & 3];
                        v[2 * e + 1] = (float)h[1] + acc[ai][bj][m][e >> 1][(2 * e + 1) & 3]; }
#pragma unroll
                    for (int e = 0; e < 8; ++e) s += v[e] * v[e];
                    u32x4 w; w.x = pk_half(v[0], v[1]); w.y = pk_half(v[2], v[3]); w.z = pk_half(v[4], v[5]); w.w = pk_half(v[6], v[7]);
                    *(u32x4*)(rowb + bj * HALF) = w; }
                s += __builtin_bit_cast(float, __builtin_amdgcn_ds_bpermute((lane ^ 16) << 2, __builtin_bit_cast(int, s)));
                s += __builtin_bit_cast(float, __builtin_amdgcn_ds_bpermute((lane ^ 32) << 2, __builtin_bit_cast(int, s)));
                if (fq == 0) __hip_atomic_fetch_add(SS + row, (unsigned long long)(s * 1048576.f + 0.5f), __ATOMIC_RELAXED, __HIP_MEMORY_SCOPE_AGENT); }
    }
};
struct GroupedOrder {
    int G, c;
    __host__ __device__ void init(int G_, int c_) { G = G_; c = c_; }
    __host__ __device__ bool next(int i, Unit& u) const {
        const int L = i * G + c; if (L >= 48) return false;
        const int layer = L / 12, rem = L % 12; u.pm = layer * 3 + rem % 3; u.pn = layer * 4 + rem / 3; return true;
    }
    __device__ __forceinline__ void a_ready(const Unit&) const {}
    __device__ __forceinline__ void done(const Unit&) const {}
};
struct RepOrder : StaticOrder {
    int reps;
    __host__ __device__ bool next(int i, Unit& u) const { const int rounds = nwg / G; if (i >= rounds * reps) return false; return StaticOrder::next(i % rounds, u); }
};
typedef _Float16 half8 __attribute__((ext_vector_type(8)));
template <class Epi, class Sched, bool ALIGN_EPI = false, bool SP2 = false, bool F16IN = false>
__device__ __forceinline__ void gemm_phase(PG8_LAS unsigned char* lds, const Gemm g, const Sched& S, const Epi& E, const int tid) {
    const int wid = __builtin_amdgcn_readfirstlane(tid >> 6), lane = tid & 63, wr = wid >> 2, wc = wid & 3, fr = lane & 15, fq = lane >> 4;
    const int K = g.K, nt = K / BK;
    unsigned voffA[2], voffB[2];
#pragma unroll
    for (int i = 0; i < 2; ++i) { int R, C; stage_rc(tid * 16 + i * 8192, R, C); const int Rb = Epi::PERM ? ((R & ~31) + perm32(R & 31)) : R;
        voffA[i] = (unsigned)(R * K + C) * 2u; voffB[i] = (unsigned)(Rb * K + C) * 2u; }
    const size_t kstep = (size_t)(BK * 2);
    const size_t hstep = (size_t)HALF * K * 2;
    const size_t tstep = 2 * hstep;
    const unsigned ldsw = (unsigned)wid * 1024u;
    const int aoff = lds_byte(wr * 64 + fr, fq * 8), boff = lds_byte(wc * 32 + fr, fq * 8);
#define PG8_SA(b, h) (((b) * 2 + (h)) * HTB)
#define PG8_SB(b, h) ((4 + (b) * 2 + (h)) * HTB)
#define PG8_STAGE(bufoff, gbase, voff) do { unsigned long long gi_ = (unsigned long long)(gbase); asm volatile("" : "+s"(gi_)); const __attribute__((address_space(1))) char* gb_ = (const __attribute__((address_space(1))) char*)gi_; _Pragma("unroll") for (int _i = 0; _i < 2; ++_i) \
        __builtin_amdgcn_global_load_lds((const __attribute__((address_space(1))) unsigned*)(gb_ + (voff)[_i]), (PG8_LAS unsigned*)(lds + (bufoff) + ldsw + _i * 8192), 16, 0, 0); } while (0)
#define PG8_LDA(dst, b, h) do { _Pragma("unroll") for (int m = 0; m < 4; ++m) _Pragma("unroll") for (int k = 0; k < 2; ++k) dst[m][k] = *(const PG8_LAS bf16x8*)(lds + PG8_SA(b, h) + aoff + m * 2048 + k * 1024); } while (0)
#define PG8_LDB(dst, b, h) do { _Pragma("unroll") for (int n = 0; n < 2; ++n) _Pragma("unroll") for (int k = 0; k < 2; ++k) dst[n][k] = *(const PG8_LAS bf16x8*)(lds + PG8_SB(b, h) + boff + n * 2048 + k * 1024); } while (0)
#define PG8_MMA(ai, bj, At, Bt) do { __builtin_amdgcn_s_setprio(1); _Pragma("unroll") for (int m = 0; m < 4; ++m) _Pragma("unroll") for (int n = 0; n < 2; ++n) _Pragma("unroll") for (int k = 0; k < 2; ++k) \
        { if constexpr (F16IN) acc[ai][bj][m][n] = __builtin_amdgcn_mfma_f32_16x16x32_f16(__builtin_bit_cast(half8, Bt[n][k]), __builtin_bit_cast(half8, At[m][k]), acc[ai][bj][m][n], 0, 0, 0); \
          else acc[ai][bj][m][n] = __builtin_amdgcn_mfma_f32_16x16x32_bf16(Bt[n][k], At[m][k], acc[ai][bj][m][n], 0, 0, 0); } __builtin_amdgcn_s_setprio(0); } while (0)
#define PG8_WAIT_V(n) asm volatile("s_waitcnt vmcnt(" #n ")" ::: "memory")
#define PG8_WAIT_L(n) asm volatile("s_waitcnt lgkmcnt(" #n ")" ::: "memory")
#define PG8_BAR __builtin_amdgcn_s_barrier()
#define PG8_SCHED __builtin_amdgcn_sched_barrier(0)
    Unit cur, nxt; int ui = 0;
    if (!S.next(0, cur)) return;
    f32x4 acc[2][2][4][2];
#pragma unroll
    for (int a = 0; a < 2; ++a)
#pragma unroll
        for (int b = 0; b < 2; ++b)
#pragma unroll
            for (int m = 0; m < 4; ++m)
#pragma unroll
                for (int n = 0; n < 2; ++n) acc[a][b][m][n] = (f32x4){0.f, 0.f, 0.f, 0.f};
    bf16x8 At[4][2], B0[2][2], B1[2][2];
    const char* cA = (const char*)g.A + (size_t)cur.pm * tstep; const char* cB = (const char*)g.Bt + (size_t)cur.pn * tstep;
    S.a_ready(cur);
    if constexpr (SP2) {
        PG8_STAGE(PG8_SB(0, 0), cB, voffB); PG8_STAGE(PG8_SB(0, 1), cB + hstep, voffB); PG8_STAGE(PG8_SA(0, 0), cA, voffA); PG8_STAGE(PG8_SA(0, 1), cA + hstep, voffA);
        if (wr == 1) PG8_BAR;
        PG8_WAIT_V(2); PG8_BAR;
        PG8_STAGE(PG8_SB(1, 0), cB + kstep, voffB); PG8_STAGE(PG8_SA(1, 0), cA + kstep, voffA); PG8_STAGE(PG8_SB(1, 1), cB + hstep + kstep, voffB);
        PG8_WAIT_V(6); PG8_BAR;
    } else {
        PG8_STAGE(PG8_SB(0, 0), cB, voffB); PG8_STAGE(PG8_SA(0, 0), cA, voffA); PG8_STAGE(PG8_SB(0, 1), cB + hstep, voffB); PG8_STAGE(PG8_SA(0, 1), cA + hstep, voffA);
        if (wr == 1) PG8_BAR;
        PG8_WAIT_V(4); PG8_BAR;
        PG8_STAGE(PG8_SB(1, 0), cB + kstep, voffB); PG8_STAGE(PG8_SA(1, 0), cA + kstep, voffA); PG8_STAGE(PG8_SB(1, 1), cB + hstep + kstep, voffB);
        PG8_WAIT_V(6); PG8_BAR;
    }
    for (;;) {
        const bool has_next = S.next(ui + 1, nxt);
        const char* nA = has_next ? (const char*)g.A + (size_t)nxt.pm * tstep : cA; const char* nB = has_next ? (const char*)g.Bt + (size_t)nxt.pn * tstep : cB;
        for (int t = 0; t < nt; t += 2) {
            asm volatile("" : "+v"(voffA[0]), "+v"(voffA[1]), "+v"(voffB[0]), "+v"(voffB[1]));
            const bool last = (t == nt - 2);
            const char* a1 = cA + (size_t)(t + 1) * kstep;
            const char* a2 = last ? nA : cA + (size_t)(t + 2) * kstep; const char* b2 = last ? nB : cB + (size_t)(t + 2) * kstep;
            const char* a3 = a2 + kstep; const char* b3 = b2 + kstep;
            if (last && has_next) S.a_ready(nxt);
            if constexpr (SP2) {
            PG8_LDB(B0, 0, 0); PG8_LDB(B1, 0, 1); PG8_SCHED; PG8_LDA(At, 0, 0); PG8_STAGE(PG8_SA(1, 1), a1 + hstep, voffA);
            PG8_WAIT_V(8); PG8_WAIT_L(0); PG8_BAR; PG8_MMA(0, 0, At, B0); PG8_MMA(0, 1, At, B1); PG8_BAR; PG8_SCHED;
            PG8_LDA(At, 0, 1); PG8_STAGE(PG8_SB(0, 0), b2, voffB); PG8_STAGE(PG8_SB(0, 1), b2 + hstep, voffB); PG8_STAGE(PG8_SA(0, 0), a2, voffA);
            PG8_WAIT_V(8); PG8_WAIT_L(0); PG8_BAR; PG8_MMA(1, 0, At, B0); PG8_MMA(1, 1, At, B1); PG8_BAR; PG8_SCHED;
            PG8_LDB(B0, 1, 0); PG8_LDB(B1, 1, 1); PG8_SCHED; PG8_LDA(At, 1, 0); PG8_STAGE(PG8_SA(0, 1), a2 + hstep, voffA);
            PG8_WAIT_V(8); PG8_WAIT_L(0); PG8_BAR; PG8_MMA(0, 0, At, B0); PG8_MMA(0, 1, At, B1); PG8_BAR; PG8_SCHED;
            PG8_LDA(At, 1, 1); PG8_STAGE(PG8_SB(1, 0), b3, voffB); PG8_STAGE(PG8_SB(1, 1), b3 + hstep, voffB); PG8_STAGE(PG8_SA(1, 0), a3, voffA);
            PG8_WAIT_V(8); PG8_WAIT_L(0); PG8_BAR; PG8_MMA(1, 0, At, B0); PG8_MMA(1, 1, At, B1); PG8_BAR; PG8_SCHED;
            } else {
            PG8_LDB(B0, 0, 0); PG8_SCHED; PG8_LDA(At, 0, 0); PG8_STAGE(PG8_SA(1, 1), a1 + hstep, voffA);
            PG8_WAIT_L(8); PG8_BAR; PG8_WAIT_L(0); PG8_MMA(0, 0, At, B0); PG8_BAR; PG8_SCHED;
            PG8_LDB(B1, 0, 1); PG8_STAGE(PG8_SB(0, 0), b2, voffB);
            PG8_BAR; PG8_WAIT_L(0); PG8_MMA(0, 1, At, B1); PG8_BAR;
            PG8_LDA(At, 0, 1); PG8_STAGE(PG8_SA(0, 0), a2, voffA);
            PG8_BAR; PG8_WAIT_L(0); PG8_MMA(1, 0, At, B0); PG8_BAR; PG8_SCHED;
            PG8_STAGE(PG8_SB(0, 1), b2 + hstep, voffB);
            PG8_WAIT_V(6); PG8_BAR; PG8_MMA(1, 1, At, B1); PG8_BAR;
            PG8_LDB(B0, 1, 0); PG8_SCHED; PG8_LDA(At, 1, 0); PG8_STAGE(PG8_SA(0, 1), a2 + hstep, voffA);
            PG8_WAIT_L(8); PG8_BAR; PG8_WAIT_L(0); PG8_MMA(0, 0, At, B0); PG8_BAR; PG8_SCHED;
            PG8_LDB(B1, 1, 1); PG8_STAGE(PG8_SB(1, 0), b3, voffB);
            PG8_BAR; PG8_WAIT_L(0); PG8_MMA(0, 1, At, B1); PG8_BAR;
            PG8_LDA(At, 1, 1); PG8_STAGE(PG8_SA(1, 0), a3, voffA);
            PG8_BAR; PG8_WAIT_L(0); PG8_MMA(1, 0, At, B0); PG8_BAR; PG8_SCHED;
            PG8_STAGE(PG8_SB(1, 1), b3 + hstep, voffB);
            PG8_WAIT_V(6); PG8_BAR; PG8_MMA(1, 1, At, B1); PG8_BAR;
            }
        }
        if constexpr (ALIGN_EPI) { if (wr == 0) PG8_BAR; }
        if constexpr (!Epi::AFTER_DRAIN) { E(acc, cur, wr, wc, fr, fq); S.done(cur); }
        if (!has_next) break;
#pragma unroll
        for (int a = 0; a < 2; ++a)
#pragma unroll
            for (int b = 0; b < 2; ++b)
#pragma unroll
                for (int m = 0; m < 4; ++m)
#pragma unroll
                    for (int n = 0; n < 2; ++n) acc[a][b][m][n] = (f32x4){0.f, 0.f, 0.f, 0.f};
        cur = nxt; cA = nA; cB = nB; ++ui;
        if constexpr (ALIGN_EPI) { if (wr == 1) PG8_BAR; }
    }
    PG8_WAIT_V(0);
    if constexpr (!ALIGN_EPI) { if (wr == 0) PG8_BAR; }
    PG8_BAR;
    if constexpr (Epi::AFTER_DRAIN) { E.fused(acc, cur, wr, wc, fr, fq, lds, wid, lane); S.done(cur); }
#undef PG8_SA
#undef PG8_SB
#undef PG8_STAGE
#undef PG8_LDA
#undef PG8_LDB
#undef PG8_MMA
#undef PG8_WAIT_V
#undef PG8_WAIT_L
#undef PG8_BAR
#undef PG8_SCHED
}
}

namespace da {
using bf16 = unsigned short;
constexpr int   D = 128, NW = 8, QBLK = 32, KVBLK = 64;
constexpr float SCALE = 0.088388347648318440f;
constexpr float THR = 8.f;
constexpr size_t SHM_V = KVBLK * D * 2, SHM_K = KVBLK * D * 2, SHM_ATTN = 2 * SHM_V + 2 * SHM_K + NW * 64 * 4;
using bf16x8 = __attribute__((ext_vector_type(8))) short;
using s16x4  = __attribute__((ext_vector_type(4))) short;
using f32x16 = __attribute__((ext_vector_type(16))) float;
using u32x4  = __attribute__((ext_vector_type(4))) unsigned;
using f32x4v = __attribute__((ext_vector_type(4))) float;
#define KSWZ(row, colB) ((row) * 256 + ((colB) ^ (((row) & 7) << 4)))
#define SBAR() __builtin_amdgcn_sched_barrier(0)
__device__ __forceinline__ int crow(int r, int hi) { return (r & 3) + 8 * (r >> 2) + 4 * hi; }
__device__ __forceinline__ unsigned cvtpk(float lo, float hi) {
  unsigned r; asm volatile("v_cvt_pk_bf16_f32 %0, %1, %2" : "=v"(r) : "v"(lo), "v"(hi)); return r;
}
__device__ __forceinline__ bf16x8 ld8(const bf16* p) { return *reinterpret_cast<const bf16x8*>(p); }

__device__ __forceinline__ void partialSM(f32x16& p0, f32x16& p1, float& m_reg, float& mn, float& alpha) {
  constexpr float C = SCALE * 1.4426950408889634f;
  float pmax = p0[0]; for (int r = 1; r < 16; ++r) pmax = fmaxf(pmax, p0[r]); for (int r = 0; r < 16; ++r) pmax = fmaxf(pmax, p1[r]);
  { auto rr = __builtin_amdgcn_permlane32_swap(__float_as_uint(pmax), __float_as_uint(pmax), false, false);
    pmax = fmaxf(__uint_as_float(rr[0]), __uint_as_float(rr[1])); }
  if (__builtin_expect(__all(pmax - m_reg <= THR / SCALE), 1)) { mn = m_reg; alpha = 1.f; }
  else { mn = fmaxf(m_reg, pmax); alpha = __builtin_amdgcn_exp2f((m_reg - mn) * C); m_reg = mn; }
  float mnC = -mn * C;
  for (int r = 0; r < 16; ++r) p0[r] = fmaf(p0[r], C, mnC); for (int r = 0; r < 16; ++r) p1[r] = fmaf(p1[r], C, mnC);
  for (int r = 0; r < 16; ++r) p0[r] = __builtin_amdgcn_exp2f(p0[r]);
}
#define PK4(P, BASE, OUT) do { unsigned a0 = cvtpk(P[BASE + 0], P[BASE + 1]), a1 = cvtpk(P[BASE + 2], P[BASE + 3]);   \
    unsigned b0 = cvtpk(P[BASE + 4], P[BASE + 5]), b1 = cvtpk(P[BASE + 6], P[BASE + 7]);                              \
    auto r0 = __builtin_amdgcn_permlane32_swap(a0, b0, false, false); auto r1 = __builtin_amdgcn_permlane32_swap(a1, b1, false, false); \
    u32x4 w = {r0[0], r1[0], r0[1], r1[1]}; OUT = *reinterpret_cast<bf16x8*>(&w); } while (0)
__device__ __forceinline__ void finishSM(f32x16& p0, f32x16& p1, float alpha, float& l_reg, bf16x8& pa0, bf16x8& pa1, bf16x8& pa2, bf16x8& pa3) {
  for (int r = 0; r < 16; ++r) p1[r] = __builtin_amdgcn_exp2f(p1[r]);
  float ps = 0; for (int r = 0; r < 16; ++r) ps += p0[r]; for (int r = 0; r < 16; ++r) ps += p1[r];
  { auto rr = __builtin_amdgcn_permlane32_swap(__float_as_uint(ps), __float_as_uint(ps), false, false);
    ps = __uint_as_float(rr[0]) + __uint_as_float(rr[1]); }
  l_reg = l_reg * alpha + ps;
  PK4(p0, 0, pa0); PK4(p0, 8, pa1); PK4(p1, 0, pa2); PK4(p1, 8, pa3);
}
__device__ __forceinline__ void qkt(f32x16& p0, f32x16& p1, const bf16* Ks, const bf16x8* qr, int r32, int hi) {
  p0 = f32x16{}; p1 = f32x16{};
  for (int d0 = 0; d0 < 8; ++d0) { int cb = (d0 * 16 + hi * 8) * 2;
    bf16x8 b0 = *reinterpret_cast<const bf16x8*>((const char*)Ks + KSWZ(r32, cb));
    bf16x8 b1 = *reinterpret_cast<const bf16x8*>((const char*)Ks + KSWZ(32 + r32, cb));
    p0 = __builtin_amdgcn_mfma_f32_32x32x16_bf16(b0, qr[d0], p0, 0, 0, 0);
    p1 = __builtin_amdgcn_mfma_f32_32x32x16_bf16(b1, qr[d0], p1, 0, 0, 0); }
}
constexpr float CQ = SCALE * 1.4426950408889634f, THR2 = THR * 1.4426950408889634f;
__device__ __forceinline__ void qkt_n(f32x16& p0, f32x16& p1, const bf16* Ks, const bf16x8* qr, const f32x16& negm, int r32, int hi) {
  { const int cb = (hi * 8) * 2;
    bf16x8 b0 = *reinterpret_cast<const bf16x8*>((const char*)Ks + KSWZ(r32, cb));
    bf16x8 b1 = *reinterpret_cast<const bf16x8*>((const char*)Ks + KSWZ(32 + r32, cb));
    p0 = __builtin_amdgcn_mfma_f32_32x32x16_bf16(b0, qr[0], negm, 0, 0, 0);
    p1 = __builtin_amdgcn_mfma_f32_32x32x16_bf16(b1, qr[0], negm, 0, 0, 0); }
  for (int d0 = 1; d0 < 8; ++d0) { int cb = (d0 * 16 + hi * 8) * 2;
    bf16x8 b0 = *reinterpret_cast<const bf16x8*>((const char*)Ks + KSWZ(r32, cb));
    bf16x8 b1 = *reinterpret_cast<const bf16x8*>((const char*)Ks + KSWZ(32 + r32, cb));
    p0 = __builtin_amdgcn_mfma_f32_32x32x16_bf16(b0, qr[d0], p0, 0, 0, 0);
    p1 = __builtin_amdgcn_mfma_f32_32x32x16_bf16(b1, qr[d0], p1, 0, 0, 0); }
}
__device__ __forceinline__ void partialSM_b(f32x16& p0, float& alpha) { alpha = 1.f; for (int r = 0; r < 16; ++r) p0[r] = __builtin_amdgcn_exp2f(p0[r]); }
template <bool FIRST>
__device__ __forceinline__ void partialSM_n(f32x16& p0, f32x16& p1, float& mhat, f32x16& negm, float& alpha) {
  float pmax = p0[0]; for (int r = 1; r < 16; ++r) pmax = fmaxf(pmax, p0[r]); for (int r = 0; r < 16; ++r) pmax = fmaxf(pmax, p1[r]);
  { auto rr = __builtin_amdgcn_permlane32_swap(__float_as_uint(pmax), __float_as_uint(pmax), false, false);
    pmax = fmaxf(__uint_as_float(rr[0]), __uint_as_float(rr[1])); }
  alpha = 1.f;
  if (FIRST || !__builtin_expect(__all(pmax <= THR2), 1)) {
    const float dl = FIRST ? pmax : fmaxf(pmax, 0.f); mhat += dl;
    for (int r = 0; r < 16; ++r) { p0[r] -= dl; p1[r] -= dl; }
    for (int r = 0; r < 16; ++r) negm[r] = -mhat;
    asm volatile("" : "+v"(negm));
    if (!FIRST) alpha = __builtin_amdgcn_exp2f(-dl);
  }
  for (int r = 0; r < 16; ++r) p0[r] = __builtin_amdgcn_exp2f(p0[r]);
}
__device__ __forceinline__ void decide_n(f32x16& p0, f32x16& p1, float& mhat, f32x16& negm, float& alpha) {
  float pmax = p0[0]; for (int r = 1; r < 16; ++r) pmax = fmaxf(pmax, p0[r]); for (int r = 0; r < 16; ++r) pmax = fmaxf(pmax, p1[r]);
  { auto rr = __builtin_amdgcn_permlane32_swap(__float_as_uint(pmax), __float_as_uint(pmax), false, false);
    pmax = fmaxf(__uint_as_float(rr[0]), __uint_as_float(rr[1])); }
  alpha = 1.f;
  if (!__builtin_expect(__all(pmax <= THR2), 1)) {
    const float dl = fmaxf(pmax, 0.f); mhat += dl;
    for (int r = 0; r < 16; ++r) { p0[r] -= dl; p1[r] -= dl; }
    for (int r = 0; r < 16; ++r) negm[r] = -mhat;
    asm volatile("" : "+v"(negm));
    alpha = __builtin_amdgcn_exp2f(-dl);
  }
}
typedef __attribute__((address_space(3))) const char* lds_cp;
typedef short v4i16_t __attribute__((ext_vector_type(4)));
__device__ __forceinline__ s16x4 vtr(lds_cp p) { return __builtin_bit_cast(s16x4, __builtin_amdgcn_ds_read_tr16_b64_v4i16((__attribute__((address_space(3))) v4i16_t*)p)); }
__device__ __forceinline__ int v_st(int k, int c) { const int kk = (k & ~0xC) | ((k & 4) << 1) | ((k & 8) >> 1); return ((kk >> 3) * 4 + (c >> 5)) * 512 + ((kk & 7) * 32 + (c & 31)) * 2; }
__device__ __forceinline__ int v_rd_base(int lane) { return ((lane & 3) << 3) | (((lane >> 2) & 3) << 6) | (((lane >> 4) & 1) << 5) | (((lane >> 5) & 1) << 8); }
constexpr int v_rd_off(int d0, int ks, int half) { return d0 * 512 + ks * 4096 + half * 2048; }
template <int OFF> __device__ __forceinline__ s16x4 tr_read(int vb) {
  s16x4 r; asm volatile("ds_read_b64_tr_b16 %0, %1 offset:%2" : "=&v"(r) : "v"(vb), "i"(OFF) : "memory"); return r;
}
template <int D0> __device__ __forceinline__ void pv_one(f32x16& od, int vb, bf16x8 pa0, bf16x8 pa1, bf16x8 pa2, bf16x8 pa3) {
  const s16x4 l0 = tr_read<v_rd_off(D0, 0, 0)>(vb), h0 = tr_read<v_rd_off(D0, 0, 1)>(vb), l1 = tr_read<v_rd_off(D0, 1, 0)>(vb), h1 = tr_read<v_rd_off(D0, 1, 1)>(vb);
  const s16x4 l2 = tr_read<v_rd_off(D0, 2, 0)>(vb), h2 = tr_read<v_rd_off(D0, 2, 1)>(vb), l3 = tr_read<v_rd_off(D0, 3, 0)>(vb), h3 = tr_read<v_rd_off(D0, 3, 1)>(vb);
  asm volatile("s_waitcnt lgkmcnt(0)" ::: "memory"); SBAR();
#define PK(L, H) (bf16x8){L[0], L[1], L[2], L[3], H[0], H[1], H[2], H[3]}
  od = __builtin_amdgcn_mfma_f32_32x32x16_bf16(pa0, PK(l0, h0), od, 0, 0, 0);
  od = __builtin_amdgcn_mfma_f32_32x32x16_bf16(pa1, PK(l1, h1), od, 0, 0, 0);
  od = __builtin_amdgcn_mfma_f32_32x32x16_bf16(pa2, PK(l2, h2), od, 0, 0, 0);
  od = __builtin_amdgcn_mfma_f32_32x32x16_bf16(pa3, PK(l3, h3), od, 0, 0, 0);
#undef PK
}
__device__ __forceinline__ void pv_d0(f32x16* o, int vb, bf16x8 pa0, bf16x8 pa1, bf16x8 pa2, bf16x8 pa3) {
  pv_one<0>(o[0], vb, pa0, pa1, pa2, pa3); pv_one<1>(o[1], vb, pa0, pa1, pa2, pa3); pv_one<2>(o[2], vb, pa0, pa1, pa2, pa3); pv_one<3>(o[3], vb, pa0, pa1, pa2, pa3);
}

__device__ __forceinline__ bf16x8 pack8(const f32x16& p, int base) {
  u32x4 w = {cvtpk(p[base + 0], p[base + 1]), cvtpk(p[base + 2], p[base + 3]), cvtpk(p[base + 4], p[base + 5]), cvtpk(p[base + 6], p[base + 7])}; return *reinterpret_cast<bf16x8*>(&w); }
__device__ __forceinline__ void finishSM_ot(f32x16& p0, f32x16& p1, float alpha, float& l_reg, bf16x8& pa0, bf16x8& pa1, bf16x8& pa2, bf16x8& pa3) {
  for (int r = 0; r < 16; ++r) p1[r] = __builtin_amdgcn_exp2f(p1[r]);
  float ps = 0; for (int r = 0; r < 16; ++r) ps += p0[r]; for (int r = 0; r < 16; ++r) ps += p1[r];
  { auto rr = __builtin_amdgcn_permlane32_swap(__float_as_uint(ps), __float_as_uint(ps), false, false);
    ps = __uint_as_float(rr[0]) + __uint_as_float(rr[1]); }
  l_reg = l_reg * alpha + ps;
  pa0 = pack8(p0, 0); pa1 = pack8(p0, 8); pa2 = pack8(p1, 0); pa3 = pack8(p1, 8);
}
template <int D0> __device__ __forceinline__ void pv_one_ot(f32x16& od, int vb, bf16x8 pa0, bf16x8 pa1, bf16x8 pa2, bf16x8 pa3) {
  const s16x4 l0 = tr_read<v_rd_off(D0, 0, 0)>(vb), h0 = tr_read<v_rd_off(D0, 0, 1)>(vb), l1 = tr_read<v_rd_off(D0, 1, 0)>(vb), h1 = tr_read<v_rd_off(D0, 1, 1)>(vb);
  const s16x4 l2 = tr_read<v_rd_off(D0, 2, 0)>(vb), h2 = tr_read<v_rd_off(D0, 2, 1)>(vb), l3 = tr_read<v_rd_off(D0, 3, 0)>(vb), h3 = tr_read<v_rd_off(D0, 3, 1)>(vb);
  asm volatile("s_waitcnt lgkmcnt(0)" ::: "memory"); SBAR();
#define PK(L, H) (bf16x8){L[0], L[1], L[2], L[3], H[0], H[1], H[2], H[3]}
  od = __builtin_amdgcn_mfma_f32_32x32x16_bf16(PK(l0, h0), pa0, od, 0, 0, 0);
  od = __builtin_amdgcn_mfma_f32_32x32x16_bf16(PK(l1, h1), pa1, od, 0, 0, 0);
  od = __builtin_amdgcn_mfma_f32_32x32x16_bf16(PK(l2, h2), pa2, od, 0, 0, 0);
  od = __builtin_amdgcn_mfma_f32_32x32x16_bf16(PK(l3, h3), pa3, od, 0, 0, 0);
#undef PK
}
__device__ __forceinline__ void pv_ot(f32x16* o, int vb, bf16x8 pa0, bf16x8 pa1, bf16x8 pa2, bf16x8 pa3) {
  pv_one_ot<0>(o[0], vb, pa0, pa1, pa2, pa3); pv_one_ot<1>(o[1], vb, pa0, pa1, pa2, pa3); pv_one_ot<2>(o[2], vb, pa0, pa1, pa2, pa3); pv_one_ot<3>(o[3], vb, pa0, pa1, pa2, pa3);
}
constexpr int ASLOT = 16384, RING_ATTN = 6 * ASLOT + NW * 64 * 4;
#define AWAIT_BAR(N) asm volatile("s_waitcnt vmcnt(" #N ") lgkmcnt(0)\n\ts_barrier" ::: "memory")
template <int LDQ, int LDK, int LDO, bool QN, bool BND = false, bool HS = false>
__device__ __forceinline__ void attn_dense_body(const bf16* Qb, const bf16* __restrict__ Kh, const bf16* __restrict__ Vh, bf16* Ob, int seq, char* lds,
                                                __attribute__((address_space(3))) unsigned char* ldsl, const int wave_s, const float* qg = nullptr, const float* axt = nullptr, int tok0 = 0, float bnd = 0.f) {
  constexpr bool OT = HS;
  int lane; asm volatile("v_mbcnt_lo_u32_b32 %0, -1, 0\n\tv_mbcnt_hi_u32_b32 %0, -1, %0" : "=v"(lane));
  const int wid = wave_s, r32 = lane & 31, hi = lane >> 5;
  char* K_lds = lds; char* V_lds = lds + 3 * ASLOT;
  float* ws = (float*)(lds + 6 * ASLOT) + wid * 64; float* li_l = ws; float* al_l = ws + 32;
  float mhat = 0.f, l_reg = 0; f32x16 o[4] = {}; bf16x8 qr[8]; f32x16 negm;
  unsigned ksrc[2], vsrc[2];
#pragma unroll
  for (int i = 0; i < 2; ++i) { const int p = 2 * wid + i;
    const int krow = 4 * p + (lane >> 4), kch = (lane & 15) ^ (krow & 7); ksrc[i] = (unsigned)(krow * LDK + kch * 8) * 2u;
    const int sub = 2 * p + (lane >> 5), kk = ((sub >> 2) << 3) | ((lane & 31) >> 2), key = OT ? kk : ((kk & ~0xC) | ((kk & 4) << 1) | ((kk & 8) >> 1)), vc = ((sub & 3) << 5) | ((lane & 3) << 3);
    vsrc[i] = (unsigned)(key * LDK + vc) * 2u; }
#define DMA_K1(t, sl, i_) __builtin_amdgcn_global_load_lds((const unsigned*)((const char*)Kh + (ksrc[i_] + (unsigned)(t) * (unsigned)(KVBLK * LDK * 2))), (__attribute__((address_space(3))) unsigned*)(ldsl + (sl) + (2 * wid + (i_)) * 1024), 16, 0, 0)
#define DMA_V1(t, sl, i_) __builtin_amdgcn_global_load_lds((const unsigned*)((const char*)Vh + (vsrc[i_] + (unsigned)(t) * (unsigned)(KVBLK * LDK * 2))), (__attribute__((address_space(3))) unsigned*)(ldsl + 3 * ASLOT + (sl) + (2 * wid + (i_)) * 1024), 16, 0, 0)
#define DMA_K(t, sl) do { DMA_K1(t, sl, 0); DMA_K1(t, sl, 1); } while (0)
#define DMA_V(t, sl) do { DMA_V1(t, sl, 0); DMA_V1(t, sl, 1); } while (0)
  const int NT = seq / KVBLK;
  DMA_K(0, 0); DMA_V(0, 0); DMA_K(1, ASLOT);
  const bf16* Qw = Qb + (long)(wid * QBLK + r32) * LDQ + hi * 8;
#pragma unroll
  for (int d0 = 0; d0 < 8; ++d0) qr[d0] = ld8(Qw + d0 * 16);
  if constexpr (QN) {
    const int t = tok0 + wid * QBLK + r32, prow = t >> 6, pcol = t & 63;
    float x[8][8]; float ss = 0.f;
#pragma unroll
    for (int d0 = 0; d0 < 8; ++d0)
#pragma unroll
      for (int e = 0; e < 8; ++e) { x[d0][e] = __builtin_bit_cast(float, (unsigned)(unsigned short)qr[d0][e] << 16); ss += x[d0][e] * x[d0][e]; }
    { auto rr = __builtin_amdgcn_permlane32_swap(__float_as_uint(ss), __float_as_uint(ss), false, false); ss = __uint_as_float(rr[0]) + __uint_as_float(rr[1]); }
    const float rstd = CQ / sqrtf(ss * (1.f / 128.f) + 1e-6f);
#pragma unroll
    for (int d0 = 0; d0 < 8; ++d0) { const float* gp = qg + d0 * 16 + hi * 8; const f32x4v g0 = *(const f32x4v*)gp, g1 = *(const f32x4v*)(gp + 4);
#pragma unroll
      for (int e = 0; e < 8; ++e) x[d0][e] *= rstd * (e < 4 ? g0[e] : g1[e - 4]); }
#pragma unroll
    for (int half = 0; half < 2; ++half) { const float* ct = half == 0 ? axt + prow * 32 : axt + 16384 + pcol * 32; const float* st = ct + (half == 0 ? 8192 : 2048);
#pragma unroll
      for (int dd = 0; dd < 2; ++dd) { const int ix = dd * 16 + hi * 8;
        const f32x4v c0 = *(const f32x4v*)(ct + ix), c1 = *(const f32x4v*)(ct + ix + 4), s0 = *(const f32x4v*)(st + ix), s1 = *(const f32x4v*)(st + ix + 4);
#pragma unroll
        for (int e = 0; e < 8; ++e) { const float c = e < 4 ? c0[e] : c1[e - 4], sn = e < 4 ? s0[e] : s1[e - 4];
          const float a = x[half * 4 + dd][e], b = x[half * 4 + 2 + dd][e]; x[half * 4 + dd][e] = a * c - b * sn; x[half * 4 + 2 + dd][e] = b * c + a * sn; } } }
#pragma unroll
    for (int d0 = 0; d0 < 8; ++d0) { u32x4 w = {cvtpk(x[d0][0], x[d0][1]), cvtpk(x[d0][2], x[d0][3]), cvtpk(x[d0][4], x[d0][5]), cvtpk(x[d0][6], x[d0][7])}; qr[d0] = *reinterpret_cast<bf16x8*>(&w); }
  }
  if constexpr (!QN) {
#pragma unroll
    for (int d0 = 0; d0 < 8; ++d0) { float x[8];
#pragma unroll
      for (int e = 0; e < 8; ++e) x[e] = __builtin_bit_cast(float, (unsigned)(unsigned short)qr[d0][e] << 16) * CQ;
      u32x4 w = {cvtpk(x[0], x[1]), cvtpk(x[2], x[3]), cvtpk(x[4], x[5]), cvtpk(x[6], x[7])}; qr[d0] = *reinterpret_cast<bf16x8*>(&w); }
  }
  const bool onl = !BND || !(bnd <= 60.f);
  { float nb = (BND && !onl) ? -bnd : 0.f; asm volatile("" : "+v"(nb));
    for (int r = 0; r < 16; ++r) negm[r] = nb; asm volatile("" : "+v"(negm)); }
  const int vb0 = (int)(uintptr_t)V_lds + v_rd_base(lane);
#define RESC(a) do { if ((!BND || onl) && __any((a) < 1.f)) { if constexpr (OT) { for (int d = 0; d < 4; ++d) for (int r = 0; r < 16; ++r) o[d][r] *= (a); } else { \
    if (hi == 0) al_l[r32] = (a); asm volatile("s_waitcnt lgkmcnt(0)" ::: "memory"); \
    for (int d = 0; d < 4; ++d) for (int r = 0; r < 16; ++r) o[d][r] *= al_l[crow(r, hi)]; } } } while (0)
  f32x16 pA0, pA1, pB0, pB1; float alA, alB; bf16x8 pa0, pa1, pa2, pa3;
  int s0 = 2 * ASLOT, s1 = 0, s2 = ASLOT;
#define ROT() do { const int t_ = s0; s0 = s1; s1 = s2; s2 = t_; } while (0)
  AWAIT_BAR(0);
  if (wid >= 4) __builtin_amdgcn_s_setprio(1);
  DMA_K(2, s0); DMA_V(1, s2);
  qkt_n(pA0, pA1, (const bf16*)(K_lds + s1), qr, negm, r32, hi); if (BND && !onl) partialSM_b(pA0, alA); else partialSM_n<true>(pA0, pA1, mhat, negm, alA);
  AWAIT_BAR(4); ROT();
  if constexpr (HS) {
    const lds_cp kb_l = (lds_cp)ldsl + r32 * 256, vb_l = (lds_cp)ldsl + 3 * ASLOT + v_rd_base(lane);
    const int ksw = (r32 & 7) << 4, khi = hi * 16;
    bf16x8 kf[3][2]; s16x4 vl[4], vh[4];
#define H_KRD(kp, i) do { const unsigned a_ = (unsigned)(uintptr_t)(kp) + (unsigned)((((i) * 32 + khi) ^ ksw)); \
      asm volatile("ds_read_b128 %0, %2\n\tds_read_b128 %1, %2 offset:8192" : "=&v"(kf[(i) % 3][0]), "=&v"(kf[(i) % 3][1]) : "v"(a_) : "memory"); } while (0)
#define H_KWAIT(N, i) asm volatile("s_waitcnt lgkmcnt(" #N ")" : "+v"(kf[(i) % 3][0]), "+v"(kf[(i) % 3][1]) :: "memory")
#define H_VRD(vp, j) do { const unsigned a_ = (unsigned)(uintptr_t)(vp); \
      asm volatile("ds_read_b64_tr_b16 %0, %2 offset:%3\n\tds_read_b64_tr_b16 %1, %2 offset:%4" : "=&v"(vl[(j) & 3]), "=&v"(vh[(j) & 3]) : "v"(a_), "i"(v_rd_off((j) >> 2, (j) & 3, 0)), "i"(v_rd_off((j) >> 2, (j) & 3, 1)) : "memory"); } while (0)
#define H_VWAIT(N, j) asm volatile("s_waitcnt lgkmcnt(" #N ")" : "+v"(vl[(j) & 3]), "+v"(vh[(j) & 3]) :: "memory")
#define H_PIN(x) asm volatile("" : "+v"(x))
#define H_VF(j) (bf16x8){vl[(j) & 3][0], vl[(j) & 3][1], vl[(j) & 3][2], vl[(j) & 3][3], vh[(j) & 3][0], vh[(j) & 3][1], vh[(j) & 3][2], vh[(j) & 3][3]}
#define H_PA(j) (((j) & 3) == 0 ? pa0 : ((j) & 3) == 1 ? pa1 : ((j) & 3) == 2 ? pa2 : pa3)
#define H_GA(i, C0, C1, P0, P1, kp) do { \
      if (((i) & 1) == 0 && ((i) >> 1) + 2 < 8) H_KRD(kp, ((i) >> 1) + 2); \
      if (((i) & 1) == 0) { if ((i) < 12) H_KWAIT(4, (i) >> 1); else if ((i) == 12) H_KWAIT(2, 6); else H_KWAIT(0, 7); } \
      if ((i) == 8) DMA_K1(tkk, s0, 0); else if ((i) == 10) DMA_K1(tkk, s0, 1); else if ((i) == 12) DMA_V1(tvv, s2, 0); else if ((i) == 14) DMA_V1(tvv, s2, 1); \
      if (((i) & 1) == 0) C0 = __builtin_amdgcn_mfma_f32_32x32x16_bf16(kf[((i) >> 1) % 3][0], qr[(i) >> 1], (i) < 2 ? negm : C0, 0, 0, 0); \
      else C1 = __builtin_amdgcn_mfma_f32_32x32x16_bf16(kf[((i) >> 1) % 3][1], qr[(i) >> 1], (i) < 2 ? negm : C1, 0, 0, 0); \
      if ((i) < 8) { P1[2 * (i)] = __builtin_amdgcn_exp2f(P1[2 * (i)]); P1[2 * (i) + 1] = __builtin_amdgcn_exp2f(P1[2 * (i) + 1]); sacc += P0[2 * (i)]; sacc += P0[2 * (i) + 1]; H_PIN(P1); H_PIN(sacc); } \
      else { sacc += P1[2 * ((i) - 8)]; sacc += P1[2 * ((i) - 8) + 1]; H_PIN(sacc); \
        if (((i) & 1) == 0) { if ((i) < 12) { ca0 = cvtpk(P0[((i) - 8) * 4 + 0], P0[((i) - 8) * 4 + 1]); ca1 = cvtpk(P0[((i) - 8) * 4 + 2], P0[((i) - 8) * 4 + 3]); } \
                              else { ca0 = cvtpk(P1[((i) - 12) * 4 + 0], P1[((i) - 12) * 4 + 1]); ca1 = cvtpk(P1[((i) - 12) * 4 + 2], P1[((i) - 12) * 4 + 3]); } H_PIN(ca0); H_PIN(ca1); } \
        else { unsigned cb0, cb1; if ((i) < 12) { cb0 = cvtpk(P0[((i) - 9) * 4 + 4], P0[((i) - 9) * 4 + 5]); cb1 = cvtpk(P0[((i) - 9) * 4 + 6], P0[((i) - 9) * 4 + 7]); } \
                              else { cb0 = cvtpk(P1[((i) - 13) * 4 + 4], P1[((i) - 13) * 4 + 5]); cb1 = cvtpk(P1[((i) - 13) * 4 + 6], P1[((i) - 13) * 4 + 7]); } \
          u32x4 w_ = {ca0, ca1, cb0, cb1};     \
          if ((i) == 9) { pa0 = *reinterpret_cast<bf16x8*>(&w_); H_PIN(pa0); } else if ((i) == 11) { pa1 = *reinterpret_cast<bf16x8*>(&w_); H_PIN(pa1); } \
          else if ((i) == 13) { pa2 = *reinterpret_cast<bf16x8*>(&w_); H_PIN(pa2); } else { pa3 = *reinterpret_cast<bf16x8*>(&w_); H_PIN(pa3); } } } \
      SBAR(); } while (0)
#define H_GB(j, C0, vp) do { if ((j) + 3 < 16) H_VRD(vp, (j) + 3); \
      if ((j) < 13) H_VWAIT(6, j); else if ((j) == 13) H_VWAIT(4, 13); else if ((j) == 14) H_VWAIT(2, 14); else H_VWAIT(0, 15); \
      o[(j) >> 2] = __builtin_amdgcn_mfma_f32_32x32x16_bf16(H_VF(j), H_PA(j), o[(j) >> 2], 0, 0, 0);     \
      C0[j] = __builtin_amdgcn_exp2f(C0[j]); H_PIN(C0); SBAR(); } while (0)
#define H_STEP(C0, C1, P0, P1, alP, alC, tk_, tv_) do { \
      const lds_cp kp_ = kb_l + s1, vp_ = vb_l + s0; float sacc = 0.f; unsigned ca0 = 0, ca1 = 0; const int tkk = (tk_), tvv = (tv_); \
      SBAR(); H_KRD(kp_, 0); H_KRD(kp_, 1); SBAR(); \
      H_GA(0, C0, C1, P0, P1, kp_); H_GA(1, C0, C1, P0, P1, kp_); H_GA(2, C0, C1, P0, P1, kp_); H_GA(3, C0, C1, P0, P1, kp_); \
      H_GA(4, C0, C1, P0, P1, kp_); H_GA(5, C0, C1, P0, P1, kp_); H_GA(6, C0, C1, P0, P1, kp_); H_GA(7, C0, C1, P0, P1, kp_); \
      H_GA(8, C0, C1, P0, P1, kp_); H_GA(9, C0, C1, P0, P1, kp_); H_GA(10, C0, C1, P0, P1, kp_); H_GA(11, C0, C1, P0, P1, kp_); \
      H_GA(12, C0, C1, P0, P1, kp_); H_GA(13, C0, C1, P0, P1, kp_); H_GA(14, C0, C1, P0, P1, kp_); H_GA(15, C0, C1, P0, P1, kp_); \
      { auto rr_ = __builtin_amdgcn_permlane32_swap(__float_as_uint(sacc), __float_as_uint(sacc), false, false); l_reg = l_reg * (alP) + (__uint_as_float(rr_[0]) + __uint_as_float(rr_[1])); } \
      if (onl) decide_n(C0, C1, mhat, negm, alC); else alC = 1.f; \
      H_VRD(vp_, 0); H_VRD(vp_, 1); H_VRD(vp_, 2); SBAR(); \
      H_GB(0, C0, vp_); H_GB(1, C0, vp_); H_GB(2, C0, vp_); H_GB(3, C0, vp_); H_GB(4, C0, vp_); H_GB(5, C0, vp_); H_GB(6, C0, vp_); H_GB(7, C0, vp_); \
      H_GB(8, C0, vp_); H_GB(9, C0, vp_); H_GB(10, C0, vp_); H_GB(11, C0, vp_); H_GB(12, C0, vp_); H_GB(13, C0, vp_); H_GB(14, C0, vp_); H_GB(15, C0, vp_); \
    } while (0)
    for (int j = 1; j + 1 < NT; j += 2) {
      { const int tk = j + 2 < NT ? j + 2 : NT - 1, tv = j + 1;
      H_STEP(pB0, pB1, pA0, pA1, alA, alB, tk, tv); }
      RESC(alB); AWAIT_BAR(4); ROT();
      { const int tk = j + 3 < NT ? j + 3 : NT - 1, tv = j + 2 < NT ? j + 2 : NT - 1;
      H_STEP(pA0, pA1, pB0, pB1, alB, alA, tk, tv); }
      RESC(alA); AWAIT_BAR(4); ROT();
    }
#undef H_KRD
#undef H_VRD
#undef H_KWAIT
#undef H_VWAIT
#undef H_PIN
#undef H_VF
#undef H_PA
#undef H_GA
#undef H_GB
#undef H_STEP
  } else {
  for (int j = 1; j + 1 < NT; j += 2) {
    { const int tk = j + 2 < NT ? j + 2 : NT - 1, tv = j + 1; DMA_K(tk, s0); DMA_V(tv, s2); }
    SBAR(); qkt_n(pB0, pB1, (const bf16*)(K_lds + s1), qr, negm, r32, hi);
    finishSM(pA0, pA1, alA, l_reg, pa0, pa1, pa2, pa3); SBAR();
    pv_d0(o, vb0 + s0, pa0, pa1, pa2, pa3); if (BND && !onl) partialSM_b(pB0, alB); else partialSM_n<false>(pB0, pB1, mhat, negm, alB);
    RESC(alB); AWAIT_BAR(4); ROT();
    { const int tk = j + 3 < NT ? j + 3 : NT - 1, tv = j + 2 < NT ? j + 2 : NT - 1; DMA_K(tk, s0); DMA_V(tv, s2); }
    SBAR(); qkt_n(pA0, pA1, (const bf16*)(K_lds + s1), qr, negm, r32, hi);
    finishSM(pB0, pB1, alB, l_reg, pa0, pa1, pa2, pa3); SBAR();
    pv_d0(o, vb0 + s0, pa0, pa1, pa2, pa3); if (BND && !onl) partialSM_b(pA0, alA); else partialSM_n<false>(pA0, pA1, mhat, negm, alA);
    RESC(alA); AWAIT_BAR(4); ROT();
  }
  }
  { DMA_K(NT - 1, s0); DMA_V(NT - 1, s2); }
  SBAR(); qkt_n(pB0, pB1, (const bf16*)(K_lds + s1), qr, negm, r32, hi);
  if constexpr (OT) finishSM_ot(pA0, pA1, alA, l_reg, pa0, pa1, pa2, pa3); else finishSM(pA0, pA1, alA, l_reg, pa0, pa1, pa2, pa3);
  SBAR();
  if constexpr (OT) pv_ot(o, vb0 + s0, pa0, pa1, pa2, pa3); else pv_d0(o, vb0 + s0, pa0, pa1, pa2, pa3);
  if (BND && !onl) partialSM_b(pB0, alB); else partialSM_n<false>(pB0, pB1, mhat, negm, alB);
  RESC(alB); AWAIT_BAR(4); ROT();
  if constexpr (OT) finishSM_ot(pB0, pB1, alB, l_reg, pa0, pa1, pa2, pa3); else finishSM(pB0, pB1, alB, l_reg, pa0, pa1, pa2, pa3);
  SBAR();
  if constexpr (OT) pv_ot(o, vb0 + s0, pa0, pa1, pa2, pa3); else pv_d0(o, vb0 + s0, pa0, pa1, pa2, pa3);
  __builtin_amdgcn_s_setprio(0);
  int lane2; asm volatile("v_mbcnt_lo_u32_b32 %0, -1, 0\n\tv_mbcnt_hi_u32_b32 %0, -1, %0" : "=v"(lane2));
  const int r32b = lane2 & 31, hib = lane2 >> 5;
  if constexpr (OT) {
    const float rl = __builtin_amdgcn_rcpf(l_reg);
    bf16* Ow = Ob + (long)(wid * QBLK + r32b) * LDO + 4 * hib;
#pragma unroll
    for (int d0 = 0; d0 < 4; ++d0)
#pragma unroll
      for (int g = 0; g < 4; ++g) { const unsigned long long w = (unsigned long long)cvtpk(o[d0][4 * g] * rl, o[d0][4 * g + 1] * rl) | ((unsigned long long)cvtpk(o[d0][4 * g + 2] * rl, o[d0][4 * g + 3] * rl) << 32);
        *(unsigned long long*)(Ow + d0 * 32 + g * 8) = w; }
  } else {
  if (hi == 0) li_l[r32] = l_reg; asm volatile("s_waitcnt lgkmcnt(0)" ::: "memory");
  float rli[16];
#pragma unroll
  for (int r = 0; r < 16; ++r) rli[r] = __builtin_amdgcn_rcpf(li_l[crow(r, hib)]);
  bf16* Ow = Ob + (long)(wid * QBLK) * LDO + r32b;
#pragma unroll
  for (int r = 0; r < 16; ++r) { int orow = crow(r, hib);
    for (int d0 = 0; d0 < 4; ++d0) Ow[(long)orow * LDO + d0 * 32] = (bf16)(cvtpk(o[d0][r] * rli[r], 0.f) & 0xffffu); }
  }
  AWAIT_BAR(0);
#undef DMA_K
#undef DMA_V
#undef DMA_K1
#undef DMA_V1
#undef RESC
#undef ROT
}
template <int LDQ, int LDK, int LDO>
__device__ __forceinline__ void attn_dense_stg(const bf16* Qb, const bf16* __restrict__ Kh, const bf16* __restrict__ Vh, bf16* Ob, int seq, char* lds,
                                                __attribute__((address_space(3))) unsigned char* ldsl, const int wave_s, const float* qg = nullptr, const float* axt = nullptr, int tok0 = 0, float bnd = 0.f) {
  constexpr bool OT = true, QN = true, BND = true;
  int lane; asm volatile("v_mbcnt_lo_u32_b32 %0, -1, 0\n\tv_mbcnt_hi_u32_b32 %0, -1, %0" : "=v"(lane));
  const int wid = wave_s, r32 = lane & 31, hi = lane >> 5;
  float mhat = 0.f, l_reg = 0; f32x16 o[4] = {}; bf16x8 qr[8]; f32x16 negm;
  unsigned ksrc[2], vsrc[2];
#pragma unroll
  for (int i = 0; i < 2; ++i) { const int p = 2 * wid + i;
    const int krow = 4 * p + (lane >> 4), kch = (lane & 15) ^ (krow & 15); ksrc[i] = (unsigned)(krow * LDK + kch * 8) * 2u;
    const int sub = 2 * p + (lane >> 5), kk = ((sub >> 2) << 3) | ((lane & 31) >> 2), key = OT ? kk : ((kk & ~0xC) | ((kk & 4) << 1) | ((kk & 8) >> 1)), vc = ((sub & 3) << 5) | ((lane & 3) << 3);
    vsrc[i] = (unsigned)(key * LDK + vc) * 2u; }
#define DMA_K1(t, sl, i_) __builtin_amdgcn_global_load_lds((const unsigned*)((const char*)Kh + (ksrc[i_] + (unsigned)(t) * (unsigned)(KVBLK * LDK * 2))), (__attribute__((address_space(3))) unsigned*)(ldsl + (sl) + (2 * wid + (i_)) * 1024), 16, 0, 0)
#define DMA_V1(t, sl, i_) __builtin_amdgcn_global_load_lds((const unsigned*)((const char*)Vh + (vsrc[i_] + (unsigned)(t) * (unsigned)(KVBLK * LDK * 2))), (__attribute__((address_space(3))) unsigned*)(ldsl + 4 * ASLOT + (sl) + (2 * wid + (i_)) * 1024), 16, 0, 0)
#define DMA_K(t, sl) do { DMA_K1(t, sl, 0); DMA_K1(t, sl, 1); } while (0)
#define DMA_V(t, sl) do { DMA_V1(t, sl, 0); DMA_V1(t, sl, 1); } while (0)
  const int NT = seq / KVBLK;
  DMA_K(0, 0); DMA_V(0, 0); DMA_K(1, ASLOT); DMA_K(2, 2 * ASLOT);
  const bf16* Qw = Qb + (long)(wid * QBLK + r32) * LDQ + hi * 8;
#pragma unroll
  for (int d0 = 0; d0 < 8; ++d0) qr[d0] = ld8(Qw + d0 * 16);
  if constexpr (QN) {
    const int t = tok0 + wid * QBLK + r32, prow = t >> 6, pcol = t & 63;
    float x[8][8]; float ss = 0.f;
#pragma unroll
    for (int d0 = 0; d0 < 8; ++d0)
#pragma unroll
      for (int e = 0; e < 8; ++e) { x[d0][e] = __builtin_bit_cast(float, (unsigned)(unsigned short)qr[d0][e] << 16); ss += x[d0][e] * x[d0][e]; }
    { auto rr = __builtin_amdgcn_permlane32_swap(__float_as_uint(ss), __float_as_uint(ss), false, false); ss = __uint_as_float(rr[0]) + __uint_as_float(rr[1]); }
    const float rstd = CQ / sqrtf(ss * (1.f / 128.f) + 1e-6f);
#pragma unroll
    for (int d0 = 0; d0 < 8; ++d0) { const float* gp = qg + d0 * 16 + hi * 8; const f32x4v g0 = *(const f32x4v*)gp, g1 = *(const f32x4v*)(gp + 4);
#pragma unroll
      for (int e = 0; e < 8; ++e) x[d0][e] *= rstd * (e < 4 ? g0[e] : g1[e - 4]); }
#pragma unroll
    for (int half = 0; half < 2; ++half) { const float* ct = half == 0 ? axt + prow * 32 : axt + 16384 + pcol * 32; const float* st = ct + (half == 0 ? 8192 : 2048);
#pragma unroll
      for (int dd = 0; dd < 2; ++dd) { const int ix = dd * 16 + hi * 8;
        const f32x4v c0 = *(const f32x4v*)(ct + ix), c1 = *(const f32x4v*)(ct + ix + 4), s0 = *(const f32x4v*)(st + ix), s1 = *(const f32x4v*)(st + ix + 4);
#pragma unroll
        for (int e = 0; e < 8; ++e) { const float c = e < 4 ? c0[e] : c1[e - 4], sn = e < 4 ? s0[e] : s1[e - 4];
          const float a = x[half * 4 + dd][e], b = x[half * 4 + 2 + dd][e]; x[half * 4 + dd][e] = a * c - b * sn; x[half * 4 + 2 + dd][e] = b * c + a * sn; } } }
#pragma unroll
    for (int d0 = 0; d0 < 8; ++d0) { u32x4 w = {cvtpk(x[d0][0], x[d0][1]), cvtpk(x[d0][2], x[d0][3]), cvtpk(x[d0][4], x[d0][5]), cvtpk(x[d0][6], x[d0][7])}; qr[d0] = *reinterpret_cast<bf16x8*>(&w); }
  }
  if constexpr (!QN) {
#pragma unroll
    for (int d0 = 0; d0 < 8; ++d0) { float x[8];
#pragma unroll
      for (int e = 0; e < 8; ++e) x[e] = __builtin_bit_cast(float, (unsigned)(unsigned short)qr[d0][e] << 16) * CQ;
      u32x4 w = {cvtpk(x[0], x[1]), cvtpk(x[2], x[3]), cvtpk(x[4], x[5]), cvtpk(x[6], x[7])}; qr[d0] = *reinterpret_cast<bf16x8*>(&w); }
  }
  const bool onl = !BND || !(bnd <= 60.f);
  { float nb = (BND && !onl) ? -bnd : 0.f; asm volatile("" : "+v"(nb));
    for (int r = 0; r < 16; ++r) negm[r] = nb; asm volatile("" : "+v"(negm)); }
  f32x16 S0, S1; float al = 1.f; bf16x8 pa0, pa1, pa2, pa3;
  int s0 = 2 * ASLOT, s1 = 0, s2 = ASLOT;
#define ROT() do { const int t_ = s0; s0 = s1; s1 = s2; s2 = t_; } while (0)
#define VBAR() asm volatile("s_waitcnt lgkmcnt(0)\n\ts_barrier" ::: "memory")
  const lds_cp kb_l = (lds_cp)ldsl + r32 * 256, vb_l = (lds_cp)ldsl + 4 * ASLOT + v_rd_base(lane);
  const int ksw = (r32 & 15) << 4, khi = hi * 16;
  bf16x8 kf[4][2]; s16x4 vl[8], vh[8];
#define G_KRD(kp, i) do { const unsigned a_ = (unsigned)(uintptr_t)(kp) + (unsigned)((((i) * 32 + khi) ^ ksw)); \
    asm volatile("ds_read_b128 %0, %2\n\tds_read_b128 %1, %2 offset:8192" : "=&v"(kf[(i) & 3][0]), "=&v"(kf[(i) & 3][1]) : "v"(a_) : "memory"); } while (0)
#define G_KWAIT(N, i) do { asm volatile("s_waitcnt lgkmcnt(" #N ")" ::: "memory"); SBAR(); } while (0)
#define G_VRD(vp, j) do { const unsigned a_ = (unsigned)(uintptr_t)(vp); \
    asm volatile("ds_read_b64_tr_b16 %0, %2 offset:%3\n\tds_read_b64_tr_b16 %1, %2 offset:%4" : "=&v"(vl[(j) & 7]), "=&v"(vh[(j) & 7]) : "v"(a_), "i"(v_rd_off((j) & 3, (j) >> 2, 0)), "i"(v_rd_off((j) & 3, (j) >> 2, 1)) : "memory"); } while (0)
#define G_VWAIT(N, j) do { asm volatile("s_waitcnt lgkmcnt(" #N ")" ::: "memory"); SBAR(); } while (0)
#define G_VF(j) (bf16x8){vl[(j) & 7][0], vl[(j) & 7][1], vl[(j) & 7][2], vl[(j) & 7][3], vh[(j) & 7][0], vh[(j) & 7][1], vh[(j) & 7][2], vh[(j) & 7][3]}
#define G_PA(j) (((j) >> 2) == 0 ? pa0 : ((j) >> 2) == 1 ? pa1 : ((j) >> 2) == 2 ? pa2 : pa3)
#define G_QK(i, HASPV, kp, vp, tk, tv) do { \
    if (((i) & 1) == 0 && ((i) >> 1) + 3 < 8) G_KRD(kp, ((i) >> 1) + 3); \
    if ((HASPV) && (i) >= 10) G_VRD(vp, (i) - 10); \
    if (((i) & 1) == 0) { if ((i) < 10) G_KWAIT(6, (i) >> 1); \
      else if ((i) == 10) { if (HASPV) G_KWAIT(6, 5); else G_KWAIT(4, 5); } \
      else if ((i) == 12) { if (HASPV) G_KWAIT(8, 6); else G_KWAIT(2, 6); } \
      else { if (HASPV) G_KWAIT(10, 7); else G_KWAIT(0, 7); } } \
    if (((i) & 1) == 0) S0 = __builtin_amdgcn_mfma_f32_32x32x16_bf16(kf[((i) >> 1) & 3][0], qr[(i) >> 1], (i) < 2 ? negm : S0, 0, 0, 0); \
    else S1 = __builtin_amdgcn_mfma_f32_32x32x16_bf16(kf[((i) >> 1) & 3][1], qr[(i) >> 1], (i) < 2 ? negm : S1, 0, 0, 0); \
    SBAR(); } while (0)
#define G_PV(j, vp) do { if ((j) + 6 < 16) G_VRD(vp, (j) + 6); \
    if ((j) < 10) G_VWAIT(12, j); else if ((j) == 10) G_VWAIT(10, 10); else if ((j) == 11) G_VWAIT(8, 11); else if ((j) == 12) G_VWAIT(6, 12); \
    else if ((j) == 13) G_VWAIT(4, 13); else if ((j) == 14) G_VWAIT(2, 14); else G_VWAIT(0, 15); \
    o[(j) & 3] = __builtin_amdgcn_mfma_f32_32x32x16_bf16(G_VF(j), G_PA(j), o[(j) & 3], 0, 0, 0); SBAR(); } while (0)
#define G_KPRE(kp) do { SBAR(); G_KRD(kp, 0); G_KRD(kp, 1); G_KRD(kp, 2); SBAR(); } while (0)
#define G_QK16(HASPV, kp, vp, tk, tv) do { \
    G_QK(0, HASPV, kp, vp, tk, tv); G_QK(1, HASPV, kp, vp, tk, tv); G_QK(2, HASPV, kp, vp, tk, tv); G_QK(3, HASPV, kp, vp, tk, tv); \
    G_QK(4, HASPV, kp, vp, tk, tv); G_QK(5, HASPV, kp, vp, tk, tv); G_QK(6, HASPV, kp, vp, tk, tv); G_QK(7, HASPV, kp, vp, tk, tv); \
    G_QK(8, HASPV, kp, vp, tk, tv); G_QK(9, HASPV, kp, vp, tk, tv); G_QK(10, HASPV, kp, vp, tk, tv); G_QK(11, HASPV, kp, vp, tk, tv); \
    G_QK(12, HASPV, kp, vp, tk, tv); G_QK(13, HASPV, kp, vp, tk, tv); G_QK(14, HASPV, kp, vp, tk, tv); G_QK(15, HASPV, kp, vp, tk, tv); } while (0)
#define G_PV16(vp) do { G_PV(0, vp); G_PV(1, vp); G_PV(2, vp); G_PV(3, vp); G_PV(4, vp); G_PV(5, vp); G_PV(6, vp); G_PV(7, vp); \
    G_PV(8, vp); G_PV(9, vp); G_PV(10, vp); G_PV(11, vp); G_PV(12, vp); G_PV(13, vp); G_PV(14, vp); G_PV(15, vp); } while (0)
#define G_SOFTMAX(FIRST) do { al = 1.f; \
    if (onl) { float pmax = S0[0]; for (int r = 1; r < 16; ++r) pmax = fmaxf(pmax, S0[r]); for (int r = 0; r < 16; ++r) pmax = fmaxf(pmax, S1[r]); \
      { auto rr = __builtin_amdgcn_permlane32_swap(__float_as_uint(pmax), __float_as_uint(pmax), false, false); pmax = fmaxf(__uint_as_float(rr[0]), __uint_as_float(rr[1])); } \
      if ((FIRST) || !__all(pmax <= THR2)) { const float dl = (FIRST) ? pmax : fmaxf(pmax, 0.f); mhat += dl; \
        for (int r = 0; r < 16; ++r) { S0[r] -= dl; S1[r] -= dl; } for (int r = 0; r < 16; ++r) negm[r] = -mhat; asm volatile("" : "+v"(negm)); \
        if (!(FIRST)) { al = __builtin_amdgcn_exp2f(-dl); for (int d = 0; d < 4; ++d) for (int r = 0; r < 16; ++r) o[d][r] *= al; } } } \
    for (int r = 0; r < 16; ++r) S0[r] = __builtin_amdgcn_exp2f(S0[r]); for (int r = 0; r < 16; ++r) S1[r] = __builtin_amdgcn_exp2f(S1[r]); \
    { float ps = 0.f; for (int r = 0; r < 16; ++r) ps += S0[r]; for (int r = 0; r < 16; ++r) ps += S1[r]; \
      auto rr = __builtin_amdgcn_permlane32_swap(__float_as_uint(ps), __float_as_uint(ps), false, false); l_reg = l_reg * al + (__uint_as_float(rr[0]) + __uint_as_float(rr[1])); } \
    pa0 = pack8(S0, 0); pa1 = pack8(S0, 8); pa2 = pack8(S1, 0); pa3 = pack8(S1, 8); } while (0)
  AWAIT_BAR(0);
  const bool grpB = wid >= 4;
  G_KPRE(kb_l);
  if (grpB) VBAR();
  { const lds_cp kp_ = kb_l, vp_ = vb_l + s0; __builtin_amdgcn_s_setprio(1);
    G_QK16(false, kp_, vp_, 2, 1);
    __builtin_amdgcn_s_setprio(0); AWAIT_BAR(0); ROT(); }
  DMA_K(3, 3 * ASLOT); DMA_V(1, s1);
  G_SOFTMAX(true); G_KPRE(kb_l + ASLOT); VBAR();
#pragma unroll 1
  for (int t = 1; t < NT; ++t) {
    { const int tk = t + 3 < NT ? t + 3 : NT - 1, tv = t + 1 < NT ? t + 1 : NT - 1;
      const lds_cp kp_ = kb_l + ((t & 3) << 14), vp_ = vb_l + s0; __builtin_amdgcn_s_setprio(1);
      G_QK16(true, kp_, vp_, tk, tv);
      G_PV16(vp_);
      __builtin_amdgcn_s_setprio(0); AWAIT_BAR(0); ROT(); }
    G_SOFTMAX(false);
    { const lds_cp kn_ = kb_l + (((t + 1) & 3) << 14); G_KPRE(kn_); }
    { const int tk = t + 3 < NT ? t + 3 : NT - 1, tv = t + 1 < NT ? t + 1 : NT - 1; SBAR();
      DMA_K(tk, ((t + 3) & 3) << 14); DMA_V(tv, s1); }
    VBAR();
  }
  { const lds_cp vp_ = vb_l + s0; __builtin_amdgcn_s_setprio(1);
    SBAR(); G_VRD(vp_, 0); G_VRD(vp_, 1); G_VRD(vp_, 2); G_VRD(vp_, 3); G_VRD(vp_, 4); G_VRD(vp_, 5); SBAR();
    G_PV16(vp_);
    __builtin_amdgcn_s_setprio(0); }
  if (!grpB) VBAR();
#undef G_KRD
#undef G_KWAIT
#undef G_VRD
#undef G_VWAIT
#undef G_VF
#undef G_PA
#undef G_QK
#undef G_PV
#undef G_QK16
#undef G_KPRE
#undef G_PV16
#undef G_SOFTMAX
  int lane2; asm volatile("v_mbcnt_lo_u32_b32 %0, -1, 0\n\tv_mbcnt_hi_u32_b32 %0, -1, %0" : "=v"(lane2));
  const int r32b = lane2 & 31, hib = lane2 >> 5;
  { const float rl = __builtin_amdgcn_rcpf(l_reg);
    bf16* Ow = Ob + (long)(wid * QBLK + r32b) * LDO + 4 * hib;
#pragma unroll
    for (int d0 = 0; d0 < 4; ++d0)
#pragma unroll
      for (int g = 0; g < 4; ++g) { const unsigned long long w = (unsigned long long)cvtpk(o[d0][4 * g] * rl, o[d0][4 * g + 1] * rl) | ((unsigned long long)cvtpk(o[d0][4 * g + 2] * rl, o[d0][4 * g + 3] * rl) << 32);
        *(unsigned long long*)(Ow + d0 * 32 + g * 8) = w; } }
  AWAIT_BAR(0);
#undef DMA_K
#undef DMA_V
#undef DMA_K1
#undef DMA_V1
#undef ROT
#undef VBAR
}
}

namespace ba {
using namespace da;
constexpr float C2 = SCALE * 1.4426950408889634f;
__device__ __forceinline__ void battn_wg_unit(const bf16* __restrict__ Q, const bf16* __restrict__ K, const bf16* __restrict__ V, bf16* __restrict__ OG, float* __restrict__ LSE,
                                              int q0, int seg_lo, int seg_hi, int h, char* lds, __attribute__((address_space(3))) unsigned char* ldsl, const int wave_s) {
  constexpr int LD = 1024;
  int lane; asm volatile("v_mbcnt_lo_u32_b32 %0, -1, 0\n\tv_mbcnt_hi_u32_b32 %0, -1, %0" : "=v"(lane));
  const int wid = wave_s, r32 = lane & 31, hi = lane >> 5;
  char* K_lds = lds; char* V_lds = lds + 3 * ASLOT;
  float mhat = 0.f, l_reg = 0; f32x16 o[4] = {}; bf16x8 qr[8]; f32x16 negm = {}; asm volatile("" : "+v"(negm));
  const int kb0 = q0 - 64;
  int krow[2], kcol[2], vrow[2], vcol[2];
#pragma unroll
  for (int i = 0; i < 2; ++i) { const int p = 2 * wid + i;
    krow[i] = 4 * p + (lane >> 4); kcol[i] = ((lane & 15) ^ (krow[i] & 7)) * 8;
    const int sub = 2 * p + (lane >> 5), kk = ((sub >> 2) << 3) | ((lane & 31) >> 2); vrow[i] = kk; vcol[i] = ((sub & 3) << 5) | ((lane & 3) << 3); }
  const bf16* Kh = K + h * 128; const bf16* Vh = V + h * 128;
#define BDMA(t, sl) do { const int kb_ = kb0 + 64 * (t); _Pragma("unroll") for (int i_ = 0; i_ < 2; ++i_) { \
    int rk_ = kb_ + krow[i_]; rk_ = rk_ < seg_lo ? seg_lo : (rk_ >= seg_hi ? seg_hi - 1 : rk_); int rv_ = kb_ + vrow[i_]; rv_ = rv_ < seg_lo ? seg_lo : (rv_ >= seg_hi ? seg_hi - 1 : rv_); \
    __builtin_amdgcn_global_load_lds((const unsigned*)(Kh + (long)rk_ * LD + kcol[i_]), (__attribute__((address_space(3))) unsigned*)(ldsl + (sl) + (2 * wid + i_) * 1024), 16, 0, 0); \
    __builtin_amdgcn_global_load_lds((const unsigned*)(Vh + (long)rv_ * LD + vcol[i_]), (__attribute__((address_space(3))) unsigned*)(ldsl + 3 * ASLOT + (sl) + (2 * wid + i_) * 1024), 16, 0, 0); } } while (0)
  BDMA(0, 0); BDMA(1, ASLOT);
  { const bf16* Qw = Q + (long)(q0 + wid * QBLK + r32) * LD + h * 128 + hi * 8;
#pragma unroll
    for (int d0 = 0; d0 < 8; ++d0) { const bf16x8 raw = ld8(Qw + d0 * 16); float x[8];
#pragma unroll
      for (int e = 0; e < 8; ++e) x[e] = __builtin_bit_cast(float, (unsigned)(unsigned short)raw[e] << 16) * CQ;
      u32x4 w = {cvtpk(x[0], x[1]), cvtpk(x[2], x[3]), cvtpk(x[4], x[5]), cvtpk(x[6], x[7])}; qr[d0] = *reinterpret_cast<bf16x8*>(&w); } }
  const int vb0 = (int)(uintptr_t)V_lds + v_rd_base(lane);
  const int qi = q0 + wid * QBLK + r32, t_lo = wid >> 1;
  int s0 = 2 * ASLOT, s1 = 0, s2 = ASLOT;
  bool started = false;
  AWAIT_BAR(0);
#pragma unroll 1
  for (int t = 0; t < 6; ++t) {
    { const int tn = t + 2 < 6 ? t + 2 : 5; BDMA(tn, s0); }
    const int kb = kb0 + 64 * t;
    const bool active = (t >= t_lo) && (t <= t_lo + 2) && (kb + 64 > seg_lo) && (kb < seg_hi);
    if (active) {
      f32x16 S0, S1; float al; bf16x8 pa0, pa1, pa2, pa3;
      qkt_n(S0, S1, (const bf16*)(K_lds + s1), qr, negm, r32, hi);
#pragma unroll
      for (int r = 0; r < 16; ++r) { const int ka = kb + crow(r, hi), kc = ka + 32;
        const bool oka = (ka - qi <= 64) & (qi - ka <= 64), okc = (kc - qi <= 64) & (qi - kc <= 64);
        S0[r] = oka ? S0[r] : -1e30f; S1[r] = okc ? S1[r] : -1e30f; }
      float pmax = S0[0];
#pragma unroll
      for (int r = 1; r < 16; ++r) pmax = fmaxf(pmax, S0[r]);
#pragma unroll
      for (int r = 0; r < 16; ++r) pmax = fmaxf(pmax, S1[r]);
      { auto rr = __builtin_amdgcn_permlane32_swap(__float_as_uint(pmax), __float_as_uint(pmax), false, false); pmax = fmaxf(__uint_as_float(rr[0]), __uint_as_float(rr[1])); }
      al = 1.f;
      if (!started || !__all(pmax <= THR2)) {
        const float dl = !started ? pmax : fmaxf(pmax, 0.f); mhat += dl;
#pragma unroll
        for (int r = 0; r < 16; ++r) { S0[r] -= dl; S1[r] -= dl; }
#pragma unroll
        for (int r = 0; r < 16; ++r) negm[r] = -mhat;
        asm volatile("" : "+v"(negm));
        if (started) al = __builtin_amdgcn_exp2f(-dl);
      }
      started = true;
      float ps = 0.f;
#pragma unroll
      for (int r = 0; r < 16; ++r) { S0[r] = __builtin_amdgcn_exp2f(S0[r]); S1[r] = __builtin_amdgcn_exp2f(S1[r]); ps += S0[r] + S1[r]; }
      { auto rr = __builtin_amdgcn_permlane32_swap(__float_as_uint(ps), __float_as_uint(ps), false, false); ps = __uint_as_float(rr[0]) + __uint_as_float(rr[1]); }
      l_reg = l_reg * al + ps;
      pa0 = pack8(S0, 0); pa1 = pack8(S0, 8); pa2 = pack8(S1, 0); pa3 = pack8(S1, 8);
      if (__any(al < 1.f)) {
#pragma unroll
        for (int d = 0; d < 4; ++d)
#pragma unroll
          for (int r = 0; r < 16; ++r) o[d][r] *= al; }
      pv_ot(o, vb0 + s1, pa0, pa1, pa2, pa3);
    }
    AWAIT_BAR(4); { const int t_ = s0; s0 = s1; s1 = s2; s2 = t_; }
  }
  int lane2; asm volatile("v_mbcnt_lo_u32_b32 %0, -1, 0\n\tv_mbcnt_hi_u32_b32 %0, -1, %0" : "=v"(lane2));
  const int r32b = lane2 & 31, hib = lane2 >> 5;
  { const float rl = __builtin_amdgcn_rcpf(l_reg);
    bf16* Ow = OG + (long)(q0 + wid * QBLK + r32b) * LD + h * 128 + 4 * hib;
#pragma unroll
    for (int d0 = 0; d0 < 4; ++d0)
#pragma unroll
      for (int g = 0; g < 4; ++g) { const unsigned long long w = (unsigned long long)cvtpk(o[d0][4 * g] * rl, o[d0][4 * g + 1] * rl) | ((unsigned long long)cvtpk(o[d0][4 * g + 2] * rl, o[d0][4 * g + 3] * rl) << 32);
        *(unsigned long long*)(Ow + d0 * 32 + g * 8) = w; } }
  if (hib == 0) LSE[(size_t)(q0 + wid * QBLK + r32b) * 8 + h] = (mhat + __builtin_amdgcn_logf(l_reg)) * 0.6931471805599453f;
  AWAIT_BAR(0);
#undef BDMA
}
}
#define GAS __attribute__((address_space(1)))
#define LAS __attribute__((address_space(3)))
typedef unsigned short bf16;
typedef unsigned v4u __attribute__((ext_vector_type(4)));
typedef float f32x4 __attribute__((ext_vector_type(4)));
typedef short bf16x8 __attribute__((ext_vector_type(8)));
typedef GAS unsigned gu32;
typedef GAS unsigned long long gu64;
#define RLX_AGENT __ATOMIC_RELAXED, __HIP_MEMORY_SCOPE_AGENT
#define LDS_WAIT() asm volatile("s_waitcnt lgkmcnt(0)" ::: "memory")
#define VM_WAIT() asm volatile("s_waitcnt vmcnt(0)" ::: "memory")
__device__ __forceinline__ unsigned long long rt() { return __builtin_amdgcn_s_memrealtime(); }
__device__ __forceinline__ unsigned f2bf(float f) { unsigned u = __builtin_bit_cast(unsigned, f); return (u + 0x7fffu + ((u >> 16) & 1u)) >> 16; }
__device__ __forceinline__ unsigned pk2(float lo, float hi) { return f2bf(lo) | (f2bf(hi) << 16); }

#define XB_TMO      128
#define XB_XCNT(j)  (256  + 64 * (j))
#define XB_XSUB(j)  (1280 + 64 * (j))
#define XB_XGEN(j)  (2304 + 64 * (j))
#define XB_TOP      3328
#define XB_TOPGEN   3392
#define XCD_BAR_WORDS 3456
#define XB_SPIN_CAP (1u << 18)

__device__ __forceinline__ unsigned xb_ld(unsigned* p)              { return __hip_atomic_load(p, __ATOMIC_RELAXED, __HIP_MEMORY_SCOPE_AGENT); }
__device__ __forceinline__ unsigned xb_add(unsigned* p, unsigned v) { return __hip_atomic_fetch_add(p, v, __ATOMIC_RELAXED, __HIP_MEMORY_SCOPE_AGENT); }
__device__ __forceinline__ unsigned xb_xcc_id() { return (unsigned)__builtin_amdgcn_s_getreg((3 << 11) | 20) & 0xFu; }
#define XB_SPIN(cond, bar) do { unsigned _sp = 0; while (cond) { __builtin_amdgcn_s_sleep(1); \
    if ((++_sp & 255u) == 0u) { if (xb_ld(&(bar)[XB_TMO])) break; if (_sp > XB_SPIN_CAP) { atomicAdd(&(bar)[XB_TMO], 1u); break; } } } } while (0)

struct XcdBarrier {
    unsigned* bar; unsigned x;
    volatile LAS unsigned* st;
};

__device__ __forceinline__ XcdBarrier xcd_barrier_post(unsigned* bar, volatile LAS unsigned* st) {
    XcdBarrier b; b.bar = bar; b.x = xb_xcc_id(); b.st = st;
    if (threadIdx.x == 0) (void)xb_add(&bar[XB_XCNT(b.x)], 1u);
    return b;
}
__device__ __forceinline__ void xcd_barrier_complete(unsigned* bar, unsigned x, unsigned& nloc, unsigned& nx) {
    const unsigned G = gridDim.x * gridDim.y * gridDim.z;
    unsigned sum, cnt, mine, sp = 0u;
    for (;;) {
        sum = 0u; cnt = 0u; mine = 0u;
#pragma unroll
        for (unsigned j = 0; j < 16; ++j) { const unsigned c = xb_ld(&bar[XB_XCNT(j)]); sum += c; cnt += (c > 0u) ? 1u : 0u; mine = (j == x) ? c : mine; }
        if (sum == G) break;
        __builtin_amdgcn_s_sleep(1);
        if ((++sp & 255u) == 0u) { if (xb_ld(&bar[XB_TMO])) break; if (sp > XB_SPIN_CAP) { atomicAdd(&bar[XB_TMO], 1u); break; } }
    }
    nloc = mine > 0u ? mine : 1u; nx = cnt > 0u ? cnt : 1u;
}

__device__ __forceinline__ void xcd_barrier(const XcdBarrier& b) {
    asm volatile("s_waitcnt vmcnt(0)" ::: "memory");
    __syncthreads();
    if (threadIdx.x == 0) {
        unsigned* bar = b.bar;
        __builtin_amdgcn_s_waitcnt(0);
        unsigned nloc = b.st[0], nx = b.st[1];
        if (nloc == 0u) { xcd_barrier_complete(bar, b.x, nloc, nx); b.st[0] = nloc; b.st[1] = nx; }
        const unsigned old = xb_add(&bar[XB_XSUB(b.x)], 1u);
        const unsigned gen = old / nloc;
        if (old + 1u == (gen + 1u) * nloc) {
            __builtin_amdgcn_fence(__ATOMIC_RELEASE, "agent");
            asm volatile("s_waitcnt vmcnt(0)" ::: "memory");
            const unsigned og = xb_add(&bar[XB_TOP], 1u);
            const unsigned tg = og / nx;
            if (og + 1u == (tg + 1u) * nx) xb_add(&bar[XB_TOPGEN], 1u);
            else XB_SPIN(xb_ld(&bar[XB_TOPGEN]) == tg, bar);
            __builtin_amdgcn_fence(__ATOMIC_ACQUIRE, "agent");
            xb_add(&bar[XB_XGEN(b.x)], 1u);
            asm volatile("s_waitcnt vmcnt(0)" ::: "memory");
        } else {
            XB_SPIN(xb_ld(&bar[XB_XGEN(b.x)]) == gen, bar);
            __builtin_amdgcn_fence(__ATOMIC_ACQUIRE, "agent");
            asm volatile("s_waitcnt vmcnt(0)" ::: "memory");
        }
    }
    __syncthreads();
}

constexpr int DM = 2048, SEQ = 16384, NSEQ = 3, MTOK = NSEQ * SEQ, HD = 128, DFF = 8192, MEMR = 768, DEPTH = 4;
constexpr float EPS = 1e-6f;
constexpr int NWAVES = 8;
#ifndef GM_ALIGN
#define GM_ALIGN true
#endif
#ifndef GM_SP2
#define GM_SP2 true
#endif
constexpr int MLPC = 8192;
#ifndef PHMASK
#define PHMASK 0xFFFFFFu
#endif
#define PH(n) (((PHMASK) >> (n)) & 1u)
#ifndef WGM_QKVB
#define WGM_QKVB 8
#define WGM_QKVA 8
#endif
#ifndef EXPN
#define EXPN 0
#endif
#define REPS(k) for (int rep_ = 0; rep_ < (((EXPN) == (k) || ((EXPN) == 9 && ((k) == 2 || (k) == 3 || (k) == 7))) ? 2 : 1); ++rep_)
constexpr size_t MiB = 1u << 20;
constexpr size_t WS_CTL = 0, CTL_ZERO_BYTES = 8 * MiB;
constexpr size_t WS_SS = 1 * MiB;
constexpr size_t WS_COS1 = 8 * MiB, WS_SIN1 = 12 * MiB;
constexpr size_t WS_AXT = 16 * MiB;
constexpr size_t WS_MEMN = 17 * MiB;
constexpr size_t WS_CKVT = 29 * MiB;
constexpr size_t WS_CKV = 45 * MiB;
constexpr size_t WS_WQKV = 51 * MiB;
constexpr size_t WS_WO = 87 * MiB;
constexpr size_t WS_CWQ = 95 * MiB, WS_CWO = 97 * MiB;
constexpr size_t WS_WUP = 99 * MiB, WS_WDN = 131 * MiB;
constexpr size_t WS_HN = 163 * MiB;
constexpr size_t WS_QKV = 355 * MiB;
constexpr size_t WS_BIG = 643 * MiB;
constexpr size_t WS_END = 899 * MiB;
constexpr size_t BIG_OB = 0, BIG_OG = 96 * MiB, BIG_LSE = 192 * MiB;
constexpr int CW_BAR = 4096;
constexpr int RING_BYTES = 131072;
constexpr int LDSCTL_OFF = RING_BYTES, MISC_OFF = LDSCTL_OFF + 320;
constexpr int PTAB_OFF = RING_BYTES + 512;
constexpr int BSCR_OFF = RING_BYTES + 1024;
constexpr int LDS_BYTES = 147456;

__device__ __forceinline__ float shflx(float v, int mask, int lane) { return __builtin_bit_cast(float, __builtin_amdgcn_ds_bpermute((lane ^ mask) << 2, __builtin_bit_cast(int, v))); }
__device__ __forceinline__ float wave_sum(float v, int lane) {
#pragma unroll
    for (int o = 1; o < 64; o <<= 1) v += shflx(v, o, lane);
    return v;
}
__device__ __forceinline__ int pair_row(int L) { const int w = L & 255, d = w & 127; return (L & ~255) + (d >> 6) * 128 + (w >> 7) * 64 + (d & 63); }
typedef _Float16 half2k __attribute__((ext_vector_type(2)));
__device__ __forceinline__ unsigned pkh(float lo, float hi) { const half2k v = {(_Float16)lo, (_Float16)hi}; return __builtin_bit_cast(unsigned, v); }
__device__ __forceinline__ unsigned pkhb(float lo, float hi) { const unsigned t = pk2(lo, hi); return pkh(__builtin_bit_cast(float, t << 16), __builtin_bit_cast(float, t & 0xFFFF0000u)); }
__device__ __forceinline__ void transpose_item(const float* W, const float* gain, int K, int N, bf16* WT, LAS float* scr, int item, int lane, int nperm = 0, bool f16 = false) {
    const int nblk = N / 32, kb = item / nblk, nb = item % nblk, k0 = 64 * kb, n0 = 32 * nb;
    float wv[32];
#pragma unroll
    for (int i = 0; i < 32; ++i) { const int kk = 2 * i + (lane >> 5); wv[i] = W[(size_t)(k0 + kk) * N + n0 + (lane & 31)]; }
    if (gain) {
#pragma unroll
        for (int i = 0; i < 32; ++i) wv[i] *= gain[k0 + 2 * i + (lane >> 5)];
    }
#pragma unroll
    for (int i = 0; i < 32; ++i) { const int kk = 2 * i + (lane >> 5); scr[kk * 33 + (lane & 31)] = wv[i]; }
    LDS_WAIT(); asm volatile("" ::: "memory");
    const int c = lane & 7;
#pragma unroll
    for (int j = 0; j < 4; ++j) { const int n = (lane >> 3) + 8 * j; const LAS float* s = scr + (8 * c) * 33 + n;
        v4u o;
        if (f16) { o.x = pkhb(s[0 * 33], s[1 * 33]); o.y = pkhb(s[2 * 33], s[3 * 33]); o.z = pkhb(s[4 * 33], s[5 * 33]); o.w = pkhb(s[6 * 33], s[7 * 33]); }
        else { o.x = pk2(s[0 * 33], s[1 * 33]); o.y = pk2(s[2 * 33], s[3 * 33]); o.z = pk2(s[4 * 33], s[5 * 33]); o.w = pk2(s[6 * 33], s[7 * 33]); }
        const int nr = (n0 + n) < nperm ? pair_row(n0 + n) : (n0 + n);
        *(GAS v4u*)(WT + (size_t)nr * K + k0 + 8 * c) = o; }
    LDS_WAIT(); asm volatile("" ::: "memory");
}
__device__ __forceinline__ void transpose_all(const float* W, const float* gain, int K, int N, bf16* WT, LAS float* scr, int gw, int NGW, int lane, int nperm = 0, bool f16 = false) {
    const int nitems = (K / 64) * (N / 32);
    for (int it = gw; it < nitems; it += NGW) transpose_item(W, gain, K, N, WT, scr, it, lane, nperm, f16);
}
__device__ __forceinline__ void rms_row_bf16(const float* xrow, const float* gain, bf16* orow, float* copy, int lane) {
    const GAS f32x4* xr = (const GAS f32x4*)xrow + lane; const GAS f32x4* gr = (const GAS f32x4*)gain + lane;
    f32x4 v[8]; float s = 0.f;
#pragma unroll
    for (int j = 0; j < 8; ++j) { v[j] = xr[64 * j]; s += (v[j].x * v[j].x + v[j].y * v[j].y) + (v[j].z * v[j].z + v[j].w * v[j].w); }
    const float rstd = 1.0f / sqrtf(wave_sum(s, lane) * (1.f / DM) + EPS);
    if (copy) { GAS f32x4* c4 = (GAS f32x4*)copy + lane;
#pragma unroll
        for (int j = 0; j < 8; ++j) c4[64 * j] = v[j]; }
    GAS unsigned long long* o8 = (GAS unsigned long long*)orow + lane;
#pragma unroll
    for (int j = 0; j < 8; ++j) { const f32x4 g = gr[64 * j];
        o8[64 * j] = (unsigned long long)pk2(v[j].x * rstd * g.x, v[j].y * rstd * g.y) | ((unsigned long long)pk2(v[j].z * rstd * g.z, v[j].w * rstd * g.w) << 32); }
}
__device__ __forceinline__ void prep_row(const float* xrow, bf16* brow, unsigned long long* ss, int lane) {
    const GAS f32x4* xr = (const GAS f32x4*)xrow + lane; GAS unsigned long long* o8 = (GAS unsigned long long*)brow + lane;
    f32x4 v[8]; float s = 0.f;
#pragma unroll
    for (int j = 0; j < 8; ++j) { v[j] = xr[64 * j]; s += (v[j].x * v[j].x + v[j].y * v[j].y) + (v[j].z * v[j].z + v[j].w * v[j].w); }
    s = wave_sum(s, lane);
#pragma unroll
    for (int j = 0; j < 8; ++j) o8[64 * j] = (unsigned long long)pkh(v[j].x, v[j].y) | ((unsigned long long)pkh(v[j].z, v[j].w) << 32);
    if (lane == 0) *ss = (unsigned long long)(s * 1048576.f + 0.5f);
}
__device__ __forceinline__ void final_row(const bf16* brow, float* orow, const float* gain, const unsigned long long* ss, int lane) {
    const GAS unsigned long long* b8 = (const GAS unsigned long long*)brow + lane; GAS f32x4* xr = (GAS f32x4*)orow + lane; const GAS f32x4* gr = (const GAS f32x4*)gain + lane;
    const float rstd = 1.0f / sqrtf((float)*ss * (1.0f / (1048576.f * 2048.f)) + EPS);
#pragma unroll
    for (int j = 0; j < 8; ++j) { const f32x4 g = gr[64 * j]; const unsigned long long w = b8[64 * j];
        const half2k lo = __builtin_bit_cast(half2k, (unsigned)w), hi = __builtin_bit_cast(half2k, (unsigned)(w >> 32));
        f32x4 v; v.x = (float)lo[0]; v.y = (float)lo[1]; v.z = (float)hi[0]; v.w = (float)hi[1];
        xr[64 * j] = v * rstd * g; }
}
__device__ __forceinline__ float bf2f(unsigned short b) { return __builtin_bit_cast(float, (unsigned)b << 16); }
typedef unsigned short us8 __attribute__((ext_vector_type(8)));

typedef const __attribute__((address_space(4))) unsigned long long* kargp_t;
#define P_IN(i) ((const float*)(const GAS float*)kp[(i)])
#define PHASE_PTRS kargp_t kp = (kargp_t)__builtin_amdgcn_kernarg_segment_ptr(); asm volatile("" : "+s"(kp)); unsigned char* ws = (unsigned char*)(GAS unsigned char*)kp[21]; \
    const float* x_prompt = P_IN(0); const float* x_sample = P_IN(1); const float* mem_prompt = P_IN(2); const float* mem_sample = P_IN(3); \
    const float* norm_mix = P_IN(4); const float* a_wqkv = P_IN(5); const float* a_q_gain = P_IN(6); const float* a_k_gain = P_IN(7); const float* a_wo = P_IN(8); \
    const float* b_wqkv = P_IN(9); const float* b_wo = P_IN(10); const float* norm_cross = P_IN(11); const float* norm_mem = P_IN(12); \
    const float* c_wq = P_IN(13); const float* c_wkv = P_IN(14); const float* c_wo = P_IN(15); const float* norm_mlp = P_IN(16); \
    const float* w_up = P_IN(17); const float* w_down = P_IN(18); const float* final_norm = P_IN(19); \
    float* X = (float*)(GAS float*)kp[20]; \
    unsigned long long* SS = (unsigned long long*)(ws + WS_SS); float* COS1 = (float*)(ws + WS_COS1); float* SIN1 = (float*)(ws + WS_SIN1); float* AXT = (float*)(ws + WS_AXT); \
    bf16* MEMN = (bf16*)(ws + WS_MEMN); bf16* CKVT = (bf16*)(ws + WS_CKVT); bf16* CKV = (bf16*)(ws + WS_CKV); \
    bf16* WQKV = (bf16*)(ws + WS_WQKV); bf16* WO = (bf16*)(ws + WS_WO); bf16* CWQ = (bf16*)(ws + WS_CWQ); bf16* CWO = (bf16*)(ws + WS_CWO); \
    bf16* WUP = (bf16*)(ws + WS_WUP); bf16* WDN = (bf16*)(ws + WS_WDN); bf16* HN = (bf16*)(ws + WS_HN); \
    bf16* QKV = (bf16*)(ws + WS_QKV); bf16* HB = (bf16*)(ws + WS_BIG); \
    bf16* OB = (bf16*)(ws + WS_BIG + BIG_OB); bf16* OG = (bf16*)(ws + WS_BIG + BIG_OG); float* LSE = (float*)(ws + WS_BIG + BIG_LSE); \
    bf16* QA = QKV; bf16* KA = QKV + (size_t)MTOK * 2048; bf16* VA = KA + (size_t)MTOK * 512;
struct Args { const float* in[20]; float* out; unsigned char* ws; };
__global__ void __launch_bounds__(NWAVES * 64, 2) fwd_kernel(Args args) {
    extern __shared__ __attribute__((aligned(16))) unsigned char lds[];
    LAS unsigned char* ldsl = (LAS unsigned char*)lds;
    volatile LAS unsigned* MISC = (volatile LAS unsigned*)(ldsl + MISC_OFF);
    const int wave = __builtin_amdgcn_readfirstlane(threadIdx.x >> 6);
#define OPQ_LANE int lane, G = G_k, bx = bx_k; asm volatile("v_mbcnt_lo_u32_b32 %0, -1, 0\n\tv_mbcnt_hi_u32_b32 %0, -1, %0" : "=v"(lane)); asm volatile("" : "+s"(G), "+s"(bx)); const int tid = wave * 64 + lane; const int gw = bx * NWAVES + wave, NGW = G * NWAVES; LAS float* tscr = (LAS float*)(ldsl + wave * 16384)
    const int G_k = gridDim.x, bx_k = blockIdx.x;
    for (int u = threadIdx.x; u < (LDS_BYTES - LDSCTL_OFF) / 4; u += NWAVES * 64) ((LAS unsigned*)(ldsl + LDSCTL_OFF))[u] = 0u;
    __syncthreads();
    XcdBarrier bar = xcd_barrier_post((unsigned*)(args.ws + WS_CTL) + CW_BAR, MISC + 8);
#define GRID_BAR() do { XcdBarrier b2_ = bar; unsigned long long bp_ = (unsigned long long)bar.bar; asm volatile("" : "+s"(bp_), "+s"(b2_.x)); b2_.bar = (unsigned*)(GAS unsigned*)bp_; xcd_barrier(b2_); } while (0)


    if constexpr (PH(0))
    { OPQ_LANE; PHASE_PTRS;
        for (int e = bx * 512 + tid; e < SEQ * 64; e += G * 512) {
            const int t = e >> 6, i = e & 63;
            const double inv = exp2(-(double)i * (13.287712379549449 / 64.0));
            const double a = (double)t * inv, rev = a * 0.15915494309189535; const float fr = (float)(rev - floor(rev));
            COS1[e] = __builtin_amdgcn_cosf(fr); SIN1[e] = __builtin_amdgcn_sinf(fr);
        }
        for (int e = bx * 512 + tid; e < 320 * 32; e += G * 512) {
            const int p = e >> 5, i = e & 31; const int pos = p < 256 ? p : p - 256;
            const double inv = exp2(-(double)i * (13.287712379549449 / 32.0));
            const double a = (double)pos * inv, rev = a * 0.15915494309189535; const float fr = (float)(rev - floor(rev));
            const float c = __builtin_amdgcn_cosf(fr), s = __builtin_amdgcn_sinf(fr);
            if (p < 256) { AXT[p * 32 + i] = c; AXT[8192 + p * 32 + i] = s; } else { AXT[16384 + pos * 32 + i] = c; AXT[16384 + 2048 + pos * 32 + i] = s; }
        }
        for (int r = gw; r < DEPTH * MEMR; r += NGW) { const int l = r / MEMR, m = r % MEMR;
            const float* src = m < 256 ? mem_prompt + (size_t)m * DM : mem_sample + (size_t)(m - 256) * DM;
            rms_row_bf16(src, norm_mem + l * DM, MEMN + (size_t)r * DM, nullptr, lane); }
        for (int l = 0; l < DEPTH; ++l) transpose_all(c_wkv + (size_t)l * DM * 1024, nullptr, DM, 1024, CKVT + (size_t)l * 1024 * DM, tscr, gw, NGW, lane);
    }

    for (int layer = 0; layer < DEPTH; ++layer) {
        const int j = layer >> 1; const bool isA = (layer & 1) == 0;
        if constexpr (PH(1))
        { OPQ_LANE; PHASE_PTRS;
            REPS(3) {
            const float* gmix = norm_mix + layer * DM;
            if (isA) { transpose_all(a_wqkv + (size_t)j * DM * 3072, gmix, DM, 3072, WQKV, tscr, gw, NGW, lane, 0, true); transpose_all(a_wo + (size_t)j * DM * DM, nullptr, DM, DM, WO, tscr, gw, NGW, lane); }
            else { transpose_all(b_wqkv + (size_t)j * DM * 9216, gmix, DM, 9216, WQKV, tscr, gw, NGW, lane, 6144, true); transpose_all(b_wo + (size_t)j * 1024 * DM, nullptr, 1024, DM, WO, tscr, gw, NGW, lane); }
            transpose_all(c_wq + (size_t)layer * DM * 512, norm_cross + layer * DM, DM, 512, CWQ, tscr, gw, NGW, lane, 0, true);
            transpose_all(c_wo + (size_t)layer * 512 * DM, nullptr, 512, DM, CWO, tscr, gw, NGW, lane);
            transpose_all(w_up + (size_t)layer * DM * DFF, norm_mlp + layer * DM, DM, DFF, WUP, tscr, gw, NGW, lane, 0, true);
            transpose_all(w_down + (size_t)layer * DFF * DM, nullptr, DFF, DM, WDN, tscr, gw, NGW, lane);
            if (layer == 0) {
                for (int m = gw; m < MTOK; m += NGW) { const float* src = m < SEQ ? x_prompt + (size_t)m * DM : x_sample + (size_t)(m - SEQ) * DM;
                    prep_row(src, HN + (size_t)m * DM, SS + m, lane); }
            }
            GRID_BAR(); }
        }
        if (PH(2) && layer == 0) { OPQ_LANE; PHASE_PTRS;
            pg8::Gemm g{MEMN, CKVT, DEPTH * MEMR, DEPTH * 1024, DM}; pg8::GroupedOrder S; S.init(G, bx);
            pg8::EpiB<0> E{CKV, 1024, 4, nullptr, nullptr, nullptr, nullptr, nullptr};
            pg8::gemm_phase<pg8::EpiB<0>, pg8::GroupedOrder, GM_ALIGN, GM_SP2>(ldsl, g, S, E, tid);
        }
        if (isA) {
            if constexpr (PH(3))
            { OPQ_LANE; PHASE_PTRS; pg8::Gemm g{HN, WQKV, MTOK, 3072, DM}; pg8::RepOrder S; S.init(MTOK, 3072, G, bx, WGM_QKVA); S.reps = (EXPN == 11) ? 2 : 1;
              pg8::EpiB<1> E{QA, 2048, 1, KA, VA, SS + (size_t)(3 * layer) * MTOK, nullptr, nullptr};
              pg8::gemm_phase<pg8::EpiB<1>, pg8::RepOrder, GM_ALIGN, GM_SP2, true>(ldsl, g, S, E, tid); GRID_BAR(); }
            if constexpr (PH(4))
            { OPQ_LANE; PHASE_PTRS;
                const float* qg = a_q_gain + j * HD; const float* kg = a_k_gain + j * HD;
                const int jl = lane & 15, sub = lane >> 4;
                const long nq = (long)MTOK * 16, nk = (long)MTOK * 4;
                for (long hr4 = nq / 4 + gw; hr4 < (nq + nk) / 4; hr4 += NGW) {
                    long hr = hr4 * 4 + sub; const bool isq = hr < nq; bf16* p; int tok; const float* gp;
                    if (isq) { p = QA + hr * 128; tok = (int)(hr >> 4); gp = qg; } else { hr -= nq; p = KA + hr * 128; tok = (int)(hr >> 2); gp = kg; }
                    const int t = tok & (SEQ - 1), prow = t >> 6, pcol = t & 63;
                    const us8 raw = *(const GAS us8*)(p + jl * 8);
                    float v[8]; float ss = 0.f;
#pragma unroll
                    for (int e = 0; e < 8; ++e) { v[e] = bf2f(raw[e]); ss += v[e] * v[e]; }
                    ss += shflx(ss, 1, lane); ss += shflx(ss, 2, lane); ss += shflx(ss, 4, lane); ss += shflx(ss, 8, lane);
                    const float rstd = 1.0f / sqrtf(ss * (1.f / 128.f) + EPS);
                    const float* ct = (jl < 8) ? AXT + prow * 32 + (jl & 3) * 8 : AXT + 16384 + pcol * 32 + (jl & 3) * 8;
                    const float* st = ct + ((jl < 8) ? 8192 : 2048);
                    const f32x4 g0 = *(const GAS f32x4*)(gp + jl * 8), g1 = *(const GAS f32x4*)(gp + jl * 8 + 4);
                    const f32x4 c0 = *(const GAS f32x4*)ct, c1 = *(const GAS f32x4*)(ct + 4), s0 = *(const GAS f32x4*)st, s1 = *(const GAS f32x4*)(st + 4);
                    const float sgn = (jl & 4) ? 1.f : -1.f;
                    float o[8];
#pragma unroll
                    for (int e = 0; e < 8; ++e) { const float y = v[e] * rstd * (e < 4 ? g0[e] : g1[e - 4]); const float pr = shflx(y, 4, lane);
                        const float c = e < 4 ? c0[e] : c1[e - 4], s = e < 4 ? s0[e] : s1[e - 4]; o[e] = y * c + sgn * pr * s; }
                    v4u w; w.x = pk2(o[0], o[1]); w.y = pk2(o[2], o[3]); w.z = pk2(o[4], o[5]); w.w = pk2(o[6], o[7]);
                    *(GAS v4u*)(p + jl * 8) = w;
                }
                GRID_BAR();
            }
            if constexpr (PH(5))
            { OPQ_LANE; PHASE_PTRS;
                float gqm = 0.f, gkm = 0.f;
                for (int d = 0; d < HD; ++d) { gqm = fmaxf(gqm, fabsf(a_q_gain[j * HD + d])); gkm = fmaxf(gkm, fabsf(a_k_gain[j * HD + d])); }
                const float bnd = gqm * gkm * (128.f * da::CQ * 1.02f) + 0.5f;
                REPS(1) {
                for (int u = bx; u < NSEQ * 16 * 64; u += G) {
                    const int qb = u & 63, hg = (u >> 6) & 3, kvh = (u >> 8) & 3, b = u >> 10, h = kvh * 4 + hg;
                    const size_t qoff = ((size_t)b * SEQ + (size_t)qb * 256) * 2048 + h * 128;
                    const bf16* Kh = KA + (size_t)b * SEQ * 512 + kvh * 128; const bf16* Vh = VA + (size_t)b * SEQ * 512 + kvh * 128;
                    da::attn_dense_stg<2048, 512, 2048>(QA + qoff, Kh, Vh, HB + qoff, SEQ, (char*)lds, ldsl, wave, a_q_gain + j * HD, AXT, qb * 256, bnd);
                }
                GRID_BAR(); }
            }
            if constexpr (PH(6))
            { OPQ_LANE; PHASE_PTRS; pg8::Gemm g{HB, WO, MTOK, DM, DM}; pg8::StaticOrder S; S.init(MTOK, DM, G, bx);
              pg8::EpiRes E{HN, SS + (size_t)(3 * layer + 1) * MTOK, DM, 0};
              pg8::gemm_phase<pg8::EpiRes, pg8::StaticOrder, GM_ALIGN, GM_SP2>(ldsl, g, S, E, tid); GRID_BAR(); }
        } else {
            for (int sq = 0; sq <= NSEQ; ++sq) {
                if constexpr (PH(7)) if (sq < NSEQ)
                { OPQ_LANE; PHASE_PTRS; pg8::Gemm g{HN + (size_t)sq * SEQ * DM, WQKV, SEQ, 9216, DM}; pg8::RepOrder S; S.init(SEQ, 9216, G, bx, WGM_QKVB); S.reps = (EXPN == 10) ? 2 : 1;
                  pg8::EpiB<2> E{QKV, 1024, 1, nullptr, nullptr, SS + (size_t)(3 * layer) * MTOK + (size_t)sq * SEQ, COS1, SIN1};
                  pg8::gemm_phase<pg8::EpiB<2>, pg8::RepOrder, GM_ALIGN, GM_SP2, true>(ldsl, g, S, E, tid); }
                if constexpr (PH(10)) if (sq > 0)
                { OPQ_LANE; PHASE_PTRS;
                    const int jl = lane & 15, sub = lane >> 4;
                    REPS(7) {
                    for (int r4 = gw; r4 < SEQ * 8 / 4; r4 += NGW) {
                        const int rr = r4 * 4 + sub, t = rr >> 3, h = rr & 7;
                        float ls[3]; us8 ov[3];
#pragma unroll
                        for (int g = 0; g < 3; ++g) { const int shift = 2 * g; const int pp = ((t & ((1 << shift) - 1)) << (14 - shift)) + (t >> shift);
                            ls[g] = LSE[(size_t)g * SEQ * 8 + (size_t)pp * 8 + h]; ov[g] = *(const GAS us8*)(OG + (size_t)g * SEQ * 1024 + (size_t)pp * 1024 + h * 128 + jl * 8); }
                        const float mx = fmaxf(ls[0], fmaxf(ls[1], ls[2]));
                        float w0 = __expf(ls[0] - mx), w1 = __expf(ls[1] - mx), w2 = __expf(ls[2] - mx); const float inv = 1.f / (w0 + w1 + w2); w0 *= inv; w1 *= inv; w2 *= inv;
                        float o[8];
#pragma unroll
                        for (int e = 0; e < 8; ++e) o[e] = w0 * bf2f(ov[0][e]) + w1 * bf2f(ov[1][e]) + w2 * bf2f(ov[2][e]);
                        v4u w; w.x = pk2(o[0], o[1]); w.y = pk2(o[2], o[3]); w.z = pk2(o[4], o[5]); w.w = pk2(o[6], o[7]);
                        *(GAS v4u*)(OB + ((size_t)(sq - 1) * SEQ + t) * 1024 + h * 128 + jl * 8) = w;
                    }
                    }
                }
                { OPQ_LANE; GRID_BAR(); }
                if constexpr (PH(9)) if (sq < NSEQ)
                { OPQ_LANE; PHASE_PTRS;
                    REPS(4) {
                    for (int u = bx; u < 3 * 8 * (SEQ / 256); u += G) {
                        const int blkq = u & 63, gh = u >> 6, g = gh >> 3, h = gh & 7, q0 = blkq * 256;
                        const int seglen = SEQ >> (2 * g), seg_lo = q0 & ~(seglen - 1), seg_hi = seg_lo + seglen;
                        const size_t blk = (size_t)SEQ * 1024;
                        ba::battn_wg_unit(QKV + (size_t)g * blk, QKV + (size_t)(3 + g) * blk, QKV + (size_t)(6 + g) * blk, OG + (size_t)g * blk, LSE + (size_t)g * SEQ * 8,
                                          q0, seg_lo, seg_hi, h, (char*)lds, ldsl, wave);
                    }
                    GRID_BAR(); }
                }
            }
            if constexpr (PH(11))
            { OPQ_LANE; PHASE_PTRS; pg8::Gemm g{OB, WO, MTOK, DM, 1024}; pg8::StaticOrder S; S.init(MTOK, DM, G, bx);
              pg8::EpiRes E{HN, SS + (size_t)(3 * layer + 1) * MTOK, DM, 0};
              pg8::gemm_phase<pg8::EpiRes, pg8::StaticOrder, GM_ALIGN, GM_SP2>(ldsl, g, S, E, tid); GRID_BAR(); }
        }
        if constexpr (PH(13))
        { OPQ_LANE; PHASE_PTRS; pg8::Gemm g{HN, CWQ, MTOK, 512, DM}; pg8::StaticOrder S; S.init(MTOK, 512, G, bx);
          pg8::EpiB<0> E{QKV, 512, 1 << 20, nullptr, nullptr, SS + (size_t)(3 * layer + 1) * MTOK, nullptr, nullptr};
          pg8::gemm_phase<pg8::EpiB<0>, pg8::StaticOrder, GM_ALIGN, GM_SP2, true>(ldsl, g, S, E, tid); GRID_BAR(); }
        if constexpr (PH(14))
        { OPQ_LANE; PHASE_PTRS;
            const bf16* ckv = CKV + (size_t)layer * MEMR * 1024;
            REPS(2) {
            for (int u = bx; u < NSEQ * 4 * 64; u += G) {
                const int qb = u & 63, h = (u >> 6) & 3, b = u >> 8;
                const size_t qoff = ((size_t)b * SEQ + (size_t)qb * 256) * 512 + h * 128;
                const bf16* Kh = ckv + (size_t)b * 256 * 1024 + h * 128; const bf16* Vh = Kh + 512;
                da::attn_dense_body<512, 1024, 512, false>(QKV + qoff, Kh, Vh, HB + qoff, 256, (char*)lds, ldsl, wave);
            }
            GRID_BAR(); }
        }
        if constexpr (PH(15))
        { OPQ_LANE; PHASE_PTRS; pg8::Gemm g{HB, CWO, MTOK, DM, 512}; pg8::StaticOrder S; S.init(MTOK, DM, G, bx);
          pg8::EpiRes E{HN, SS + (size_t)(3 * layer + 2) * MTOK, DM, 0};
          pg8::gemm_phase<pg8::EpiRes, pg8::StaticOrder, GM_ALIGN, GM_SP2>(ldsl, g, S, E, tid); GRID_BAR(); }
        for (int ch = 0; ch <= MTOK / MLPC; ++ch) {
            if constexpr (PH(18)) if (ch > 0)
            { OPQ_LANE; PHASE_PTRS; const int c = ch - 1; pg8::Gemm g{HB + (size_t)(c & 1) * MLPC * DFF, WDN, MLPC, DM, DFF}; pg8::StaticOrder S; S.init(MLPC, DM, G, bx);
              if (EXPN == 6) {
                  pg8::EpiRes E2{(bf16*)(ws + WS_END + 64 * MiB), (unsigned long long*)(ws + WS_END + 96 * MiB), DM, 0};
                  pg8::gemm_phase<pg8::EpiRes, pg8::StaticOrder, GM_ALIGN, GM_SP2>(ldsl, g, S, E2, tid); }
              pg8::EpiRes E{HN, SS + (size_t)(3 * layer + 3) * MTOK, DM, c * MLPC};
              pg8::gemm_phase<pg8::EpiRes, pg8::StaticOrder, GM_ALIGN, GM_SP2>(ldsl, g, S, E, tid); }
            if constexpr (PH(17)) if (ch < MTOK / MLPC)
            { OPQ_LANE; PHASE_PTRS; pg8::Gemm g{HN + (size_t)ch * MLPC * DM, WUP, MLPC, DFF, DM}; pg8::RepOrder S; S.init(MLPC, DFF, G, bx); S.reps = (EXPN == 5) ? 2 : 1;
              pg8::EpiB<3> E{HB + (size_t)(ch & 1) * MLPC * DFF, DFF, 1 << 20, nullptr, nullptr, SS + (size_t)(3 * layer + 2) * MTOK + (size_t)ch * MLPC, nullptr, nullptr};
              pg8::gemm_phase<pg8::EpiB<3>, pg8::RepOrder, GM_ALIGN, GM_SP2, true>(ldsl, g, S, E, tid); }
            GRID_BAR();
        }
    }
    if constexpr (PH(19)) { OPQ_LANE; PHASE_PTRS;
    for (int m = gw; m < MTOK; m += NGW) final_row(HN + (size_t)m * DM, X + (size_t)m * DM, final_norm, SS + (size_t)12 * MTOK + m, lane); }
}

extern "C" void kernel_launch(void* const* d_in, const int* in_sizes, int n_in, void* d_out, int out_size, void* d_ws, size_t ws_size, hipStream_t stream) {
    static int grid = 0;
    if (grid == 0) {
        if (n_in != 20 || out_size != MTOK * DM || ws_size < WS_END) { fprintf(stderr, "kernel_launch: unexpected shapes: n_in %d out %d ws %zu (need %zu)\n", n_in, out_size, ws_size, (size_t)WS_END); grid = -1; return; }
        int dev = 0, cus = 0, per_cu = 0;
        if (hipGetDevice(&dev) != hipSuccess || hipDeviceGetAttribute(&cus, hipDeviceAttributeMultiprocessorCount, dev) != hipSuccess) { grid = -1; return; }
        if (hipFuncSetAttribute((const void*)fwd_kernel, hipFuncAttributeMaxDynamicSharedMemorySize, LDS_BYTES) != hipSuccess) { fprintf(stderr, "kernel_launch: hipFuncSetAttribute failed\n"); grid = -1; return; }
        if (hipOccupancyMaxActiveBlocksPerMultiprocessor(&per_cu, (const void*)fwd_kernel, NWAVES * 64, LDS_BYTES) != hipSuccess || per_cu < 1)
            fprintf(stderr, "kernel_launch: note: occupancy query reports %d workgroups per CU\n", per_cu);
        (void)hipGetLastError();
        grid = cus;
    }
    if (grid < 0) return;
    if (hipMemsetAsync((char*)d_ws + WS_CTL, 0, CTL_ZERO_BYTES, stream) != hipSuccess) { fprintf(stderr, "kernel_launch: memset failed\n"); return; }
    Args a{};
    for (int i = 0; i < 20; ++i) a.in[i] = (const float*)d_in[i];
    a.out = (float*)d_out; a.ws = (unsigned char*)d_ws;
    hipLaunchKernelGGL(fwd_kernel, dim3(grid), dim3(NWAVES * 64), LDS_BYTES, stream, a);
    const hipError_t le = hipPeekAtLastError();
    if (le != hipSuccess) fprintf(stderr, "kernel_launch: launch failed: %s\n", hipGetErrorName(le));
}
```

```cpp
#include <hip/hip_runtime.h>
#include <cstdio>
#include <cstdint>
namespace pg8 {
#define PG8_LAS __attribute__((address_space(3)))
typedef unsigned short bf16_t;
typedef short bf16x8 __attribute__((ext_vector_type(8)));
typedef float f32x4 __attribute__((ext_vector_type(4)));
typedef unsigned u32x4 __attribute__((ext_vector_type(4)));
constexpr int BM = 256, BK = 64, HALF = 128, HTB = HALF * BK * 2  , STAGE_BYTES = 8 * HTB, NXCD = 8, WGM = 4;

__host__ __device__ __forceinline__ int lds_byte(int r, int c) { const int st = (r >> 4) * 2 + (c >> 5), rr = r & 15, cc = c & 31, ob = rr * 64 + cc * 2; return st * 1024 + (ob ^ (((ob >> 9) & 1) << 5)); }
__host__ __device__ __forceinline__ void stage_rc(int b, int& R, int& C) { const int st = b / 1024, sb = b % 1024, swz = sb ^ (((sb >> 9) & 1) << 5); R = (st >> 1) * 16 + swz / 64; C = (st & 1) * 32 + (swz % 64) / 2; }
__host__ __device__ __forceinline__ int perm32(int rho) { const int n = rho >> 4, i = rho & 15; return 8 * (i >> 2) + 4 * n + (i & 3); }

struct Unit { int pm, pn; };
struct Gemm { const bf16_t* A; const bf16_t* Bt; int M, N, K; };

struct StaticOrder {
    int nM, nN, nwg, G, c, wgm;
    __host__ __device__ void init(int M, int N, int G_, int c_, int wgm_ = WGM) { nM = M / BM; nN = N / BM; nwg = nM * nN; G = G_; c = c_; wgm = wgm_; }
    __host__ __device__ bool next(int i, Unit& u) const {
        const long L = (long)i * G + c; if (L >= nwg) return false;
        int wgid = (int)L; { const int q = nwg / NXCD, r = nwg % NXCD, xcd = wgid % NXCD, off = wgid / NXCD; wgid = (xcd < r ? xcd * (q + 1) : r * (q + 1) + (xcd - r) * q) + off; }
        const int nig = wgm * nN, gid = wgid / nig, fm = gid * wgm, gsz = (nM - fm) < wgm ? (nM - fm) : wgm;
        u.pm = fm + ((wgid % nig) % gsz); u.pn = (wgid % nig) / gsz; return true;
    }
    __device__ __forceinline__ void a_ready(const Unit&) const {}
    __device__ __forceinline__ void done(const Unit&) const {}
};

__device__ __forceinline__ unsigned cvt_pk_bf16(float lo, float hi) { unsigned r; asm volatile("v_cvt_pk_bf16_f32 %0, %1, %2" : "=v"(r) : "v"(lo), "v"(hi)); return r; }
typedef float f32x2 __attribute__((ext_vector_type(2)));
__device__ __forceinline__ f32x2 gelu_pk(f32x2 v) {
    const f32x2 av = __builtin_elementwise_abs(v), d = av * 0.2316418882f + 1.0f;
    f32x2 t; t.x = __builtin_amdgcn_rcpf(d.x); t.y = __builtin_amdgcn_rcpf(d.y);
    f32x2 q = t * 0.5307027145f + (-0.7265760135f); q = q * t + 0.7107068705f; q = q * t + (-0.142248368f); q = q * t + 0.127414796f; q = q * t;
    const f32x2 s = (v * v) * (-0.72134752044f);
    f32x2 e; e.x = __builtin_amdgcn_exp2f(s.x); e.y = __builtin_amdgcn_exp2f(s.y);
    const f32x2 m = v * (q * e), r = v - m;
    f32x2 o; o.x = v.x < 0.f ? m.x : r.x; o.y = v.y < 0.f ? m.y : r.y; return o;
}

template <int ACT  > struct EpiBf16 {
    static constexpr bool PERM = true, AFTER_DRAIN = false; static_assert(ACT == 0 || ACT == 1, "EpiBf16: ACT is 0 (none) or 1 (gelu_pk)");
    bf16_t* O; int ldc; const float* bias; int split_cols; size_t split_stride; float scale0;
    __device__ __forceinline__ void operator()(const f32x4 (&acc)[2][2][4][2], const Unit& u, int wr, int wc, int fr, int fq) const {
        const int row0 = u.pm * BM + wr * 64 + fr; int colt = u.pn * BM; bf16_t* base = O;
        float sc = 1.f; if (split_cols) { const int t = colt / split_cols; base += (size_t)t * split_stride; colt -= t * split_cols; if (t == 0) sc = scale0; }
        const int col0 = colt + wc * 32 + 8 * fq, bcol0 = u.pn * BM + wc * 32 + 8 * fq;
        f32x4 bv[2][2];
#pragma unroll
        for (int bj = 0; bj < 2; ++bj)
#pragma unroll
            for (int n = 0; n < 2; ++n) bv[bj][n] = bias ? *(const f32x4*)(bias + bcol0 + bj * HALF + 4 * n) : (f32x4){0.f, 0.f, 0.f, 0.f};
#pragma unroll
        for (int ai = 0; ai < 2; ++ai)
#pragma unroll
            for (int m = 0; m < 4; ++m) { bf16_t* rowp = base + (size_t)(row0 + ai * HALF + m * 16) * ldc + col0;
#pragma unroll
                for (int bj = 0; bj < 2; ++bj) { f32x4 v0 = acc[ai][bj][m][0] + bv[bj][0], v1 = acc[ai][bj][m][1] + bv[bj][1];
                    if (ACT == 1) { f32x2 a = gelu_pk((f32x2){v0[0], v0[1]}), b = gelu_pk((f32x2){v0[2], v0[3]}), c = gelu_pk((f32x2){v1[0], v1[1]}), d = gelu_pk((f32x2){v1[2], v1[3]});
                        v0 = (f32x4){a.x, a.y, b.x, b.y}; v1 = (f32x4){c.x, c.y, d.x, d.y}; }
                    v0 = v0 * sc; v1 = v1 * sc; u32x4 w; w.x = cvt_pk_bf16(v0[0], v0[1]); w.y = cvt_pk_bf16(v0[2], v0[3]); w.z = cvt_pk_bf16(v1[0], v1[1]); w.w = cvt_pk_bf16(v1[2], v1[3]);
                    *(u32x4*)(rowp + bj * HALF) = w; } }
    }
};

template <int MODE> struct EpiB {
    static constexpr bool PERM = true, AFTER_DRAIN = false;
    bf16_t* O; int ldc; int pn_mod; bf16_t* O2; bf16_t* O3;
    const unsigned long long* SS;
    const float* cs; const float* sn;
    __device__ __forceinline__ void operator()(const f32x4 (&acc)[2][2][4][2], const Unit& u, int wr, int wc, int fr, int fq) const {
        const int row0 = u.pm * BM + wr * 64 + fr;
        bf16_t* base = O; int ld = ldc, colt = 0, shift = 0, which = 2;
        if constexpr (MODE == 0 || MODE == 3) { colt = (u.pn % pn_mod) * BM; }
        if constexpr (MODE == 1) {
            if (u.pn < 8) { base = O; ld = 2048; colt = u.pn * BM; }
            else if (u.pn < 10) { base = O2; ld = 512; colt = (u.pn - 8) * BM; }
            else { base = O3; ld = 512; colt = (u.pn - 10) * BM; }
        }
        if constexpr (MODE == 2) {
            which = u.pn / 12; const int g = (u.pn % 12) / 4; colt = (u.pn % 4) * BM; ld = 1024; shift = 2 * g;
            base = O + (size_t)(which * 3 + g) * ((size_t)16384 * 1024);
        }
        const int col0 = colt + wc * 32 + 8 * fq;
        const int rcol = colt + (wc >> 1) * 128 + (wc & 1) * 32 + 8 * fq, rdim = (wc & 1) * 32 + 8 * fq;
#pragma unroll
        for (int ai = 0; ai < 2; ++ai)
#pragma unroll
            for (int m = 0; m < 4; ++m) {
                int r = row0 + ai * HALF + m * 16;
                float rs = 1.f;
                if (SS) rs = __builtin_amdgcn_rsqf((float)SS[r] * (1.0f / (1048576.f * 2048.f)) + 1e-6f);
                const int t = r;
                if constexpr (MODE == 2) r = ((r & ((1 << shift) - 1)) << (14 - shift)) + (r >> shift);
                if (MODE == 2 && which < 2) {
                    const f32x4 c0 = *(const f32x4*)(cs + t * 64 + rdim), c1 = *(const f32x4*)(cs + t * 64 + rdim + 4), s0 = *(const f32x4*)(sn + t * 64 + rdim), s1 = *(const f32x4*)(sn + t * 64 + rdim + 4);
                    const f32x4 l0 = acc[ai][0][m][0] * rs, l1 = acc[ai][0][m][1] * rs, h0 = acc[ai][1][m][0] * rs, h1 = acc[ai][1][m][1] * rs;
                    const f32x4 ol0 = l0 * c0 - h0 * s0, ol1 = l1 * c1 - h1 * s1, oh0 = h0 * c0 + l0 * s0, oh1 = h1 * c1 + l1 * s1;
                    bf16_t* rowp = base + (size_t)r * ld + rcol;
                    u32x4 w; w.x = cvt_pk_bf16(ol0[0], ol0[1]); w.y = cvt_pk_bf16(ol0[2], ol0[3]); w.z = cvt_pk_bf16(ol1[0], ol1[1]); w.w = cvt_pk_bf16(ol1[2], ol1[3]);
                    *(u32x4*)rowp = w;
                    w.x = cvt_pk_bf16(oh0[0], oh0[1]); w.y = cvt_pk_bf16(oh0[2], oh0[3]); w.z = cvt_pk_bf16(oh1[0], oh1[1]); w.w = cvt_pk_bf16(oh1[2], oh1[3]);
                    *(u32x4*)(rowp + 64) = w;
                } else {
                bf16_t* rowp = base + (size_t)r * ld + col0;
#pragma unroll
                for (int bj = 0; bj < 2; ++bj) { f32x4 v0 = acc[ai][bj][m][0] * rs, v1 = acc[ai][bj][m][1] * rs;
                    if constexpr (MODE == 3) {
#pragma unroll
                        for (int e = 0; e < 4; ++e) { const float a = fmaxf(v0[e], 0.f), b = fmaxf(v1[e], 0.f); v0[e] = a * a; v1[e] = b * b; }
                    }
                    u32x4 w; w.x = cvt_pk_bf16(v0[0], v0[1]); w.y = cvt_pk_bf16(v0[2], v0[3]); w.z = cvt_pk_bf16(v1[0], v1[1]); w.w = cvt_pk_bf16(v1[2], v1[3]);
                    *(u32x4*)(rowp + bj * HALF) = w; }
                }
            }
    }
};
typedef _Float16 half2v __attribute__((ext_vector_type(2)));
__device__ __forceinline__ unsigned pk_half(float lo, float hi) { const half2v v = {(_Float16)lo, (_Float16)hi}; return __builtin_bit_cast(unsigned, v); }
struct EpiRes {
    static constexpr bool PERM = true, AFTER_DRAIN = false;
    bf16_t* XB; unsigned long long* SS; int ldc; int row_off;
    __device__ __forceinline__ void operator()(const f32x4 (&acc)[2][2][4][2], const Unit& u, int wr, int wc, int fr, int fq) const {
        const int row0 = row_off + u.pm * BM + wr * 64 + fr, col0 = u.pn * BM + wc * 32 + 8 * fq;
        const int lane = fq * 16 + fr;
#pragma unroll
        for (int ai = 0; ai < 2; ++ai)
#pragma unroll
            for (int m = 0; m < 4; ++m) { const int row = row0 + ai * HALF + m * 16; bf16_t* rowb = XB + (size_t)row * ldc + col0;
                u32x4 xo[2];
#pragma unroll
                for (int bj = 0; bj < 2; ++bj) xo[bj] = *(const u32x4*)(rowb + bj * HALF);
                float s = 0.f;
#pragma unroll
                for (int bj = 0; bj < 2; ++bj) { float v[8];
#pragma unroll
                    for (int e = 0; e < 4; ++e) { const unsigned wv = xo[bj][e]; const half2v h = __builtin_bit_cast(half2v, wv);
                        v[2 * e] = (float)h[0] + acc[ai][bj][m][e >> 1][(2 * e) & 3];
                        v[2 * e + 1] = (float)h[1] + acc[ai][bj][m][e >> 1][(2 * e + 1) & 3]; }
#pragma unroll
                    for (int e = 0; e < 8; ++e) s += v[e] * v[e];
                    u32x4 w; w.x = pk_half(v[0], v[1]); w.y = pk_half(v[2], v[3]); w.z = pk_half(v[4], v[5]); w.w = pk_half(v[6], v[7]);
                    *(u32x4*)(rowb + bj * HALF) = w; }
                s += __builtin_bit_cast(float, __builtin_amdgcn_ds_bpermute((lane ^ 16) << 2, __builtin_bit_cast(int, s)));
                s += __builtin_bit_cast(float, __builtin_amdgcn_ds_bpermute((lane ^ 32) << 2, __builtin_bit_cast(int, s)));
                if (fq == 0) __hip_atomic_fetch_add(SS + row, (unsigned long long)(s * 1048576.f + 0.5f), __ATOMIC_RELAXED, __HIP_MEMORY_SCOPE_AGENT); }
    }
};
struct GroupedOrder {
    int G, c;
    __host__ __device__ void init(int G_, int c_) { G = G_; c = c_; }
    __host__ __device__ bool next(int i, Unit& u) const {
        const int L = i * G + c; if (L >= 48) return false;
        const int layer = L / 12, rem = L % 12; u.pm = layer * 3 + rem % 3; u.pn = layer * 4 + rem / 3; return true;
    }
    __device__ __forceinline__ void a_ready(const Unit&) const {}
    __device__ __forceinline__ void done(const Unit&) const {}
};
struct RepOrder : StaticOrder {
    int reps;
    __host__ __device__ bool next(int i, Unit& u) const { const int rounds = nwg / G; if (i >= rounds * reps) return false; return StaticOrder::next(i % rounds, u); }
};
typedef _Float16 half8 __attribute__((ext_vector_type(8)));
template <class Epi, class Sched, bool ALIGN_EPI = false, bool SP2 = false, bool F16IN = false>
__device__ __forceinline__ void gemm_phase(PG8_LAS unsigned char* lds, const Gemm g, const Sched& S, const Epi& E, const int tid) {
    const int wid = __builtin_amdgcn_readfirstlane(tid >> 6), lane = tid & 63, wr = wid >> 2, wc = wid & 3, fr = lane & 15, fq = lane >> 4;
    const int K = g.K, nt = K / BK;
    unsigned voffA[2], voffB[2];
#pragma unroll
    for (int i = 0; i < 2; ++i) { int R, C; stage_rc(tid * 16 + i * 8192, R, C); const int Rb = Epi::PERM ? ((R & ~31) + perm32(R & 31)) : R;
        voffA[i] = (unsigned)(R * K + C) * 2u; voffB[i] = (unsigned)(Rb * K + C) * 2u; }
    const size_t kstep = (size_t)(BK * 2);
    const size_t hstep = (size_t)HALF * K * 2;
    const size_t tstep = 2 * hstep;
    const unsigned ldsw = (unsigned)wid * 1024u;
    const int aoff = lds_byte(wr * 64 + fr, fq * 8), boff = lds_byte(wc * 32 + fr, fq * 8);
#define PG8_SA(b, h) (((b) * 2 + (h)) * HTB)
#define PG8_SB(b, h) ((4 + (b) * 2 + (h)) * HTB)
#define PG8_STAGE(bufoff, gbase, voff) do { unsigned long long gi_ = (unsigned long long)(gbase); asm volatile("" : "+s"(gi_)); const __attribute__((address_space(1))) char* gb_ = (const __attribute__((address_space(1))) char*)gi_; _Pragma("unroll") for (int _i = 0; _i < 2; ++_i) \
        __builtin_amdgcn_global_load_lds((const __attribute__((address_space(1))) unsigned*)(gb_ + (voff)[_i]), (PG8_LAS unsigned*)(lds + (bufoff) + ldsw + _i * 8192), 16, 0, 0); } while (0)
#define PG8_LDA(dst, b, h) do { _Pragma("unroll") for (int m = 0; m < 4; ++m) _Pragma("unroll") for (int k = 0; k < 2; ++k) dst[m][k] = *(const PG8_LAS bf16x8*)(lds + PG8_SA(b, h) + aoff + m * 2048 + k * 1024); } while (0)
#define PG8_LDB(dst, b, h) do { _Pragma("unroll") for (int n = 0; n < 2; ++n) _Pragma("unroll") for (int k = 0; k < 2; ++k) dst[n][k] = *(const PG8_LAS bf16x8*)(lds + PG8_SB(b, h) + boff + n * 2048 + k * 1024); } while (0)
#define PG8_MMA(ai, bj, At, Bt) do { __builtin_amdgcn_s_setprio(1); _Pragma("unroll") for (int m = 0; m < 4; ++m) _Pragma("unroll") for (int n = 0; n < 2; ++n) _Pragma("unroll") for (int k = 0; k < 2; ++k) \
        { if constexpr (F16IN) acc[ai][bj][m][n] = __builtin_amdgcn_mfma_f32_16x16x32_f16(__builtin_bit_cast(half8, Bt[n][k]), __builtin_bit_cast(half8, At[m][k]), acc[ai][bj][m][n], 0, 0, 0); \
          else acc[ai][bj][m][n] = __builtin_amdgcn_mfma_f32_16x16x32_bf16(Bt[n][k], At[m][k], acc[ai][bj][m][n], 0, 0, 0); } __builtin_amdgcn_s_setprio(0); } while (0)
#define PG8_WAIT_V(n) asm volatile("s_waitcnt vmcnt(" #n ")" ::: "memory")
#define PG8_WAIT_L(n) asm volatile("s_waitcnt lgkmcnt(" #n ")" ::: "memory")
#define PG8_BAR __builtin_amdgcn_s_barrier()
#define PG8_SCHED __builtin_amdgcn_sched_barrier(0)
    Unit cur, nxt; int ui = 0;
    if (!S.next(0, cur)) return;
    f32x4 acc[2][2][4][2];
#pragma unroll
    for (int a = 0; a < 2; ++a)
#pragma unroll
        for (int b = 0; b < 2; ++b)
#pragma unroll
            for (int m = 0; m < 4; ++m)
#pragma unroll
                for (int n = 0; n < 2; ++n) acc[a][b][m][n] = (f32x4){0.f, 0.f, 0.f, 0.f};
    bf16x8 At[4][2], B0[2][2], B1[2][2];
    const char* cA = (const char*)g.A + (size_t)cur.pm * tstep; const char* cB = (const char*)g.Bt + (size_t)cur.pn * tstep;
    S.a_ready(cur);
    if constexpr (SP2) {
        PG8_STAGE(PG8_SB(0, 0), cB, voffB); PG8_STAGE(PG8_SB(0, 1), cB + hstep, voffB); PG8_STAGE(PG8_SA(0, 0), cA, voffA); PG8_STAGE(PG8_SA(0, 1), cA + hstep, voffA);
        if (wr == 1) PG8_BAR;
        PG8_WAIT_V(2); PG8_BAR;
        PG8_STAGE(PG8_SB(1, 0), cB + kstep, voffB); PG8_STAGE(PG8_SA(1, 0), cA + kstep, voffA); PG8_STAGE(PG8_SB(1, 1), cB + hstep + kstep, voffB);
        PG8_WAIT_V(6); PG8_BAR;
    } else {
        PG8_STAGE(PG8_SB(0, 0), cB, voffB); PG8_STAGE(PG8_SA(0, 0), cA, voffA); PG8_STAGE(PG8_SB(0, 1), cB + hstep, voffB); PG8_STAGE(PG8_SA(0, 1), cA + hstep, voffA);
        if (wr == 1) PG8_BAR;
        PG8_WAIT_V(4); PG8_BAR;
        PG8_STAGE(PG8_SB(1, 0), cB + kstep, voffB); PG8_STAGE(PG8_SA(1, 0), cA + kstep, voffA); PG8_STAGE(PG8_SB(1, 1), cB + hstep + kstep, voffB);
        PG8_WAIT_V(6); PG8_BAR;
    }
    for (;;) {
        const bool has_next = S.next(ui + 1, nxt);
        const char* nA = has_next ? (const char*)g.A + (size_t)nxt.pm * tstep : cA; const char* nB = has_next ? (const char*)g.Bt + (size_t)nxt.pn * tstep : cB;
        for (int t = 0; t < nt; t += 2) {
            asm volatile("" : "+v"(voffA[0]), "+v"(voffA[1]), "+v"(voffB[0]), "+v"(voffB[1]));
            const bool last = (t == nt - 2);
            const char* a1 = cA + (size_t)(t + 1) * kstep;
            const char* a2 = last ? nA : cA + (size_t)(t + 2) * kstep; const char* b2 = last ? nB : cB + (size_t)(t + 2) * kstep;
            const char* a3 = a2 + kstep; const char* b3 = b2 + kstep;
            if (last && has_next) S.a_ready(nxt);
            if constexpr (SP2) {
            PG8_LDB(B0, 0, 0); PG8_LDB(B1, 0, 1); PG8_SCHED; PG8_LDA(At, 0, 0); PG8_STAGE(PG8_SA(1, 1), a1 + hstep, voffA);
            PG8_WAIT_V(8); PG8_WAIT_L(0); PG8_BAR; PG8_MMA(0, 0, At, B0); PG8_MMA(0, 1, At, B1); PG8_BAR; PG8_SCHED;
            PG8_LDA(At, 0, 1); PG8_STAGE(PG8_SB(0, 0), b2, voffB); PG8_STAGE(PG8_SB(0, 1), b2 + hstep, voffB); PG8_STAGE(PG8_SA(0, 0), a2, voffA);
            PG8_WAIT_V(8); PG8_WAIT_L(0); PG8_BAR; PG8_MMA(1, 0, At, B0); PG8_MMA(1, 1, At, B1); PG8_BAR; PG8_SCHED;
            PG8_LDB(B0, 1, 0); PG8_LDB(B1, 1, 1); PG8_SCHED; PG8_LDA(At, 1, 0); PG8_STAGE(PG8_SA(0, 1), a2 + hstep, voffA);
            PG8_WAIT_V(8); PG8_WAIT_L(0); PG8_BAR; PG8_MMA(0, 0, At, B0); PG8_MMA(0, 1, At, B1); PG8_BAR; PG8_SCHED;
            PG8_LDA(At, 1, 1); PG8_STAGE(PG8_SB(1, 0), b3, voffB); PG8_STAGE(PG8_SB(1, 1), b3 + hstep, voffB); PG8_STAGE(PG8_SA(1, 0), a3, voffA);
            PG8_WAIT_V(8); PG8_WAIT_L(0); PG8_BAR; PG8_MMA(1, 0, At, B0); PG8_MMA(1, 1, At, B1); PG8_BAR; PG8_SCHED;
            } else {
            PG8_LDB(B0, 0, 0); PG8_SCHED; PG8_LDA(At, 0, 0); PG8_STAGE(PG8_SA(1, 1), a1 + hstep, voffA);
            PG8_WAIT_L(8); PG8_BAR; PG8_WAIT_L(0); PG8_MMA(0, 0, At, B0); PG8_BAR; PG8_SCHED;
            PG8_LDB(B1, 0, 1); PG8_STAGE(PG8_SB(0, 0), b2, voffB);
            PG8_BAR; PG8_WAIT_L(0); PG8_MMA(0, 1, At, B1); PG8_BAR;
            PG8_LDA(At, 0, 1); PG8_STAGE(PG8_SA(0, 0), a2, voffA);
            PG8_BAR; PG8_WAIT_L(0); PG8_MMA(1, 0, At, B0); PG8_BAR; PG8_SCHED;
            PG8_STAGE(PG8_SB(0, 1), b2 + hstep, voffB);
            PG8_WAIT_V(6); PG8_BAR; PG8_MMA(1, 1, At, B1); PG8_BAR;
            PG8_LDB(B0, 1, 0); PG8_SCHED; PG8_LDA(At, 1, 0); PG8_STAGE(PG8_SA(0, 1), a2 + hstep, voffA);
            PG8_WAIT_L(8); PG8_BAR; PG8_WAIT_L(0); PG8_MMA(0, 0, At, B0); PG8_BAR; PG8_SCHED;
            PG8_LDB(B1, 1, 1); PG8_STAGE(PG8_SB(1, 0), b3, voffB);
            PG8_BAR; PG8_WAIT_L(0); PG8_MMA(0, 1, At, B1); PG8_BAR;
            PG8_LDA(At, 1, 1); PG8_STAGE(PG8_SA(1, 0), a3, voffA);
            PG8_BAR; PG8_WAIT_L(0); PG8_MMA(1, 0, At, B0); PG8_BAR; PG8_SCHED;
            PG8_STAGE(PG8_SB(1, 1), b3 + hstep, voffB);
            PG8_WAIT_V(6); PG8_BAR; PG8_MMA(1, 1, At, B1); PG8_BAR;
            }
        }
        if constexpr (ALIGN_EPI) { if (wr == 0) PG8_BAR; }
        if constexpr (!Epi::AFTER_DRAIN) { E(acc, cur, wr, wc, fr, fq); S.done(cur); }
        if (!has_next) break;
#pragma unroll
        for (int a = 0; a < 2; ++a)
#pragma unroll
            for (int b = 0; b < 2; ++b)
#pragma unroll
                for (int m = 0; m < 4; ++m)
#pragma unroll
                    for (int n = 0; n < 2; ++n) acc[a][b][m][n] = (f32x4){0.f, 0.f, 0.f, 0.f};
        cur = nxt; cA = nA; cB = nB; ++ui;
        if constexpr (ALIGN_EPI) { if (wr == 1) PG8_BAR; }
    }
    PG8_WAIT_V(0);
    if constexpr (!ALIGN_EPI) { if (wr == 0) PG8_BAR; }
    PG8_BAR;
    if constexpr (Epi::AFTER_DRAIN) { E.fused(acc, cur, wr, wc, fr, fq, lds, wid, lane); S.done(cur); }
#undef PG8_SA
#undef PG8_SB
#undef PG8_STAGE
#undef PG8_LDA
#undef PG8_LDB
#undef PG8_MMA
#undef PG8_WAIT_V
#undef PG8_WAIT_L
#undef PG8_BAR
#undef PG8_SCHED
}
}

namespace da {
using bf16 = unsigned short;
constexpr int   D = 128, NW = 8, QBLK = 32, KVBLK = 64;
constexpr float SCALE = 0.088388347648318440f;
constexpr float THR = 8.f;
constexpr size_t SHM_V = KVBLK * D * 2, SHM_K = KVBLK * D * 2, SHM_ATTN = 2 * SHM_V + 2 * SHM_K + NW * 64 * 4;
using bf16x8 = __attribute__((ext_vector_type(8))) short;
using s16x4  = __attribute__((ext_vector_type(4))) short;
using f32x16 = __attribute__((ext_vector_type(16))) float;
using u32x4  = __attribute__((ext_vector_type(4))) unsigned;
using f32x4v = __attribute__((ext_vector_type(4))) float;
#define KSWZ(row, colB) ((row) * 256 + ((colB) ^ (((row) & 7) << 4)))
#define SBAR() __builtin_amdgcn_sched_barrier(0)
__device__ __forceinline__ int crow(int r, int hi) { return (r & 3) + 8 * (r >> 2) + 4 * hi; }
__device__ __forceinline__ unsigned cvtpk(float lo, float hi) {
  unsigned r; asm volatile("v_cvt_pk_bf16_f32 %0, %1, %2" : "=v"(r) : "v"(lo), "v"(hi)); return r;
}
__device__ __forceinline__ bf16x8 ld8(const bf16* p) { return *reinterpret_cast<const bf16x8*>(p); }

__device__ __forceinline__ void partialSM(f32x16& p0, f32x16& p1, float& m_reg, float& mn, float& alpha) {
  constexpr float C = SCALE * 1.4426950408889634f;
  float pmax = p0[0]; for (int r = 1; r < 16; ++r) pmax = fmaxf(pmax, p0[r]); for (int r = 0; r < 16; ++r) pmax = fmaxf(pmax, p1[r]);
  { auto rr = __builtin_amdgcn_permlane32_swap(__float_as_uint(pmax), __float_as_uint(pmax), false, false);
    pmax = fmaxf(__uint_as_float(rr[0]), __uint_as_float(rr[1])); }
  if (__builtin_expect(__all(pmax - m_reg <= THR / SCALE), 1)) { mn = m_reg; alpha = 1.f; }
  else { mn = fmaxf(m_reg, pmax); alpha = __builtin_amdgcn_exp2f((m_reg - mn) * C); m_reg = mn; }
  float mnC = -mn * C;
  for (int r = 0; r < 16; ++r) p0[r] = fmaf(p0[r], C, mnC); for (int r = 0; r < 16; ++r) p1[r] = fmaf(p1[r], C, mnC);
  for (int r = 0; r < 16; ++r) p0[r] = __builtin_amdgcn_exp2f(p0[r]);
}
#define PK4(P, BASE, OUT) do { unsigned a0 = cvtpk(P[BASE + 0], P[BASE + 1]), a1 = cvtpk(P[BASE + 2], P[BASE + 3]);   \
    unsigned b0 = cvtpk(P[BASE + 4], P[BASE + 5]), b1 = cvtpk(P[BASE + 6], P[BASE + 7]);                              \
    auto r0 = __builtin_amdgcn_permlane32_swap(a0, b0, false, false); auto r1 = __builtin_amdgcn_permlane32_swap(a1, b1, false, false); \
    u32x4 w = {r0[0], r1[0], r0[1], r1[1]}; OUT = *reinterpret_cast<bf16x8*>(&w); } while (0)
__device__ __forceinline__ void finishSM(f32x16& p0, f32x16& p1, float alpha, float& l_reg, bf16x8& pa0, bf16x8& pa1, bf16x8& pa2, bf16x8& pa3) {
  for (int r = 0; r < 16; ++r) p1[r] = __builtin_amdgcn_exp2f(p1[r]);
  float ps = 0; for (int r = 0; r < 16; ++r) ps += p0[r]; for (int r = 0; r < 16; ++r) ps += p1[r];
  { auto rr = __builtin_amdgcn_permlane32_swap(__float_as_uint(ps), __float_as_uint(ps), false, false);
    ps = __uint_as_float(rr[0]) + __uint_as_float(rr[1]); }
  l_reg = l_reg * alpha + ps;
  PK4(p0, 0, pa0); PK4(p0, 8, pa1); PK4(p1, 0, pa2); PK4(p1, 8, pa3);
}
__device__ __forceinline__ void qkt(f32x16& p0, f32x16& p1, const bf16* Ks, const bf16x8* qr, int r32, int hi) {
  p0 = f32x16{}; p1 = f32x16{};
  for (int d0 = 0; d0 < 8; ++d0) { int cb = (d0 * 16 + hi * 8) * 2;
    bf16x8 b0 = *reinterpret_cast<const bf16x8*>((const char*)Ks + KSWZ(r32, cb));
    bf16x8 b1 = *reinterpret_cast<const bf16x8*>((const char*)Ks + KSWZ(32 + r32, cb));
    p0 = __builtin_amdgcn_mfma_f32_32x32x16_bf16(b0, qr[d0], p0, 0, 0, 0);
    p1 = __builtin_amdgcn_mfma_f32_32x32x16_bf16(b1, qr[d0], p1, 0, 0, 0); }
}
constexpr float CQ = SCALE * 1.4426950408889634f, THR2 = THR * 1.4426950408889634f;
__device__ __forceinline__ void qkt_n(f32x16& p0, f32x16& p1, const bf16* Ks, const bf16x8* qr, const f32x16& negm, int r32, int hi) {
  { const int cb = (hi * 8) * 2;
    bf16x8 b0 = *reinterpret_cast<const bf16x8*>((const char*)Ks + KSWZ(r32, cb));
    bf16x8 b1 = *reinterpret_cast<const bf16x8*>((const char*)Ks + KSWZ(32 + r32, cb));
    p0 = __builtin_amdgcn_mfma_f32_32x32x16_bf16(b0, qr[0], negm, 0, 0, 0);
    p1 = __builtin_amdgcn_mfma_f32_32x32x16_bf16(b1, qr[0], negm, 0, 0, 0); }
  for (int d0 = 1; d0 < 8; ++d0) { int cb = (d0 * 16 + hi * 8) * 2;
    bf16x8 b0 = *reinterpret_cast<const bf16x8*>((const char*)Ks + KSWZ(r32, cb));
    bf16x8 b1 = *reinterpret_cast<const bf16x8*>((const char*)Ks + KSWZ(32 + r32, cb));
    p0 = __builtin_amdgcn_mfma_f32_32x32x16_bf16(b0, qr[d0], p0, 0, 0, 0);
    p1 = __builtin_amdgcn_mfma_f32_32x32x16_bf16(b1, qr[d0], p1, 0, 0, 0); }
}
__device__ __forceinline__ void partialSM_b(f32x16& p0, float& alpha) { alpha = 1.f; for (int r = 0; r < 16; ++r) p0[r] = __builtin_amdgcn_exp2f(p0[r]); }
template <bool FIRST>
__device__ __forceinline__ void partialSM_n(f32x16& p0, f32x16& p1, float& mhat, f32x16& negm, float& alpha) {
  float pmax = p0[0]; for (int r = 1; r < 16; ++r) pmax = fmaxf(pmax, p0[r]); for (int r = 0; r < 16; ++r) pmax = fmaxf(pmax, p1[r]);
  { auto rr = __builtin_amdgcn_permlane32_swap(__float_as_uint(pmax), __float_as_uint(pmax), false, false);
    pmax = fmaxf(__uint_as_float(rr[0]), __uint_as_float(rr[1])); }
  alpha = 1.f;
  if (FIRST || !__builtin_expect(__all(pmax <= THR2), 1)) {
    const float dl = FIRST ? pmax : fmaxf(pmax, 0.f); mhat += dl;
    for (int r = 0; r < 16; ++r) { p0[r] -= dl; p1[r] -= dl; }
    for (int r = 0; r < 16; ++r) negm[r] = -mhat;
    asm volatile("" : "+v"(negm));
    if (!FIRST) alpha = __builtin_amdgcn_exp2f(-dl);
  }
  for (int r = 0; r < 16; ++r) p0[r] = __builtin_amdgcn_exp2f(p0[r]);
}
__device__ __forceinline__ void decide_n(f32x16& p0, f32x16& p1, float& mhat, f32x16& negm, float& alpha) {
  float pmax = p0[0]; for (int r = 1; r < 16; ++r) pmax = fmaxf(pmax, p0[r]); for (int r = 0; r < 16; ++r) pmax = fmaxf(pmax, p1[r]);
  { auto rr = __builtin_amdgcn_permlane32_swap(__float_as_uint(pmax), __float_as_uint(pmax), false, false);
    pmax = fmaxf(__uint_as_float(rr[0]), __uint_as_float(rr[1])); }
  alpha = 1.f;
  if (!__builtin_expect(__all(pmax <= THR2), 1)) {
    const float dl = fmaxf(pmax, 0.f); mhat += dl;
    for (int r = 0; r < 16; ++r) { p0[r] -= dl; p1[r] -= dl; }
    for (int r = 0; r < 16; ++r) negm[r] = -mhat;
    asm volatile("" : "+v"(negm));
    alpha = __builtin_amdgcn_exp2f(-dl);
  }
}
typedef __attribute__((address_space(3))) const char* lds_cp;
typedef short v4i16_t __attribute__((ext_vector_type(4)));
__device__ __forceinline__ s16x4 vtr(lds_cp p) { return __builtin_bit_cast(s16x4, __builtin_amdgcn_ds_read_tr16_b64_v4i16((__attribute__((address_space(3))) v4i16_t*)p)); }
__device__ __forceinline__ int v_st(int k, int c) { const int kk = (k & ~0xC) | ((k & 4) << 1) | ((k & 8) >> 1); return ((kk >> 3) * 4 + (c >> 5)) * 512 + ((kk & 7) * 32 + (c & 31)) * 2; }
__device__ __forceinline__ int v_rd_base(int lane) { return ((lane & 3) << 3) | (((lane >> 2) & 3) << 6) | (((lane >> 4) & 1) << 5) | (((lane >> 5) & 1) << 8); }
constexpr int v_rd_off(int d0, int ks, int half) { return d0 * 512 + ks * 4096 + half * 2048; }
template <int OFF> __device__ __forceinline__ s16x4 tr_read(int vb) {
  s16x4 r; asm volatile("ds_read_b64_tr_b16 %0, %1 offset:%2" : "=&v"(r) : "v"(vb), "i"(OFF) : "memory"); return r;
}
template <int D0> __device__ __forceinline__ void pv_one(f32x16& od, int vb, bf16x8 pa0, bf16x8 pa1, bf16x8 pa2, bf16x8 pa3) {
  const s16x4 l0 = tr_read<v_rd_off(D0, 0, 0)>(vb), h0 = tr_read<v_rd_off(D0, 0, 1)>(vb), l1 = tr_read<v_rd_off(D0, 1, 0)>(vb), h1 = tr_read<v_rd_off(D0, 1, 1)>(vb);
  const s16x4 l2 = tr_read<v_rd_off(D0, 2, 0)>(vb), h2 = tr_read<v_rd_off(D0, 2, 1)>(vb), l3 = tr_read<v_rd_off(D0, 3, 0)>(vb), h3 = tr_read<v_rd_off(D0, 3, 1)>(vb);
  asm volatile("s_waitcnt lgkmcnt(0)" ::: "memory"); SBAR();
#define PK(L, H) (bf16x8){L[0], L[1], L[2], L[3], H[0], H[1], H[2], H[3]}
  od = __builtin_amdgcn_mfma_f32_32x32x16_bf16(pa0, PK(l0, h0), od, 0, 0, 0);
  od = __builtin_amdgcn_mfma_f32_32x32x16_bf16(pa1, PK(l1, h1), od, 0, 0, 0);
  od = __builtin_amdgcn_mfma_f32_32x32x16_bf16(pa2, PK(l2, h2), od, 0, 0, 0);
  od = __builtin_amdgcn_mfma_f32_32x32x16_bf16(pa3, PK(l3, h3), od, 0, 0, 0);
#undef PK
}
__device__ __forceinline__ void pv_d0(f32x16* o, int vb, bf16x8 pa0, bf16x8 pa1, bf16x8 pa2, bf16x8 pa3) {
  pv_one<0>(o[0], vb, pa0, pa1, pa2, pa3); pv_one<1>(o[1], vb, pa0, pa1, pa2, pa3); pv_one<2>(o[2], vb, pa0, pa1, pa2, pa3); pv_one<3>(o[3], vb, pa0, pa1, pa2, pa3);
}

__device__ __forceinline__ bf16x8 pack8(const f32x16& p, int base) {
  u32x4 w = {cvtpk(p[base + 0], p[base + 1]), cvtpk(p[base + 2], p[base + 3]), cvtpk(p[base + 4], p[base + 5]), cvtpk(p[base + 6], p[base + 7])}; return *reinterpret_cast<bf16x8*>(&w); }
__device__ __forceinline__ void finishSM_ot(f32x16& p0, f32x16& p1, float alpha, float& l_reg, bf16x8& pa0, bf16x8& pa1, bf16x8& pa2, bf16x8& pa3) {
  for (int r = 0; r < 16; ++r) p1[r] = __builtin_amdgcn_exp2f(p1[r]);
  float ps = 0; for (int r = 0; r < 16; ++r) ps += p0[r]; for (int r = 0; r < 16; ++r) ps += p1[r];
  { auto rr = __builtin_amdgcn_permlane32_swap(__float_as_uint(ps), __float_as_uint(ps), false, false);
    ps = __uint_as_float(rr[0]) + __uint_as_float(rr[1]); }
  l_reg = l_reg * alpha + ps;
  pa0 = pack8(p0, 0); pa1 = pack8(p0, 8); pa2 = pack8(p1, 0); pa3 = pack8(p1, 8);
}
template <int D0> __device__ __forceinline__ void pv_one_ot(f32x16& od, int vb, bf16x8 pa0, bf16x8 pa1, bf16x8 pa2, bf16x8 pa3) {
  const s16x4 l0 = tr_read<v_rd_off(D0, 0, 0)>(vb), h0 = tr_read<v_rd_off(D0, 0, 1)>(vb), l1 = tr_read<v_rd_off(D0, 1, 0)>(vb), h1 = tr_read<v_rd_off(D0, 1, 1)>(vb);
  const s16x4 l2 = tr_read<v_rd_off(D0, 2, 0)>(vb), h2 = tr_read<v_rd_off(D0, 2, 1)>(vb), l3 = tr_read<v_rd_off(D0, 3, 0)>(vb), h3 = tr_read<v_rd_off(D0, 3, 1)>(vb);
  asm volatile("s_waitcnt lgkmcnt(0)" ::: "memory"); SBAR();
#define PK(L, H) (bf16x8){L[0], L[1], L[2], L[3], H[0], H[1], H[2], H[3]}
  od = __builtin_amdgcn_mfma_f32_32x32x16_bf16(PK(l0, h0), pa0, od, 0, 0, 0);
  od = __builtin_amdgcn_mfma_f32_32x32x16_bf16(PK(l1, h1), pa1, od, 0, 0, 0);
  od = __builtin_amdgcn_mfma_f32_32x32x16_bf16(PK(l2, h2), pa2, od, 0, 0, 0);
  od = __builtin_amdgcn_mfma_f32_32x32x16_bf16(PK(l3, h3), pa3, od, 0, 0, 0);
#undef PK
}
__device__ __forceinline__ void pv_ot(f32x16* o, int vb, bf16x8 pa0, bf16x8 pa1, bf16x8 pa2, bf16x8 pa3) {
  pv_one_ot<0>(o[0], vb, pa0, pa1, pa2, pa3); pv_one_ot<1>(o[1], vb, pa0, pa1, pa2, pa3); pv_one_ot<2>(o[2], vb, pa0, pa1, pa2, pa3); pv_one_ot<3>(o[3], vb, pa0, pa1, pa2, pa3);
}
constexpr int ASLOT = 16384, RING_ATTN = 6 * ASLOT + NW * 64 * 4;
#define AWAIT_BAR(N) asm volatile("s_waitcnt vmcnt(" #N ") lgkmcnt(0)\n\ts_barrier" ::: "memory")
template <int LDQ, int LDK, int LDO, bool QN, bool BND = false, bool HS = false>
__device__ __forceinline__ void attn_dense_body(const bf16* Qb, const bf16* __restrict__ Kh, const bf16* __restrict__ Vh, bf16* Ob, int seq, char* lds,
                                                __attribute__((address_space(3))) unsigned char* ldsl, const int wave_s, const float* qg = nullptr, const float* axt = nullptr, int tok0 = 0, float bnd = 0.f) {
  constexpr bool OT = HS;
  int lane; asm volatile("v_mbcnt_lo_u32_b32 %0, -1, 0\n\tv_mbcnt_hi_u32_b32 %0, -1, %0" : "=v"(lane));
  const int wid = wave_s, r32 = lane & 31, hi = lane >> 5;
  char* K_lds = lds; char* V_lds = lds + 3 * ASLOT;
  float* ws = (float*)(lds + 6 * ASLOT) + wid * 64; float* li_l = ws; float* al_l = ws + 32;
  float mhat = 0.f, l_reg = 0; f32x16 o[4] = {}; bf16x8 qr[8]; f32x16 negm;
  unsigned ksrc[2], vsrc[2];
#pragma unroll
  for (int i = 0; i < 2; ++i) { const int p = 2 * wid + i;
    const int krow = 4 * p + (lane >> 4), kch = (lane & 15) ^ (krow & 7); ksrc[i] = (unsigned)(krow * LDK + kch * 8) * 2u;
    const int sub = 2 * p + (lane >> 5), kk = ((sub >> 2) << 3) | ((lane & 31) >> 2), key = OT ? kk : ((kk & ~0xC) | ((kk & 4) << 1) | ((kk & 8) >> 1)), vc = ((sub & 3) << 5) | ((lane & 3) << 3);
    vsrc[i] = (unsigned)(key * LDK + vc) * 2u; }
#define DMA_K1(t, sl, i_) __builtin_amdgcn_global_load_lds((const unsigned*)((const char*)Kh + (ksrc[i_] + (unsigned)(t) * (unsigned)(KVBLK * LDK * 2))), (__attribute__((address_space(3))) unsigned*)(ldsl + (sl) + (2 * wid + (i_)) * 1024), 16, 0, 0)
#define DMA_V1(t, sl, i_) __builtin_amdgcn_global_load_lds((const unsigned*)((const char*)Vh + (vsrc[i_] + (unsigned)(t) * (unsigned)(KVBLK * LDK * 2))), (__attribute__((address_space(3))) unsigned*)(ldsl + 3 * ASLOT + (sl) + (2 * wid + (i_)) * 1024), 16, 0, 0)
#define DMA_K(t, sl) do { DMA_K1(t, sl, 0); DMA_K1(t, sl, 1); } while (0)
#define DMA_V(t, sl) do { DMA_V1(t, sl, 0); DMA_V1(t, sl, 1); } while (0)
  const int NT = seq / KVBLK;
  DMA_K(0, 0); DMA_V(0, 0); DMA_K(1, ASLOT);
  const bf16* Qw = Qb + (long)(wid * QBLK + r32) * LDQ + hi * 8;
#pragma unroll
  for (int d0 = 0; d0 < 8; ++d0) qr[d0] = ld8(Qw + d0 * 16);
  if constexpr (QN) {
    const int t = tok0 + wid * QBLK + r32, prow = t >> 6, pcol = t & 63;
    float x[8][8]; float ss = 0.f;
#pragma unroll
    for (int d0 = 0; d0 < 8; ++d0)
#pragma unroll
      for (int e = 0; e < 8; ++e) { x[d0][e] = __builtin_bit_cast(float, (unsigned)(unsigned short)qr[d0][e] << 16); ss += x[d0][e] * x[d0][e]; }
    { auto rr = __builtin_amdgcn_permlane32_swap(__float_as_uint(ss), __float_as_uint(ss), false, false); ss = __uint_as_float(rr[0]) + __uint_as_float(rr[1]); }
    const float rstd = CQ / sqrtf(ss * (1.f / 128.f) + 1e-6f);
#pragma unroll
    for (int d0 = 0; d0 < 8; ++d0) { const float* gp = qg + d0 * 16 + hi * 8; const f32x4v g0 = *(const f32x4v*)gp, g1 = *(const f32x4v*)(gp + 4);
#pragma unroll
      for (int e = 0; e < 8; ++e) x[d0][e] *= rstd * (e < 4 ? g0[e] : g1[e - 4]); }
#pragma unroll
    for (int half = 0; half < 2; ++half) { const float* ct = half == 0 ? axt + prow * 32 : axt + 16384 + pcol * 32; const float* st = ct + (half == 0 ? 8192 : 2048);
#pragma unroll
      for (int dd = 0; dd < 2; ++dd) { const int ix = dd * 16 + hi * 8;
        const f32x4v c0 = *(const f32x4v*)(ct + ix), c1 = *(const f32x4v*)(ct + ix + 4), s0 = *(const f32x4v*)(st + ix), s1 = *(const f32x4v*)(st + ix + 4);
#pragma unroll
        for (int e = 0; e < 8; ++e) { const float c = e < 4 ? c0[e] : c1[e - 4], sn = e < 4 ? s0[e] : s1[e - 4];
          const float a = x[half * 4 + dd][e], b = x[half * 4 + 2 + dd][e]; x[half * 4 + dd][e] = a * c - b * sn; x[half * 4 + 2 + dd][e] = b * c + a * sn; } } }
#pragma unroll
    for (int d0 = 0; d0 < 8; ++d0) { u32x4 w = {cvtpk(x[d0][0], x[d0][1]), cvtpk(x[d0][2], x[d0][3]), cvtpk(x[d0][4], x[d0][5]), cvtpk(x[d0][6], x[d0][7])}; qr[d0] = *reinterpret_cast<bf16x8*>(&w); }
  }
  if constexpr (!QN) {
#pragma unroll
    for (int d0 = 0; d0 < 8; ++d0) { float x[8];
#pragma unroll
      for (int e = 0; e < 8; ++e) x[e] = __builtin_bit_cast(float, (unsigned)(unsigned short)qr[d0][e] << 16) * CQ;
      u32x4 w = {cvtpk(x[0], x[1]), cvtpk(x[2], x[3]), cvtpk(x[4], x[5]), cvtpk(x[6], x[7])}; qr[d0] = *reinterpret_cast<bf16x8*>(&w); }
  }
  const bool onl = !BND || !(bnd <= 60.f);
  { float nb = (BND && !onl) ? -bnd : 0.f; asm volatile("" : "+v"(nb));
    for (int r = 0; r < 16; ++r) negm[r] = nb; asm volatile("" : "+v"(negm)); }
  const int vb0 = (int)(uintptr_t)V_lds + v_rd_base(lane);
#define RESC(a) do { if ((!BND || onl) && __any((a) < 1.f)) { if constexpr (OT) { for (int d = 0; d < 4; ++d) for (int r = 0; r < 16; ++r) o[d][r] *= (a); } else { \
    if (hi == 0) al_l[r32] = (a); asm volatile("s_waitcnt lgkmcnt(0)" ::: "memory"); \
    for (int d = 0; d < 4; ++d) for (int r = 0; r < 16; ++r) o[d][r] *= al_l[crow(r, hi)]; } } } while (0)
  f32x16 pA0, pA1, pB0, pB1; float alA, alB; bf16x8 pa0, pa1, pa2, pa3;
  int s0 = 2 * ASLOT, s1 = 0, s2 = ASLOT;
#define ROT() do { const int t_ = s0; s0 = s1; s1 = s2; s2 = t_; } while (0)
  AWAIT_BAR(0);
  if (wid >= 4) __builtin_amdgcn_s_setprio(1);
  DMA_K(2, s0); DMA_V(1, s2);
  qkt_n(pA0, pA1, (const bf16*)(K_lds + s1), qr, negm, r32, hi); if (BND && !onl) partialSM_b(pA0, alA); else partialSM_n<true>(pA0, pA1, mhat, negm, alA);
  AWAIT_BAR(4); ROT();
  if constexpr (HS) {
    const lds_cp kb_l = (lds_cp)ldsl + r32 * 256, vb_l = (lds_cp)ldsl + 3 * ASLOT + v_rd_base(lane);
    const int ksw = (r32 & 7) << 4, khi = hi * 16;
    bf16x8 kf[3][2]; s16x4 vl[4], vh[4];
#define H_KRD(kp, i) do { const unsigned a_ = (unsigned)(uintptr_t)(kp) + (unsigned)((((i) * 32 + khi) ^ ksw)); \
      asm volatile("ds_read_b128 %0, %2\n\tds_read_b128 %1, %2 offset:8192" : "=&v"(kf[(i) % 3][0]), "=&v"(kf[(i) % 3][1]) : "v"(a_) : "memory"); } while (0)
#define H_KWAIT(N, i) asm volatile("s_waitcnt lgkmcnt(" #N ")" : "+v"(kf[(i) % 3][0]), "+v"(kf[(i) % 3][1]) :: "memory")
#define H_VRD(vp, j) do { const unsigned a_ = (unsigned)(uintptr_t)(vp); \
      asm volatile("ds_read_b64_tr_b16 %0, %2 offset:%3\n\tds_read_b64_tr_b16 %1, %2 offset:%4" : "=&v"(vl[(j) & 3]), "=&v"(vh[(j) & 3]) : "v"(a_), "i"(v_rd_off((j) >> 2, (j) & 3, 0)), "i"(v_rd_off((j) >> 2, (j) & 3, 1)) : "memory"); } while (0)
#define H_VWAIT(N, j) asm volatile("s_waitcnt lgkmcnt(" #N ")" : "+v"(vl[(j) & 3]), "+v"(vh[(j) & 3]) :: "memory")
#define H_PIN(x) asm volatile("" : "+v"(x))
#define H_VF(j) (bf16x8){vl[(j) & 3][0], vl[(j) & 3][1], vl[(j) & 3][2], vl[(j) & 3][3], vh[(j) & 3][0], vh[(j) & 3][1], vh[(j) & 3][2], vh[(j) & 3][3]}
#define H_PA(j) (((j) & 3) == 0 ? pa0 : ((j) & 3) == 1 ? pa1 : ((j) & 3) == 2 ? pa2 : pa3)
#define H_GA(i, C0, C1, P0, P1, kp) do { \
      if (((i) & 1) == 0 && ((i) >> 1) + 2 < 8) H_KRD(kp, ((i) >> 1) + 2); \
      if (((i) & 1) == 0) { if ((i) < 12) H_KWAIT(4, (i) >> 1); else if ((i) == 12) H_KWAIT(2, 6); else H_KWAIT(0, 7); } \
      if ((i) == 8) DMA_K1(tkk, s0, 0); else if ((i) == 10) DMA_K1(tkk, s0, 1); else if ((i) == 12) DMA_V1(tvv, s2, 0); else if ((i) == 14) DMA_V1(tvv, s2, 1); \
      if (((i) & 1) == 0) C0 = __builtin_amdgcn_mfma_f32_32x32x16_bf16(kf[((i) >> 1) % 3][0], qr[(i) >> 1], (i) < 2 ? negm : C0, 0, 0, 0); \
      else C1 = __builtin_amdgcn_mfma_f32_32x32x16_bf16(kf[((i) >> 1) % 3][1], qr[(i) >> 1], (i) < 2 ? negm : C1, 0, 0, 0); \
      if ((i) < 8) { P1[2 * (i)] = __builtin_amdgcn_exp2f(P1[2 * (i)]); P1[2 * (i) + 1] = __builtin_amdgcn_exp2f(P1[2 * (i) + 1]); sacc += P0[2 * (i)]; sacc += P0[2 * (i) + 1]; H_PIN(P1); H_PIN(sacc); } \
      else { sacc += P1[2 * ((i) - 8)]; sacc += P1[2 * ((i) - 8) + 1]; H_PIN(sacc); \
        if (((i) & 1) == 0) { if ((i) < 12) { ca0 = cvtpk(P0[((i) - 8) * 4 + 0], P0[((i) - 8) * 4 + 1]); ca1 = cvtpk(P0[((i) - 8) * 4 + 2], P0[((i) - 8) * 4 + 3]); } \
                              else { ca0 = cvtpk(P1[((i) - 12) * 4 + 0], P1[((i) - 12) * 4 + 1]); ca1 = cvtpk(P1[((i) - 12) * 4 + 2], P1[((i) - 12) * 4 + 3]); } H_PIN(ca0); H_PIN(ca1); } \
        else { unsigned cb0, cb1; if ((i) < 12) { cb0 = cvtpk(P0[((i) - 9) * 4 + 4], P0[((i) - 9) * 4 + 5]); cb1 = cvtpk(P0[((i) - 9) * 4 + 6], P0[((i) - 9) * 4 + 7]); } \
                              else { cb0 = cvtpk(P1[((i) - 13) * 4 + 4], P1[((i) - 13) * 4 + 5]); cb1 = cvtpk(P1[((i) - 13) * 4 + 6], P1[((i) - 13) * 4 + 7]); } \
          u32x4 w_ = {ca0, ca1, cb0, cb1};     \
          if ((i) == 9) { pa0 = *reinterpret_cast<bf16x8*>(&w_); H_PIN(pa0); } else if ((i) == 11) { pa1 = *reinterpret_cast<bf16x8*>(&w_); H_PIN(pa1); } \
          else if ((i) == 13) { pa2 = *reinterpret_cast<bf16x8*>(&w_); H_PIN(pa2); } else { pa3 = *reinterpret_cast<bf16x8*>(&w_); H_PIN(pa3); } } } \
      SBAR(); } while (0)
#define H_GB(j, C0, vp) do { if ((j) + 3 < 16) H_VRD(vp, (j) + 3); \
      if ((j) < 13) H_VWAIT(6, j); else if ((j) == 13) H_VWAIT(4, 13); else if ((j) == 14) H_VWAIT(2, 14); else H_VWAIT(0, 15); \
      o[(j) >> 2] = __builtin_amdgcn_mfma_f32_32x32x16_bf16(H_VF(j), H_PA(j), o[(j) >> 2], 0, 0, 0);     \
      C0[j] = __builtin_amdgcn_exp2f(C0[j]); H_PIN(C0); SBAR(); } while (0)
#define H_STEP(C0, C1, P0, P1, alP, alC, tk_, tv_) do { \
      const lds_cp kp_ = kb_l + s1, vp_ = vb_l + s0; float sacc = 0.f; unsigned ca0 = 0, ca1 = 0; const int tkk = (tk_), tvv = (tv_); \
      SBAR(); H_KRD(kp_, 0); H_KRD(kp_, 1); SBAR(); \
      H_GA(0, C0, C1, P0, P1, kp_); H_GA(1, C0, C1, P0, P1, kp_); H_GA(2, C0, C1, P0, P1, kp_); H_GA(3, C0, C1, P0, P1, kp_); \
      H_GA(4, C0, C1, P0, P1, kp_); H_GA(5, C0, C1, P0, P1, kp_); H_GA(6, C0, C1, P0, P1, kp_); H_GA(7, C0, C1, P0, P1, kp_); \
      H_GA(8, C0, C1, P0, P1, kp_); H_GA(9, C0, C1, P0, P1, kp_); H_GA(10, C0, C1, P0, P1, kp_); H_GA(11, C0, C1, P0, P1, kp_); \
      H_GA(12, C0, C1, P0, P1, kp_); H_GA(13, C0, C1, P0, P1, kp_); H_GA(14, C0, C1, P0, P1, kp_); H_GA(15, C0, C1, P0, P1, kp_); \
      { auto rr_ = __builtin_amdgcn_permlane32_swap(__float_as_uint(sacc), __float_as_uint(sacc), false, false); l_reg = l_reg * (alP) + (__uint_as_float(rr_[0]) + __uint_as_float(rr_[1])); } \
      if (onl) decide_n(C0, C1, mhat, negm, alC); else alC = 1.f; \
      H_VRD(vp_, 0); H_VRD(vp_, 1); H_VRD(vp_, 2); SBAR(); \
      H_GB(0, C0, vp_); H_GB(1, C0, vp_); H_GB(2, C0, vp_); H_GB(3, C0, vp_); H_GB(4, C0, vp_); H_GB(5, C0, vp_); H_GB(6, C0, vp_); H_GB(7, C0, vp_); \
      H_GB(8, C0, vp_); H_GB(9, C0, vp_); H_GB(10, C0, vp_); H_GB(11, C0, vp_); H_GB(12, C0, vp_); H_GB(13, C0, vp_); H_GB(14, C0, vp_); H_GB(15, C0, vp_); \
    } while (0)
    for (int j = 1; j + 1 < NT; j += 2) {
      { const int tk = j + 2 < NT ? j + 2 : NT - 1, tv = j + 1;
      H_STEP(pB0, pB1, pA0, pA1, alA, alB, tk, tv); }
      RESC(alB); AWAIT_BAR(4); ROT();
      { const int tk = j + 3 < NT ? j + 3 : NT - 1, tv = j + 2 < NT ? j + 2 : NT - 1;
      H_STEP(pA0, pA1, pB0, pB1, alB, alA, tk, tv); }
      RESC(alA); AWAIT_BAR(4); ROT();
    }
#undef H_KRD
#undef H_VRD
#undef H_KWAIT
#undef H_VWAIT
#undef H_PIN
#undef H_VF
#undef H_PA
#undef H_GA
#undef H_GB
#undef H_STEP
  } else {
  for (int j = 1; j + 1 < NT; j += 2) {
    { const int tk = j + 2 < NT ? j + 2 : NT - 1, tv = j + 1; DMA_K(tk, s0); DMA_V(tv, s2); }
    SBAR(); qkt_n(pB0, pB1, (const bf16*)(K_lds + s1), qr, negm, r32, hi);
    finishSM(pA0, pA1, alA, l_reg, pa0, pa1, pa2, pa3); SBAR();
    pv_d0(o, vb0 + s0, pa0, pa1, pa2, pa3); if (BND && !onl) partialSM_b(pB0, alB); else partialSM_n<false>(pB0, pB1, mhat, negm, alB);
    RESC(alB); AWAIT_BAR(4); ROT();
    { const int tk = j + 3 < NT ? j + 3 : NT - 1, tv = j + 2 < NT ? j + 2 : NT - 1; DMA_K(tk, s0); DMA_V(tv, s2); }
    SBAR(); qkt_n(pA0, pA1, (const bf16*)(K_lds + s1), qr, negm, r32, hi);
    finishSM(pB0, pB1, alB, l_reg, pa0, pa1, pa2, pa3); SBAR();
    pv_d0(o, vb0 + s0, pa0, pa1, pa2, pa3); if (BND && !onl) partialSM_b(pA0, alA); else partialSM_n<false>(pA0, pA1, mhat, negm, alA);
    RESC(alA); AWAIT_BAR(4); ROT();
  }
  }
  { DMA_K(NT - 1, s0); DMA_V(NT - 1, s2); }
  SBAR(); qkt_n(pB0, pB1, (const bf16*)(K_lds + s1), qr, negm, r32, hi);
  if constexpr (OT) finishSM_ot(pA0, pA1, alA, l_reg, pa0, pa1, pa2, pa3); else finishSM(pA0, pA1, alA, l_reg, pa0, pa1, pa2, pa3);
  SBAR();
  if constexpr (OT) pv_ot(o, vb0 + s0, pa0, pa1, pa2, pa3); else pv_d0(o, vb0 + s0, pa0, pa1, pa2, pa3);
  if (BND && !onl) partialSM_b(pB0, alB); else partialSM_n<false>(pB0, pB1, mhat, negm, alB);
  RESC(alB); AWAIT_BAR(4); ROT();
  if constexpr (OT) finishSM_ot(pB0, pB1, alB, l_reg, pa0, pa1, pa2, pa3); else finishSM(pB0, pB1, alB, l_reg, pa0, pa1, pa2, pa3);
  SBAR();
  if constexpr (OT) pv_ot(o, vb0 + s0, pa0, pa1, pa2, pa3); else pv_d0(o, vb0 + s0, pa0, pa1, pa2, pa3);
  __builtin_amdgcn_s_setprio(0);
  int lane2; asm volatile("v_mbcnt_lo_u32_b32 %0, -1, 0\n\tv_mbcnt_hi_u32_b32 %0, -1, %0" : "=v"(lane2));
  const int r32b = lane2 & 31, hib = lane2 >> 5;
  if constexpr (OT) {
    const float rl = __builtin_amdgcn_rcpf(l_reg);
    bf16* Ow = Ob + (long)(wid * QBLK + r32b) * LDO + 4 * hib;
#pragma unroll
    for (int d0 = 0; d0 < 4; ++d0)
#pragma unroll
      for (int g = 0; g < 4; ++g) { const unsigned long long w = (unsigned long long)cvtpk(o[d0][4 * g] * rl, o[d0][4 * g + 1] * rl) | ((unsigned long long)cvtpk(o[d0][4 * g + 2] * rl, o[d0][4 * g + 3] * rl) << 32);
        *(unsigned long long*)(Ow + d0 * 32 + g * 8) = w; }
  } else {
  if (hi == 0) li_l[r32] = l_reg; asm volatile("s_waitcnt lgkmcnt(0)" ::: "memory");
  float rli[16];
#pragma unroll
  for (int r = 0; r < 16; ++r) rli[r] = __builtin_amdgcn_rcpf(li_l[crow(r, hib)]);
  bf16* Ow = Ob + (long)(wid * QBLK) * LDO + r32b;
#pragma unroll
  for (int r = 0; r < 16; ++r) { int orow = crow(r, hib);
    for (int d0 = 0; d0 < 4; ++d0) Ow[(long)orow * LDO + d0 * 32] = (bf16)(cvtpk(o[d0][r] * rli[r], 0.f) & 0xffffu); }
  }
  AWAIT_BAR(0);
#undef DMA_K
#undef DMA_V
#undef DMA_K1
#undef DMA_V1
#undef RESC
#undef ROT
}
template <int LDQ, int LDK, int LDO>
__device__ __forceinline__ void attn_dense_stg(const bf16* Qb, const bf16* __restrict__ Kh, const bf16* __restrict__ Vh, bf16* Ob, int seq, char* lds,
                                                __attribute__((address_space(3))) unsigned char* ldsl, const int wave_s, const float* qg = nullptr, const float* axt = nullptr, int tok0 = 0, float bnd = 0.f) {
  constexpr bool OT = true, QN = true, BND = true;
  int lane; asm volatile("v_mbcnt_lo_u32_b32 %0, -1, 0\n\tv_mbcnt_hi_u32_b32 %0, -1, %0" : "=v"(lane));
  const int wid = wave_s, r32 = lane & 31, hi = lane >> 5;
  float mhat = 0.f, l_reg = 0; f32x16 o[4] = {}; bf16x8 qr[8]; f32x16 negm;
  unsigned ksrc[2], vsrc[2];
#pragma unroll
  for (int i = 0; i < 2; ++i) { const int p = 2 * wid + i;
    const int krow = 4 * p + (lane >> 4), kch = (lane & 15) ^ (krow & 15); ksrc[i] = (unsigned)(krow * LDK + kch * 8) * 2u;
    const int sub = 2 * p + (lane >> 5), kk = ((sub >> 2) << 3) | ((lane & 31) >> 2), key = OT ? kk : ((kk & ~0xC) | ((kk & 4) << 1) | ((kk & 8) >> 1)), vc = ((sub & 3) << 5) | ((lane & 3) << 3);
    vsrc[i] = (unsigned)(key * LDK + vc) * 2u; }
#define DMA_K1(t, sl, i_) __builtin_amdgcn_global_load_lds((const unsigned*)((const char*)Kh + (ksrc[i_] + (unsigned)(t) * (unsigned)(KVBLK * LDK * 2))), (__attribute__((address_space(3))) unsigned*)(ldsl + (sl) + (2 * wid + (i_)) * 1024), 16, 0, 0)
#define DMA_V1(t, sl, i_) __builtin_amdgcn_global_load_lds((const unsigned*)((const char*)Vh + (vsrc[i_] + (unsigned)(t) * (unsigned)(KVBLK * LDK * 2))), (__attribute__((address_space(3))) unsigned*)(ldsl + 4 * ASLOT + (sl) + (2 * wid + (i_)) * 1024), 16, 0, 0)
#define DMA_K(t, sl) do { DMA_K1(t, sl, 0); DMA_K1(t, sl, 1); } while (0)
#define DMA_V(t, sl) do { DMA_V1(t, sl, 0); DMA_V1(t, sl, 1); } while (0)
  const int NT = seq / KVBLK;
  DMA_K(0, 0); DMA_V(0, 0); DMA_K(1, ASLOT); DMA_K(2, 2 * ASLOT);
  const bf16* Qw = Qb + (long)(wid * QBLK + r32) * LDQ + hi * 8;
#pragma unroll
  for (int d0 = 0; d0 < 8; ++d0) qr[d0] = ld8(Qw + d0 * 16);
  if constexpr (QN) {
    const int t = tok0 + wid * QBLK + r32, prow = t >> 6, pcol = t & 63;
    float x[8][8]; float ss = 0.f;
#pragma unroll
    for (int d0 = 0; d0 < 8; ++d0)
#pragma unroll
      for (int e = 0; e < 8; ++e) { x[d0][e] = __builtin_bit_cast(float, (unsigned)(unsigned short)qr[d0][e] << 16); ss += x[d0][e] * x[d0][e]; }
    { auto rr = __builtin_amdgcn_permlane32_swap(__float_as_uint(ss), __float_as_uint(ss), false, false); ss = __uint_as_float(rr[0]) + __uint_as_float(rr[1]); }
    const float rstd = CQ / sqrtf(ss * (1.f / 128.f) + 1e-6f);
#pragma unroll
    for (int d0 = 0; d0 < 8; ++d0) { const float* gp = qg + d0 * 16 + hi * 8; const f32x4v g0 = *(const f32x4v*)gp, g1 = *(const f32x4v*)(gp + 4);
#pragma unroll
      for (int e = 0; e < 8; ++e) x[d0][e] *= rstd * (e < 4 ? g0[e] : g1[e - 4]); }
#pragma unroll
    for (int half = 0; half < 2; ++half) { const float* ct = half == 0 ? axt + prow * 32 : axt + 16384 + pcol * 32; const float* st = ct + (half == 0 ? 8192 : 2048);
#pragma unroll
      for (int dd = 0; dd < 2; ++dd) { const int ix = dd * 16 + hi * 8;
        const f32x4v c0 = *(const f32x4v*)(ct + ix), c1 = *(const f32x4v*)(ct + ix + 4), s0 = *(const f32x4v*)(st + ix), s1 = *(const f32x4v*)(st + ix + 4);
#pragma unroll
        for (int e = 0; e < 8; ++e) { const float c = e < 4 ? c0[e] : c1[e - 4], sn = e < 4 ? s0[e] : s1[e - 4];
          const float a = x[half * 4 + dd][e], b = x[half * 4 + 2 + dd][e]; x[half * 4 + dd][e] = a * c - b * sn; x[half * 4 + 2 + dd][e] = b * c + a * sn; } } }
#pragma unroll
    for (int d0 = 0; d0 < 8; ++d0) { u32x4 w = {cvtpk(x[d0][0], x[d0][1]), cvtpk(x[d0][2], x[d0][3]), cvtpk(x[d0][4], x[d0][5]), cvtpk(x[d0][6], x[d0][7])}; qr[d0] = *reinterpret_cast<bf16x8*>(&w); }
  }
  if constexpr (!QN) {
#pragma unroll
    for (int d0 = 0; d0 < 8; ++d0) { float x[8];
#pragma unroll
      for (int e = 0; e < 8; ++e) x[e] = __builtin_bit_cast(float, (unsigned)(unsigned short)qr[d0][e] << 16) * CQ;
      u32x4 w = {cvtpk(x[0], x[1]), cvtpk(x[2], x[3]), cvtpk(x[4], x[5]), cvtpk(x[6], x[7])}; qr[d0] = *reinterpret_cast<bf16x8*>(&w); }
  }
  const bool onl = !BND || !(bnd <= 60.f);
  { float nb = (BND && !onl) ? -bnd : 0.f; asm volatile("" : "+v"(nb));
    for (int r = 0; r < 16; ++r) negm[r] = nb; asm volatile("" : "+v"(negm)); }
  f32x16 S0, S1; float al = 1.f; bf16x8 pa0, pa1, pa2, pa3;
  int s0 = 2 * ASLOT, s1 = 0, s2 = ASLOT;
#define ROT() do { const int t_ = s0; s0 = s1; s1 = s2; s2 = t_; } while (0)
#define VBAR() asm volatile("s_waitcnt lgkmcnt(0)\n\ts_barrier" ::: "memory")
  const lds_cp kb_l = (lds_cp)ldsl + r32 * 256, vb_l = (lds_cp)ldsl + 4 * ASLOT + v_rd_base(lane);
  const int ksw = (r32 & 15) << 4, khi = hi * 16;
  bf16x8 kf[4][2]; s16x4 vl[8], vh[8];
#define G_KRD(kp, i) do { const unsigned a_ = (unsigned)(uintptr_t)(kp) + (unsigned)((((i) * 32 + khi) ^ ksw)); \
    asm volatile("ds_read_b128 %0, %2\n\tds_read_b128 %1, %2 offset:8192" : "=&v"(kf[(i) & 3][0]), "=&v"(kf[(i) & 3][1]) : "v"(a_) : "memory"); } while (0)
#define G_KWAIT(N, i) do { asm volatile("s_waitcnt lgkmcnt(" #N ")" ::: "memory"); SBAR(); } while (0)
#define G_VRD(vp, j) do { const unsigned a_ = (unsigned)(uintptr_t)(vp); \
    asm volatile("ds_read_b64_tr_b16 %0, %2 offset:%3\n\tds_read_b64_tr_b16 %1, %2 offset:%4" : "=&v"(vl[(j) & 7]), "=&v"(vh[(j) & 7]) : "v"(a_), "i"(v_rd_off((j) & 3, (j) >> 2, 0)), "i"(v_rd_off((j) & 3, (j) >> 2, 1)) : "memory"); } while (0)
#define G_VWAIT(N, j) do { asm volatile("s_waitcnt lgkmcnt(" #N ")" ::: "memory"); SBAR(); } while (0)
#define G_VF(j) (bf16x8){vl[(j) & 7][0], vl[(j) & 7][1], vl[(j) & 7][2], vl[(j) & 7][3], vh[(j) & 7][0], vh[(j) & 7][1], vh[(j) & 7][2], vh[(j) & 7][3]}
#define G_PA(j) (((j) >> 2) == 0 ? pa0 : ((j) >> 2) == 1 ? pa1 : ((j) >> 2) == 2 ? pa2 : pa3)
#define G_QK(i, HASPV, kp, vp, tk, tv) do { \
    if (((i) & 1) == 0 && ((i) >> 1) + 3 < 8) G_KRD(kp, ((i) >> 1) + 3); \
    if ((HASPV) && (i) >= 10) G_VRD(vp, (i) - 10); \
    if (((i) & 1) == 0) { if ((i) < 10) G_KWAIT(6, (i) >> 1); \
      else if ((i) == 10) { if (HASPV) G_KWAIT(6, 5); else G_KWAIT(4, 5); } \
      else if ((i) == 12) { if (HASPV) G_KWAIT(8, 6); else G_KWAIT(2, 6); } \
      else { if (HASPV) G_KWAIT(10, 7); else G_KWAIT(0, 7); } } \
    if (((i) & 1) == 0) S0 = __builtin_amdgcn_mfma_f32_32x32x16_bf16(kf[((i) >> 1) & 3][0], qr[(i) >> 1], (i) < 2 ? negm : S0, 0, 0, 0); \
    else S1 = __builtin_amdgcn_mfma_f32_32x32x16_bf16(kf[((i) >> 1) & 3][1], qr[(i) >> 1], (i) < 2 ? negm : S1, 0, 0, 0); \
    SBAR(); } while (0)
#define G_PV(j, vp) do { if ((j) + 6 < 16) G_VRD(vp, (j) + 6); \
    if ((j) < 10) G_VWAIT(12, j); else if ((j) == 10) G_VWAIT(10, 10); else if ((j) == 11) G_VWAIT(8, 11); else if ((j) == 12) G_VWAIT(6, 12); \
    else if ((j) == 13) G_VWAIT(4, 13); else if ((j) == 14) G_VWAIT(2, 14); else G_VWAIT(0, 15); \
    o[(j) & 3] = __builtin_amdgcn_mfma_f32_32x32x16_bf16(G_VF(j), G_PA(j), o[(j) & 3], 0, 0, 0); SBAR(); } while (0)
#define G_KPRE(kp) do { SBAR(); G_KRD(kp, 0); G_KRD(kp, 1); G_KRD(kp, 2); SBAR(); } while (0)
#define G_QK16(HASPV, kp, vp, tk, tv) do { \
    G_QK(0, HASPV, kp, vp, tk, tv); G_QK(1, HASPV, kp, vp, tk, tv); G_QK(2, HASPV, kp, vp, tk, tv); G_QK(3, HASPV, kp, vp, tk, tv); \
    G_QK(4, HASPV, kp, vp, tk, tv); G_QK(5, HASPV, kp, vp, tk, tv); G_QK(6, HASPV, kp, vp, tk, tv); G_QK(7, HASPV, kp, vp, tk, tv); \
    G_QK(8, HASPV, kp, vp, tk, tv); G_QK(9, HASPV, kp, vp, tk, tv); G_QK(10, HASPV, kp, vp, tk, tv); G_QK(11, HASPV, kp, vp, tk, tv); \
    G_QK(12, HASPV, kp, vp, tk, tv); G_QK(13, HASPV, kp, vp, tk, tv); G_QK(14, HASPV, kp, vp, tk, tv); G_QK(15, HASPV, kp, vp, tk, tv); } while (0)
#define G_PV16(vp) do { G_PV(0, vp); G_PV(1, vp); G_PV(2, vp); G_PV(3, vp); G_PV(4, vp); G_PV(5, vp); G_PV(6, vp); G_PV(7, vp); \
    G_PV(8, vp); G_PV(9, vp); G_PV(10, vp); G_PV(11, vp); G_PV(12, vp); G_PV(13, vp); G_PV(14, vp); G_PV(15, vp); } while (0)
#define G_SOFTMAX(FIRST) do { al = 1.f; \
    if (onl) { float pmax = S0[0]; for (int r = 1; r < 16; ++r) pmax = fmaxf(pmax, S0[r]); for (int r = 0; r < 16; ++r) pmax = fmaxf(pmax, S1[r]); \
      { auto rr = __builtin_amdgcn_permlane32_swap(__float_as_uint(pmax), __float_as_uint(pmax), false, false); pmax = fmaxf(__uint_as_float(rr[0]), __uint_as_float(rr[1])); } \
      if ((FIRST) || !__all(pmax <= THR2)) { const float dl = (FIRST) ? pmax : fmaxf(pmax, 0.f); mhat += dl; \
        for (int r = 0; r < 16; ++r) { S0[r] -= dl; S1[r] -= dl; } for (int r = 0; r < 16; ++r) negm[r] = -mhat; asm volatile("" : "+v"(negm)); \
        if (!(FIRST)) { al = __builtin_amdgcn_exp2f(-dl); for (int d = 0; d < 4; ++d) for (int r = 0; r < 16; ++r) o[d][r] *= al; } } } \
    for (int r = 0; r < 16; ++r) S0[r] = __builtin_amdgcn_exp2f(S0[r]); for (int r = 0; r < 16; ++r) S1[r] = __builtin_amdgcn_exp2f(S1[r]); \
    { float ps = 0.f; for (int r = 0; r < 16; ++r) ps += S0[r]; for (int r = 0; r < 16; ++r) ps += S1[r]; \
      auto rr = __builtin_amdgcn_permlane32_swap(__float_as_uint(ps), __float_as_uint(ps), false, false); l_reg = l_reg * al + (__uint_as_float(rr[0]) + __uint_as_float(rr[1])); } \
    pa0 = pack8(S0, 0); pa1 = pack8(S0, 8); pa2 = pack8(S1, 0); pa3 = pack8(S1, 8); } while (0)
  AWAIT_BAR(0);
  const bool grpB = wid >= 4;
  G_KPRE(kb_l);
  if (grpB) VBAR();
  { const lds_cp kp_ = kb_l, vp_ = vb_l + s0; __builtin_amdgcn_s_setprio(1);
    G_QK16(false, kp_, vp_, 2, 1);
    __builtin_amdgcn_s_setprio(0); AWAIT_BAR(0); ROT(); }
  DMA_K(3, 3 * ASLOT); DMA_V(1, s1);
  G_SOFTMAX(true); G_KPRE(kb_l + ASLOT); VBAR();
#pragma unroll 1
  for (int t = 1; t < NT; ++t) {
    { const int tk = t + 3 < NT ? t + 3 : NT - 1, tv = t + 1 < NT ? t + 1 : NT - 1;
      const lds_cp kp_ = kb_l + ((t & 3) << 14), vp_ = vb_l + s0; __builtin_amdgcn_s_setprio(1);
      G_QK16(true, kp_, vp_, tk, tv);
      G_PV16(vp_);
      __builtin_amdgcn_s_setprio(0); AWAIT_BAR(0); ROT(); }
    G_SOFTMAX(false);
    { const lds_cp kn_ = kb_l + (((t + 1) & 3) << 14); G_KPRE(kn_); }
    { const int tk = t + 3 < NT ? t + 3 : NT - 1, tv = t + 1 < NT ? t + 1 : NT - 1; SBAR();
      DMA_K(tk, ((t + 3) & 3) << 14); DMA_V(tv, s1); }
    VBAR();
  }
  { const lds_cp vp_ = vb_l + s0; __builtin_amdgcn_s_setprio(1);
    SBAR(); G_VRD(vp_, 0); G_VRD(vp_, 1); G_VRD(vp_, 2); G_VRD(vp_, 3); G_VRD(vp_, 4); G_VRD(vp_, 5); SBAR();
    G_PV16(vp_);
    __builtin_amdgcn_s_setprio(0); }
  if (!grpB) VBAR();
#undef G_KRD
#undef G_KWAIT
#undef G_VRD
#undef G_VWAIT
#undef G_VF
#undef G_PA
#undef G_QK
#undef G_PV
#undef G_QK16
#undef G_KPRE
#undef G_PV16
#undef G_SOFTMAX
  int lane2; asm volatile("v_mbcnt_lo_u32_b32 %0, -1, 0\n\tv_mbcnt_hi_u32_b32 %0, -1, %0" : "=v"(lane2));
  const int r32b = lane2 & 31, hib = lane2 >> 5;
  { const float rl = __builtin_amdgcn_rcpf(l_reg);
    bf16* Ow = Ob + (long)(wid * QBLK + r32b) * LDO + 4 * hib;
#pragma unroll
    for (int d0 = 0; d0 < 4; ++d0)
#pragma unroll
      for (int g = 0; g < 4; ++g) { const unsigned long long w = (unsigned long long)cvtpk(o[d0][4 * g] * rl, o[d0][4 * g + 1] * rl) | ((unsigned long long)cvtpk(o[d0][4 * g + 2] * rl, o[d0][4 * g + 3] * rl) << 32);
        *(unsigned long long*)(Ow + d0 * 32 + g * 8) = w; } }
  AWAIT_BAR(0);
#undef DMA_K
#undef DMA_V
#undef DMA_K1
#undef DMA_V1
#undef ROT
#undef VBAR
}
}

namespace ba {
using namespace da;
constexpr float C2 = SCALE * 1.4426950408889634f;
__device__ __forceinline__ void battn_wg_unit(const bf16* __restrict__ Q, const bf16* __restrict__ K, const bf16* __restrict__ V, bf16* __restrict__ OG, float* __restrict__ LSE,
                                              int q0, int seg_lo, int seg_hi, int h, char* lds, __attribute__((address_space(3))) unsigned char* ldsl, const int wave_s) {
  constexpr int LD = 1024;
  int lane; asm volatile("v_mbcnt_lo_u32_b32 %0, -1, 0\n\tv_mbcnt_hi_u32_b32 %0, -1, %0" : "=v"(lane));
  const int wid = wave_s, r32 = lane & 31, hi = lane >> 5;
  char* K_lds = lds; char* V_lds = lds + 3 * ASLOT;
  float* ws = (float*)(lds + 6 * ASLOT) + wid * 64; float* li_l = ws; float* al_l = ws + 32;
  float mhat = 0.f, l_reg = 0; f32x16 o[4] = {}; bf16x8 qr[8]; f32x16 negm = {}; asm volatile("" : "+v"(negm));
  const int kb0 = q0 - 64;
  int krow[2], kcol[2], vrow[2], vcol[2];
#pragma unroll
  for (int i = 0; i < 2; ++i) { const int p = 2 * wid + i;
    krow[i] = 4 * p + (lane >> 4); kcol[i] = ((lane & 15) ^ (krow[i] & 7)) * 8;
    const int sub = 2 * p + (lane >> 5), kk = ((sub >> 2) << 3) | ((lane & 31) >> 2); vrow[i] = (kk & ~0xC) | ((kk & 4) << 1) | ((kk & 8) >> 1); vcol[i] = ((sub & 3) << 5) | ((lane & 3) << 3); }
  const bf16* Kh = K + h * 128; const bf16* Vh = V + h * 128;
#define BDMA(t, sl) do { const int kb_ = kb0 + 64 * (t); _Pragma("unroll") for (int i_ = 0; i_ < 2; ++i_) { \
    int rk_ = kb_ + krow[i_]; rk_ = rk_ < seg_lo ? seg_lo : (rk_ >= seg_hi ? seg_hi - 1 : rk_); int rv_ = kb_ + vrow[i_]; rv_ = rv_ < seg_lo ? seg_lo : (rv_ >= seg_hi ? seg_hi - 1 : rv_); \
    __builtin_amdgcn_global_load_lds((const unsigned*)(Kh + (long)rk_ * LD + kcol[i_]), (__attribute__((address_space(3))) unsigned*)(ldsl + (sl) + (2 * wid + i_) * 1024), 16, 0, 0); \
    __builtin_amdgcn_global_load_lds((const unsigned*)(Vh + (long)rv_ * LD + vcol[i_]), (__attribute__((address_space(3))) unsigned*)(ldsl + 3 * ASLOT + (sl) + (2 * wid + i_) * 1024), 16, 0, 0); } } while (0)
  BDMA(0, 0); BDMA(1, ASLOT);
  { const bf16* Qw = Q + (long)(q0 + wid * QBLK + r32) * LD + h * 128 + hi * 8;
#pragma unroll
    for (int d0 = 0; d0 < 8; ++d0) { const bf16x8 raw = ld8(Qw + d0 * 16); float x[8];
#pragma unroll
      for (int e = 0; e < 8; ++e) x[e] = __builtin_bit_cast(float, (unsigned)(unsigned short)raw[e] << 16) * CQ;
      u32x4 w = {cvtpk(x[0], x[1]), cvtpk(x[2], x[3]), cvtpk(x[4], x[5]), cvtpk(x[6], x[7])}; qr[d0] = *reinterpret_cast<bf16x8*>(&w); } }
  const int vb0 = (int)(uintptr_t)V_lds + v_rd_base(lane);
  const int qi = q0 + wid * QBLK + r32, t_lo = wid >> 1;
  int s0 = 2 * ASLOT, s1 = 0, s2 = ASLOT;
  bool started = false;
  AWAIT_BAR(0);
#pragma unroll 1
  for (int t = 0; t < 6; ++t) {
    { const int tn = t + 2 < 6 ? t + 2 : 5; BDMA(tn, s0); }
    const int kb = kb0 + 64 * t;
    const bool active = (t >= t_lo) && (t <= t_lo + 2) && (kb + 64 > seg_lo) && (kb < seg_hi);
    if (active) {
      f32x16 S0, S1; float al; bf16x8 pa0, pa1, pa2, pa3;
      qkt_n(S0, S1, (const bf16*)(K_lds + s1), qr, negm, r32, hi);
#pragma unroll
      for (int r = 0; r < 16; ++r) { const int ka = kb + crow(r, hi), kc = ka + 32;
        const bool oka = (ka - qi <= 64) & (qi - ka <= 64), okc = (kc - qi <= 64) & (qi - kc <= 64);
        S0[r] = oka ? S0[r] : -1e30f; S1[r] = okc ? S1[r] : -1e30f; }
      float pmax = S0[0];
#pragma unroll
      for (int r = 1; r < 16; ++r) pmax = fmaxf(pmax, S0[r]);
#pragma unroll
      for (int r = 0; r < 16; ++r) pmax = fmaxf(pmax, S1[r]);
      { auto rr = __builtin_amdgcn_permlane32_swap(__float_as_uint(pmax), __float_as_uint(pmax), false, false); pmax = fmaxf(__uint_as_float(rr[0]), __uint_as_float(rr[1])); }
      al = 1.f;
      if (!started || !__all(pmax <= THR2)) {
        const float dl = !started ? pmax : fmaxf(pmax, 0.f); mhat += dl;
#pragma unroll
        for (int r = 0; r < 16; ++r) { S0[r] -= dl; S1[r] -= dl; }
#pragma unroll
        for (int r = 0; r < 16; ++r) negm[r] = -mhat;
        asm volatile("" : "+v"(negm));
        if (started) al = __builtin_amdgcn_exp2f(-dl);
      }
      started = true;
      float ps = 0.f;
#pragma unroll
      for (int r = 0; r < 16; ++r) { S0[r] = __builtin_amdgcn_exp2f(S0[r]); S1[r] = __builtin_amdgcn_exp2f(S1[r]); ps += S0[r] + S1[r]; }
      { auto rr = __builtin_amdgcn_permlane32_swap(__float_as_uint(ps), __float_as_uint(ps), false, false); ps = __uint_as_float(rr[0]) + __uint_as_float(rr[1]); }
      l_reg = l_reg * al + ps;
      PK4(S0, 0, pa0); PK4(S0, 8, pa1); PK4(S1, 0, pa2); PK4(S1, 8, pa3);
      if (__any(al < 1.f)) { if (hi == 0) al_l[r32] = al; asm volatile("s_waitcnt lgkmcnt(0)" ::: "memory");
#pragma unroll
        for (int d = 0; d < 4; ++d)
#pragma unroll
          for (int r = 0; r < 16; ++r) o[d][r] *= al_l[crow(r, hi)]; }
      pv_d0(o, vb0 + s1, pa0, pa1, pa2, pa3);
    }
    AWAIT_BAR(4); { const int t_ = s0; s0 = s1; s1 = s2; s2 = t_; }
  }
  if (hi == 0) li_l[r32] = l_reg; asm volatile("s_waitcnt lgkmcnt(0)" ::: "memory");
  int lane2; asm volatile("v_mbcnt_lo_u32_b32 %0, -1, 0\n\tv_mbcnt_hi_u32_b32 %0, -1, %0" : "=v"(lane2));
  const int r32b = lane2 & 31, hib = lane2 >> 5;
  float rli[16];
#pragma unroll
  for (int r = 0; r < 16; ++r) rli[r] = __builtin_amdgcn_rcpf(li_l[crow(r, hib)]);
  bf16* Ow = OG + (long)(q0 + wid * QBLK) * LD + h * 128 + r32b;
#pragma unroll
  for (int r = 0; r < 16; ++r) { const int orow = crow(r, hib);
#pragma unroll
    for (int d0 = 0; d0 < 4; ++d0) Ow[(long)orow * LD + d0 * 32] = (bf16)(cvtpk(o[d0][r] * rli[r], 0.f) & 0xffffu); }
  if (hib == 0) LSE[(size_t)(q0 + wid * QBLK + r32b) * 8 + h] = (mhat + __builtin_amdgcn_logf(l_reg)) * 0.6931471805599453f;
  AWAIT_BAR(0);
#undef BDMA
}
}
#define GAS __attribute__((address_space(1)))
#define LAS __attribute__((address_space(3)))
typedef unsigned short bf16;
typedef unsigned v4u __attribute__((ext_vector_type(4)));
typedef float f32x4 __attribute__((ext_vector_type(4)));
typedef short bf16x8 __attribute__((ext_vector_type(8)));
typedef GAS unsigned gu32;
typedef GAS unsigned long long gu64;
#define RLX_AGENT __ATOMIC_RELAXED, __HIP_MEMORY_SCOPE_AGENT
#define LDS_WAIT() asm volatile("s_waitcnt lgkmcnt(0)" ::: "memory")
#define VM_WAIT() asm volatile("s_waitcnt vmcnt(0)" ::: "memory")
__device__ __forceinline__ unsigned long long rt() { return __builtin_amdgcn_s_memrealtime(); }
__device__ __forceinline__ unsigned f2bf(float f) { unsigned u = __builtin_bit_cast(unsigned, f); return (u + 0x7fffu + ((u >> 16) & 1u)) >> 16; }
__device__ __forceinline__ unsigned pk2(float lo, float hi) { return f2bf(lo) | (f2bf(hi) << 16); }

#define XB_TMO      128
#define XB_XCNT(j)  (256  + 64 * (j))
#define XB_XSUB(j)  (1280 + 64 * (j))
#define XB_XGEN(j)  (2304 + 64 * (j))
#define XB_TOP      3328
#define XB_TOPGEN   3392
#define XCD_BAR_WORDS 3456
#define XB_SPIN_CAP (1u << 18)

__device__ __forceinline__ unsigned xb_ld(unsigned* p)              { return __hip_atomic_load(p, __ATOMIC_RELAXED, __HIP_MEMORY_SCOPE_AGENT); }
__device__ __forceinline__ unsigned xb_add(unsigned* p, unsigned v) { return __hip_atomic_fetch_add(p, v, __ATOMIC_RELAXED, __HIP_MEMORY_SCOPE_AGENT); }
__device__ __forceinline__ unsigned xb_xcc_id() { return (unsigned)__builtin_amdgcn_s_getreg((3 << 11) | 20) & 0xFu; }
#define XB_SPIN(cond, bar) do { unsigned _sp = 0; while (cond) { __builtin_amdgcn_s_sleep(1); \
    if ((++_sp & 255u) == 0u) { if (xb_ld(&(bar)[XB_TMO])) break; if (_sp > XB_SPIN_CAP) { atomicAdd(&(bar)[XB_TMO], 1u); break; } } } } while (0)

struct XcdBarrier {
    unsigned* bar; unsigned x;
    volatile LAS unsigned* st;
};

__device__ __forceinline__ XcdBarrier xcd_barrier_post(unsigned* bar, volatile LAS unsigned* st) {
    XcdBarrier b; b.bar = bar; b.x = xb_xcc_id(); b.st = st;
    if (threadIdx.x == 0) (void)xb_add(&bar[XB_XCNT(b.x)], 1u);
    return b;
}
__device__ __forceinline__ void xcd_barrier_complete(unsigned* bar, unsigned x, unsigned& nloc, unsigned& nx) {
    const unsigned G = gridDim.x * gridDim.y * gridDim.z;
    unsigned sum, cnt, mine, sp = 0u;
    for (;;) {
        sum = 0u; cnt = 0u; mine = 0u;
#pragma unroll
        for (unsigned j = 0; j < 16; ++j) { const unsigned c = xb_ld(&bar[XB_XCNT(j)]); sum += c; cnt += (c > 0u) ? 1u : 0u; mine = (j == x) ? c : mine; }
        if (sum == G) break;
        __builtin_amdgcn_s_sleep(1);
        if ((++sp & 255u) == 0u) { if (xb_ld(&bar[XB_TMO])) break; if (sp > XB_SPIN_CAP) { atomicAdd(&bar[XB_TMO], 1u); break; } }
    }
    nloc = mine > 0u ? mine : 1u; nx = cnt > 0u ? cnt : 1u;
}

__device__ __forceinline__ void xcd_barrier(const XcdBarrier& b) {
    asm volatile("s_waitcnt vmcnt(0)" ::: "memory");
    __syncthreads();
    if (threadIdx.x == 0) {
        unsigned* bar = b.bar;
        __builtin_amdgcn_s_waitcnt(0);
        unsigned nloc = b.st[0], nx = b.st[1];
        if (nloc == 0u) { xcd_barrier_complete(bar, b.x, nloc, nx); b.st[0] = nloc; b.st[1] = nx; }
        const unsigned old = xb_add(&bar[XB_XSUB(b.x)], 1u);
        const unsigned gen = old / nloc;
        if (old + 1u == (gen + 1u) * nloc) {
            __builtin_amdgcn_fence(__ATOMIC_RELEASE, "agent");
            asm volatile("s_waitcnt vmcnt(0)" ::: "memory");
            const unsigned og = xb_add(&bar[XB_TOP], 1u);
            const unsigned tg = og / nx;
            if (og + 1u == (tg + 1u) * nx) xb_add(&bar[XB_TOPGEN], 1u);
            else XB_SPIN(xb_ld(&bar[XB_TOPGEN]) == tg, bar);
            __builtin_amdgcn_fence(__ATOMIC_ACQUIRE, "agent");
            xb_add(&bar[XB_XGEN(b.x)], 1u);
            asm volatile("s_waitcnt vmcnt(0)" ::: "memory");
        } else {
            XB_SPIN(xb_ld(&bar[XB_XGEN(b.x)]) == gen, bar);
            __builtin_amdgcn_fence(__ATOMIC_ACQUIRE, "agent");
            asm volatile("s_waitcnt vmcnt(0)" ::: "memory");
        }
    }
    __syncthreads();
}

constexpr int DM = 2048, SEQ = 16384, NSEQ = 3, MTOK = NSEQ * SEQ, HD = 128, DFF = 8192, MEMR = 768, DEPTH = 4;
constexpr float EPS = 1e-6f;
constexpr int NWAVES = 8;
#ifndef GM_ALIGN
#define GM_ALIGN true
#endif
#ifndef GM_SP2
#define GM_SP2 true
#endif
constexpr int MLPC = 8192;
#ifndef PHMASK
#define PHMASK 0xFFFFFFu
#endif
#define PH(n) (((PHMASK) >> (n)) & 1u)
#ifndef WGM_QKVB
#define WGM_QKVB 8
#define WGM_QKVA 8
#endif
#ifndef EXPN
#define EXPN 0
#endif
#define REPS(k) for (int rep_ = 0; rep_ < (((EXPN) == (k) || ((EXPN) == 9 && ((k) == 2 || (k) == 3 || (k) == 7))) ? 2 : 1); ++rep_)
constexpr size_t MiB = 1u << 20;
constexpr size_t WS_CTL = 0, CTL_ZERO_BYTES = 8 * MiB;
constexpr size_t WS_SS = 1 * MiB;
constexpr size_t WS_COS1 = 8 * MiB, WS_SIN1 = 12 * MiB;
constexpr size_t WS_AXT = 16 * MiB;
constexpr size_t WS_MEMN = 17 * MiB;
constexpr size_t WS_CKVT = 29 * MiB;
constexpr size_t WS_CKV = 45 * MiB;
constexpr size_t WS_WQKV = 51 * MiB;
constexpr size_t WS_WO = 87 * MiB;
constexpr size_t WS_CWQ = 95 * MiB, WS_CWO = 97 * MiB;
constexpr size_t WS_WUP = 99 * MiB, WS_WDN = 131 * MiB;
constexpr size_t WS_HN = 163 * MiB;
constexpr size_t WS_QKV = 355 * MiB;
constexpr size_t WS_BIG = 643 * MiB;
constexpr size_t WS_END = 899 * MiB;
constexpr size_t BIG_OB = 0, BIG_OG = 96 * MiB, BIG_LSE = 192 * MiB;
constexpr int CW_BAR = 4096;
constexpr int RING_BYTES = 131072;
constexpr int LDSCTL_OFF = RING_BYTES, MISC_OFF = LDSCTL_OFF + 320;
constexpr int PTAB_OFF = RING_BYTES + 512;
constexpr int BSCR_OFF = RING_BYTES + 1024;
constexpr int LDS_BYTES = 147456;

__device__ __forceinline__ float shflx(float v, int mask, int lane) { return __builtin_bit_cast(float, __builtin_amdgcn_ds_bpermute((lane ^ mask) << 2, __builtin_bit_cast(int, v))); }
__device__ __forceinline__ float wave_sum(float v, int lane) {
#pragma unroll
    for (int o = 1; o < 64; o <<= 1) v += shflx(v, o, lane);
    return v;
}
__device__ __forceinline__ int pair_row(int L) { const int w = L & 255, d = w & 127; return (L & ~255) + (d >> 6) * 128 + (w >> 7) * 64 + (d & 63); }
typedef _Float16 half2k __attribute__((ext_vector_type(2)));
__device__ __forceinline__ unsigned pkh(float lo, float hi) { const half2k v = {(_Float16)lo, (_Float16)hi}; return __builtin_bit_cast(unsigned, v); }
__device__ __forceinline__ unsigned pkhb(float lo, float hi) { const unsigned t = pk2(lo, hi); return pkh(__builtin_bit_cast(float, t << 16), __builtin_bit_cast(float, t & 0xFFFF0000u)); }
__device__ __forceinline__ void transpose_item(const float* W, const float* gain, int K, int N, bf16* WT, LAS float* scr, int item, int lane, int nperm = 0, bool f16 = false) {
    const int nblk = N / 32, kb = item / nblk, nb = item % nblk, k0 = 64 * kb, n0 = 32 * nb;
    float wv[32];
#pragma unroll
    for (int i = 0; i < 32; ++i) { const int kk = 2 * i + (lane >> 5); wv[i] = W[(size_t)(k0 + kk) * N + n0 + (lane & 31)]; }
    if (gain) {
#pragma unroll
        for (int i = 0; i < 32; ++i) wv[i] *= gain[k0 + 2 * i + (lane >> 5)];
    }
#pragma unroll
    for (int i = 0; i < 32; ++i) { const int kk = 2 * i + (lane >> 5); scr[kk * 33 + (lane & 31)] = wv[i]; }
    LDS_WAIT(); asm volatile("" ::: "memory");
    const int c = lane & 7;
#pragma unroll
    for (int j = 0; j < 4; ++j) { const int n = (lane >> 3) + 8 * j; const LAS float* s = scr + (8 * c) * 33 + n;
        v4u o;
        if (f16) { o.x = pkhb(s[0 * 33], s[1 * 33]); o.y = pkhb(s[2 * 33], s[3 * 33]); o.z = pkhb(s[4 * 33], s[5 * 33]); o.w = pkhb(s[6 * 33], s[7 * 33]); }
        else { o.x = pk2(s[0 * 33], s[1 * 33]); o.y = pk2(s[2 * 33], s[3 * 33]); o.z = pk2(s[4 * 33], s[5 * 33]); o.w = pk2(s[6 * 33], s[7 * 33]); }
        const int nr = (n0 + n) < nperm ? pair_row(n0 + n) : (n0 + n);
        *(GAS v4u*)(WT + (size_t)nr * K + k0 + 8 * c) = o; }
    LDS_WAIT(); asm volatile("" ::: "memory");
}
__device__ __forceinline__ void transpose_all(const float* W, const float* gain, int K, int N, bf16* WT, LAS float* scr, int gw, int NGW, int lane, int nperm = 0, bool f16 = false) {
    const int nitems = (K / 64) * (N / 32);
    for (int it = gw; it < nitems; it += NGW) transpose_item(W, gain, K, N, WT, scr, it, lane, nperm, f16);
}
__device__ __forceinline__ void rms_row_bf16(const float* xrow, const float* gain, bf16* orow, float* copy, int lane) {
    const GAS f32x4* xr = (const GAS f32x4*)xrow + lane; const GAS f32x4* gr = (const GAS f32x4*)gain + lane;
    f32x4 v[8]; float s = 0.f;
#pragma unroll
    for (int j = 0; j < 8; ++j) { v[j] = xr[64 * j]; s += (v[j].x * v[j].x + v[j].y * v[j].y) + (v[j].z * v[j].z + v[j].w * v[j].w); }
    const float rstd = 1.0f / sqrtf(wave_sum(s, lane) * (1.f / DM) + EPS);
    if (copy) { GAS f32x4* c4 = (GAS f32x4*)copy + lane;
#pragma unroll
        for (int j = 0; j < 8; ++j) c4[64 * j] = v[j]; }
    GAS unsigned long long* o8 = (GAS unsigned long long*)orow + lane;
#pragma unroll
    for (int j = 0; j < 8; ++j) { const f32x4 g = gr[64 * j];
        o8[64 * j] = (unsigned long long)pk2(v[j].x * rstd * g.x, v[j].y * rstd * g.y) | ((unsigned long long)pk2(v[j].z * rstd * g.z, v[j].w * rstd * g.w) << 32); }
}
__device__ __forceinline__ void prep_row(const float* xrow, bf16* brow, unsigned long long* ss, int lane) {
    const GAS f32x4* xr = (const GAS f32x4*)xrow + lane; GAS unsigned long long* o8 = (GAS unsigned long long*)brow + lane;
    f32x4 v[8]; float s = 0.f;
#pragma unroll
    for (int j = 0; j < 8; ++j) { v[j] = xr[64 * j]; s += (v[j].x * v[j].x + v[j].y * v[j].y) + (v[j].z * v[j].z + v[j].w * v[j].w); }
    s = wave_sum(s, lane);
#pragma unroll
    for (int j = 0; j < 8; ++j) o8[64 * j] = (unsigned long long)pkh(v[j].x, v[j].y) | ((unsigned long long)pkh(v[j].z, v[j].w) << 32);
    if (lane == 0) *ss = (unsigned long long)(s * 1048576.f + 0.5f);
}
__device__ __forceinline__ void final_row(const bf16* brow, float* orow, const float* gain, const unsigned long long* ss, int lane) {
    const GAS unsigned long long* b8 = (const GAS unsigned long long*)brow + lane; GAS f32x4* xr = (GAS f32x4*)orow + lane; const GAS f32x4* gr = (const GAS f32x4*)gain + lane;
    const float rstd = 1.0f / sqrtf((float)*ss * (1.0f / (1048576.f * 2048.f)) + EPS);
#pragma unroll
    for (int j = 0; j < 8; ++j) { const f32x4 g = gr[64 * j]; const unsigned long long w = b8[64 * j];
        const half2k lo = __builtin_bit_cast(half2k, (unsigned)w), hi = __builtin_bit_cast(half2k, (unsigned)(w >> 32));
        f32x4 v; v.x = (float)lo[0]; v.y = (float)lo[1]; v.z = (float)hi[0]; v.w = (float)hi[1];
        xr[64 * j] = v * rstd * g; }
}
__device__ __forceinline__ float bf2f(unsigned short b) { return __builtin_bit_cast(float, (unsigned)b << 16); }
typedef unsigned short us8 __attribute__((ext_vector_type(8)));

typedef const __attribute__((address_space(4))) unsigned long long* kargp_t;
#define P_IN(i) ((const float*)(const GAS float*)kp[(i)])
#define PHASE_PTRS kargp_t kp = (kargp_t)__builtin_amdgcn_kernarg_segment_ptr(); asm volatile("" : "+s"(kp)); unsigned char* ws = (unsigned char*)(GAS unsigned char*)kp[21]; \
    const float* x_prompt = P_IN(0); const float* x_sample = P_IN(1); const float* mem_prompt = P_IN(2); const float* mem_sample = P_IN(3); \
    const float* norm_mix = P_IN(4); const float* a_wqkv = P_IN(5); const float* a_q_gain = P_IN(6); const float* a_k_gain = P_IN(7); const float* a_wo = P_IN(8); \
    const float* b_wqkv = P_IN(9); const float* b_wo = P_IN(10); const float* norm_cross = P_IN(11); const float* norm_mem = P_IN(12); \
    const float* c_wq = P_IN(13); const float* c_wkv = P_IN(14); const float* c_wo = P_IN(15); const float* norm_mlp = P_IN(16); \
    const float* w_up = P_IN(17); const float* w_down = P_IN(18); const float* final_norm = P_IN(19); \
    float* X = (float*)(GAS float*)kp[20]; \
    unsigned long long* SS = (unsigned long long*)(ws + WS_SS); float* COS1 = (float*)(ws + WS_COS1); float* SIN1 = (float*)(ws + WS_SIN1); float* AXT = (float*)(ws + WS_AXT); \
    bf16* MEMN = (bf16*)(ws + WS_MEMN); bf16* CKVT = (bf16*)(ws + WS_CKVT); bf16* CKV = (bf16*)(ws + WS_CKV); \
    bf16* WQKV = (bf16*)(ws + WS_WQKV); bf16* WO = (bf16*)(ws + WS_WO); bf16* CWQ = (bf16*)(ws + WS_CWQ); bf16* CWO = (bf16*)(ws + WS_CWO); \
    bf16* WUP = (bf16*)(ws + WS_WUP); bf16* WDN = (bf16*)(ws + WS_WDN); bf16* HN = (bf16*)(ws + WS_HN); \
    bf16* QKV = (bf16*)(ws + WS_QKV); bf16* HB = (bf16*)(ws + WS_BIG); \
    bf16* OB = (bf16*)(ws + WS_BIG + BIG_OB); bf16* OG = (bf16*)(ws + WS_BIG + BIG_OG); float* LSE = (float*)(ws + WS_BIG + BIG_LSE); \
    bf16* QA = QKV; bf16* KA = QKV + (size_t)MTOK * 2048; bf16* VA = KA + (size_t)MTOK * 512;
struct Args { const float* in[20]; float* out; unsigned char* ws; };
__global__ void __launch_bounds__(NWAVES * 64, 2) fwd_kernel(Args args) {
    extern __shared__ __attribute__((aligned(16))) unsigned char lds[];
    LAS unsigned char* ldsl = (LAS unsigned char*)lds;
    volatile LAS unsigned* MISC = (volatile LAS unsigned*)(ldsl + MISC_OFF);
    const int wave = __builtin_amdgcn_readfirstlane(threadIdx.x >> 6);
#define OPQ_LANE int lane, G = G_k, bx = bx_k; asm volatile("v_mbcnt_lo_u32_b32 %0, -1, 0\n\tv_mbcnt_hi_u32_b32 %0, -1, %0" : "=v"(lane)); asm volatile("" : "+s"(G), "+s"(bx)); const int tid = wave * 64 + lane; const int gw = bx * NWAVES + wave, NGW = G * NWAVES; LAS float* tscr = (LAS float*)(ldsl + wave * 16384)
    const int G_k = gridDim.x, bx_k = blockIdx.x;
    for (int u = threadIdx.x; u < (LDS_BYTES - LDSCTL_OFF) / 4; u += NWAVES * 64) ((LAS unsigned*)(ldsl + LDSCTL_OFF))[u] = 0u;
    __syncthreads();
    XcdBarrier bar = xcd_barrier_post((unsigned*)(args.ws + WS_CTL) + CW_BAR, MISC + 8);
#define GRID_BAR() do { XcdBarrier b2_ = bar; unsigned long long bp_ = (unsigned long long)bar.bar; asm volatile("" : "+s"(bp_), "+s"(b2_.x)); b2_.bar = (unsigned*)(GAS unsigned*)bp_; xcd_barrier(b2_); } while (0)


    if constexpr (PH(0))
    { OPQ_LANE; PHASE_PTRS;
        for (int e = bx * 512 + tid; e < SEQ * 64; e += G * 512) {
            const int t = e >> 6, i = e & 63;
            const double inv = exp2(-(double)i * (13.287712379549449 / 64.0));
            const double a = (double)t * inv, rev = a * 0.15915494309189535; const float fr = (float)(rev - floor(rev));
            COS1[e] = __builtin_amdgcn_cosf(fr); SIN1[e] = __builtin_amdgcn_sinf(fr);
        }
        for (int e = bx * 512 + tid; e < 320 * 32; e += G * 512) {
            const int p = e >> 5, i = e & 31; const int pos = p < 256 ? p : p - 256;
            const double inv = exp2(-(double)i * (13.287712379549449 / 32.0));
            const double a = (double)pos * inv, rev = a * 0.15915494309189535; const float fr = (float)(rev - floor(rev));
            const float c = __builtin_amdgcn_cosf(fr), s = __builtin_amdgcn_sinf(fr);
            if (p < 256) { AXT[p * 32 + i] = c; AXT[8192 + p * 32 + i] = s; } else { AXT[16384 + pos * 32 + i] = c; AXT[16384 + 2048 + pos * 32 + i] = s; }
        }
        for (int r = gw; r < DEPTH * MEMR; r += NGW) { const int l = r / MEMR, m = r % MEMR;
            const float* src = m < 256 ? mem_prompt + (size_t)m * DM : mem_sample + (size_t)(m - 256) * DM;
            rms_row_bf16(src, norm_mem + l * DM, MEMN + (size_t)r * DM, nullptr, lane); }
        for (int l = 0; l < DEPTH; ++l) transpose_all(c_wkv + (size_t)l * DM * 1024, nullptr, DM, 1024, CKVT + (size_t)l * 1024 * DM, tscr, gw, NGW, lane);
    }

    for (int layer = 0; layer < DEPTH; ++layer) {
        const int j = layer >> 1; const bool isA = (layer & 1) == 0;
        if constexpr (PH(1))
        { OPQ_LANE; PHASE_PTRS;
            REPS(3) {
            const float* gmix = norm_mix + layer * DM;
            if (isA) { transpose_all(a_wqkv + (size_t)j * DM * 3072, gmix, DM, 3072, WQKV, tscr, gw, NGW, lane, 0, true); transpose_all(a_wo + (size_t)j * DM * DM, nullptr, DM, DM, WO, tscr, gw, NGW, lane); }
            else { transpose_all(b_wqkv + (size_t)j * DM * 9216, gmix, DM, 9216, WQKV, tscr, gw, NGW, lane, 6144, true); transpose_all(b_wo + (size_t)j * 1024 * DM, nullptr, 1024, DM, WO, tscr, gw, NGW, lane); }
            transpose_all(c_wq + (size_t)layer * DM * 512, norm_cross + layer * DM, DM, 512, CWQ, tscr, gw, NGW, lane, 0, true);
            transpose_all(c_wo + (size_t)layer * 512 * DM, nullptr, 512, DM, CWO, tscr, gw, NGW, lane);
            transpose_all(w_up + (size_t)layer * DM * DFF, norm_mlp + layer * DM, DM, DFF, WUP, tscr, gw, NGW, lane, 0, true);
            transpose_all(w_down + (size_t)layer * DFF * DM, nullptr, DFF, DM, WDN, tscr, gw, NGW, lane);
            if (layer == 0) {
                for (int m = gw; m < MTOK; m += NGW) { const float* src = m < SEQ ? x_prompt + (size_t)m * DM : x_sample + (size_t)(m - SEQ) * DM;
                    prep_row(src, HN + (size_t)m * DM, SS + m, lane); }
            }
            GRID_BAR(); }
        }
        if (isA) {
            if constexpr (PH(3))
            { OPQ_LANE; PHASE_PTRS; pg8::Gemm g{HN, WQKV, MTOK, 3072, DM}; pg8::RepOrder S; S.init(MTOK, 3072, G, bx, WGM_QKVA); S.reps = (EXPN == 11) ? 2 : 1;
              pg8::EpiB<1> E{QA, 2048, 1, KA, VA, SS + (size_t)(3 * layer) * MTOK, nullptr, nullptr};
              pg8::gemm_phase<pg8::EpiB<1>, pg8::RepOrder, GM_ALIGN, GM_SP2, true>(ldsl, g, S, E, tid); GRID_BAR(); }
            if constexpr (PH(4))
            { OPQ_LANE; PHASE_PTRS;
                const float* qg = a_q_gain + j * HD; const float* kg = a_k_gain + j * HD;
                const int jl = lane & 15, sub = lane >> 4;
                const long nq = (long)MTOK * 16, nk = (long)MTOK * 4;
                for (long hr4 = nq / 4 + gw; hr4 < (nq + nk) / 4; hr4 += NGW) {
                    long hr = hr4 * 4 + sub; const bool isq = hr < nq; bf16* p; int tok; const float* gp;
                    if (isq) { p = QA + hr * 128; tok = (int)(hr >> 4); gp = qg; } else { hr -= nq; p = KA + hr * 128; tok = (int)(hr >> 2); gp = kg; }
                    const int t = tok & (SEQ - 1), prow = t >> 6, pcol = t & 63;
                    const us8 raw = *(const GAS us8*)(p + jl * 8);
                    float v[8]; float ss = 0.f;
#pragma unroll
                    for (int e = 0; e < 8; ++e) { v[e] = bf2f(raw[e]); ss += v[e] * v[e]; }
                    ss += shflx(ss, 1, lane); ss += shflx(ss, 2, lane); ss += shflx(ss, 4, lane); ss += shflx(ss, 8, lane);
                    const float rstd = 1.0f / sqrtf(ss * (1.f / 128.f) + EPS);
                    const float* ct = (jl < 8) ? AXT + prow * 32 + (jl & 3) * 8 : AXT + 16384 + pcol * 32 + (jl & 3) * 8;
                    const float* st = ct + ((jl < 8) ? 8192 : 2048);
                    const f32x4 g0 = *(const GAS f32x4*)(gp + jl * 8), g1 = *(const GAS f32x4*)(gp + jl * 8 + 4);
                    const f32x4 c0 = *(const GAS f32x4*)ct, c1 = *(const GAS f32x4*)(ct + 4), s0 = *(const GAS f32x4*)st, s1 = *(const GAS f32x4*)(st + 4);
                    const float sgn = (jl & 4) ? 1.f : -1.f;
                    float o[8];
#pragma unroll
                    for (int e = 0; e < 8; ++e) { const float y = v[e] * rstd * (e < 4 ? g0[e] : g1[e - 4]); const float pr = shflx(y, 4, lane);
                        const float c = e < 4 ? c0[e] : c1[e - 4], s = e < 4 ? s0[e] : s1[e - 4]; o[e] = y * c + sgn * pr * s; }
                    v4u w; w.x = pk2(o[0], o[1]); w.y = pk2(o[2], o[3]); w.z = pk2(o[4], o[5]); w.w = pk2(o[6], o[7]);
                    *(GAS v4u*)(p + jl * 8) = w;
                }
                GRID_BAR();
            }
            if constexpr (PH(5))
            { OPQ_LANE; PHASE_PTRS;
                float gqm = 0.f, gkm = 0.f;
                for (int d = 0; d < HD; ++d) { gqm = fmaxf(gqm, fabsf(a_q_gain[j * HD + d])); gkm = fmaxf(gkm, fabsf(a_k_gain[j * HD + d])); }
                const float bnd = gqm * gkm * (128.f * da::CQ * 1.02f) + 0.5f;
                REPS(1) {
                for (int u = bx; u < NSEQ * 16 * 64; u += G) {
                    const int qb = u & 63, hg = (u >> 6) & 3, kvh = (u >> 8) & 3, b = u >> 10, h = kvh * 4 + hg;
                    const size_t qoff = ((size_t)b * SEQ + (size_t)qb * 256) * 2048 + h * 128;
                    const bf16* Kh = KA + (size_t)b * SEQ * 512 + kvh * 128; const bf16* Vh = VA + (size_t)b * SEQ * 512 + kvh * 128;
                    da::attn_dense_stg<2048, 512, 2048>(QA + qoff, Kh, Vh, HB + qoff, SEQ, (char*)lds, ldsl, wave, a_q_gain + j * HD, AXT, qb * 256, bnd);
                }
                GRID_BAR(); }
            }
            if constexpr (PH(6))
            { OPQ_LANE; PHASE_PTRS; pg8::Gemm g{HB, WO, MTOK, DM, DM}; pg8::StaticOrder S; S.init(MTOK, DM, G, bx);
              pg8::EpiRes E{HN, SS + (size_t)(3 * layer + 1) * MTOK, DM, 0};
              pg8::gemm_phase<pg8::EpiRes, pg8::StaticOrder, GM_ALIGN, GM_SP2>(ldsl, g, S, E, tid); GRID_BAR(); }
        } else {
            for (int sq = 0; sq <= NSEQ; ++sq) {
                if constexpr (PH(7)) if (sq < NSEQ)
                { OPQ_LANE; PHASE_PTRS; pg8::Gemm g{HN + (size_t)sq * SEQ * DM, WQKV, SEQ, 9216, DM}; pg8::RepOrder S; S.init(SEQ, 9216, G, bx, WGM_QKVB); S.reps = (EXPN == 10) ? 2 : 1;
                  pg8::EpiB<2> E{QKV, 1024, 1, nullptr, nullptr, SS + (size_t)(3 * layer) * MTOK + (size_t)sq * SEQ, COS1, SIN1};
                  pg8::gemm_phase<pg8::EpiB<2>, pg8::RepOrder, GM_ALIGN, GM_SP2, true>(ldsl, g, S, E, tid); }
                if constexpr (PH(10)) if (sq > 0)
                { OPQ_LANE; PHASE_PTRS;
                    const int jl = lane & 15, sub = lane >> 4;
                    REPS(7) {
                    for (int r4 = gw; r4 < SEQ * 8 / 4; r4 += NGW) {
                        const int rr = r4 * 4 + sub, t = rr >> 3, h = rr & 7;
                        float ls[3]; us8 ov[3];
#pragma unroll
                        for (int g = 0; g < 3; ++g) { const int shift = 2 * g; const int pp = ((t & ((1 << shift) - 1)) << (14 - shift)) + (t >> shift);
                            ls[g] = LSE[(size_t)g * SEQ * 8 + (size_t)pp * 8 + h]; ov[g] = *(const GAS us8*)(OG + (size_t)g * SEQ * 1024 + (size_t)pp * 1024 + h * 128 + jl * 8); }
                        const float mx = fmaxf(ls[0], fmaxf(ls[1], ls[2]));
                        float w0 = __expf(ls[0] - mx), w1 = __expf(ls[1] - mx), w2 = __expf(ls[2] - mx); const float inv = 1.f / (w0 + w1 + w2); w0 *= inv; w1 *= inv; w2 *= inv;
                        float o[8];
#pragma unroll
                        for (int e = 0; e < 8; ++e) o[e] = w0 * bf2f(ov[0][e]) + w1 * bf2f(ov[1][e]) + w2 * bf2f(ov[2][e]);
                        v4u w; w.x = pk2(o[0], o[1]); w.y = pk2(o[2], o[3]); w.z = pk2(o[4], o[5]); w.w = pk2(o[6], o[7]);
                        *(GAS v4u*)(OB + ((size_t)(sq - 1) * SEQ + t) * 1024 + h * 128 + jl * 8) = w;
                    }
                    }
                }
                { OPQ_LANE; GRID_BAR(); }
                if constexpr (PH(9)) if (sq < NSEQ)
                { OPQ_LANE; PHASE_PTRS;
                    REPS(4) {
                    for (int u = bx; u < 3 * 8 * (SEQ / 256); u += G) {
                        const int blkq = u & 63, gh = u >> 6, g = gh >> 3, h = gh & 7, q0 = blkq * 256;
                        const int seglen = SEQ >> (2 * g), seg_lo = q0 & ~(seglen - 1), seg_hi = seg_lo + seglen;
                        const size_t blk = (size_t)SEQ * 1024;
                        ba::battn_wg_unit(QKV + (size_t)g * blk, QKV + (size_t)(3 + g) * blk, QKV + (size_t)(6 + g) * blk, OG + (size_t)g * blk, LSE + (size_t)g * SEQ * 8,
                                          q0, seg_lo, seg_hi, h, (char*)lds, ldsl, wave);
                    }
                    GRID_BAR(); }
                }
            }
            if constexpr (PH(11))
            { OPQ_LANE; PHASE_PTRS; pg8::Gemm g{OB, WO, MTOK, DM, 1024}; pg8::StaticOrder S; S.init(MTOK, DM, G, bx);
              pg8::EpiRes E{HN, SS + (size_t)(3 * layer + 1) * MTOK, DM, 0};
              pg8::gemm_phase<pg8::EpiRes, pg8::StaticOrder, GM_ALIGN, GM_SP2>(ldsl, g, S, E, tid); GRID_BAR(); }
        }
        if constexpr (PH(13))
        { OPQ_LANE; PHASE_PTRS; pg8::Gemm g{HN, CWQ, MTOK, 512, DM}; pg8::StaticOrder S; S.init(MTOK, 512, G, bx);
          pg8::EpiB<0> E{QKV, 512, 1 << 20, nullptr, nullptr, SS + (size_t)(3 * layer + 1) * MTOK, nullptr, nullptr};
          pg8::gemm_phase<pg8::EpiB<0>, pg8::StaticOrder, GM_ALIGN, GM_SP2, true>(ldsl, g, S, E, tid);
          if (PH(2) && layer == 0 && bx >= 128) {
            pg8::Gemm g2{MEMN, CKVT, DEPTH * MEMR, DEPTH * 1024, DM}; pg8::GroupedOrder S2; S2.init(128, bx - 128);
            pg8::EpiB<0> E2{CKV, 1024, 4, nullptr, nullptr, nullptr, nullptr, nullptr};
            pg8::gemm_phase<pg8::EpiB<0>, pg8::GroupedOrder, GM_ALIGN, GM_SP2>(ldsl, g2, S2, E2, tid); }
          GRID_BAR(); }
        if constexpr (PH(14))
        { OPQ_LANE; PHASE_PTRS;
            const bf16* ckv = CKV + (size_t)layer * MEMR * 1024;
            REPS(2) {
            for (int u = bx; u < NSEQ * 4 * 64; u += G) {
                const int qb = u & 63, h = (u >> 6) & 3, b = u >> 8;
                const size_t qoff = ((size_t)b * SEQ + (size_t)qb * 256) * 512 + h * 128;
                const bf16* Kh = ckv + (size_t)b * 256 * 1024 + h * 128; const bf16* Vh = Kh + 512;
                da::attn_dense_body<512, 1024, 512, false>(QKV + qoff, Kh, Vh, HB + qoff, 256, (char*)lds, ldsl, wave);
            }
            GRID_BAR(); }
        }
        if constexpr (PH(15))
        { OPQ_LANE; PHASE_PTRS; pg8::Gemm g{HB, CWO, MTOK, DM, 512}; pg8::StaticOrder S; S.init(MTOK, DM, G, bx);
          pg8::EpiRes E{HN, SS + (size_t)(3 * layer + 2) * MTOK, DM, 0};
          pg8::gemm_phase<pg8::EpiRes, pg8::StaticOrder, GM_ALIGN, GM_SP2>(ldsl, g, S, E, tid); GRID_BAR(); }
        for (int ch = 0; ch <= MTOK / MLPC; ++ch) {
            if constexpr (PH(18)) if (ch > 0)
            { OPQ_LANE; PHASE_PTRS; const int c = ch - 1; pg8::Gemm g{HB + (size_t)(c & 1) * MLPC * DFF, WDN, MLPC, DM, DFF}; pg8::StaticOrder S; S.init(MLPC, DM, G, bx);
              if (EXPN == 6) {
                  pg8::EpiRes E2{(bf16*)(ws + WS_END + 64 * MiB), (unsigned long long*)(ws + WS_END + 96 * MiB), DM, 0};
                  pg8::gemm_phase<pg8::EpiRes, pg8::StaticOrder, GM_ALIGN, GM_SP2>(ldsl, g, S, E2, tid); }
              pg8::EpiRes E{HN, SS + (size_t)(3 * layer + 3) * MTOK, DM, c * MLPC};
              pg8::gemm_phase<pg8::EpiRes, pg8::StaticOrder, GM_ALIGN, GM_SP2>(ldsl, g, S, E, tid); }
            if constexpr (PH(17)) if (ch < MTOK / MLPC)
            { OPQ_LANE; PHASE_PTRS; pg8::Gemm g{HN + (size_t)ch * MLPC * DM, WUP, MLPC, DFF, DM}; pg8::RepOrder S; S.init(MLPC, DFF, G, bx); S.reps = (EXPN == 5) ? 2 : 1;
              pg8::EpiB<3> E{HB + (size_t)(ch & 1) * MLPC * DFF, DFF, 1 << 20, nullptr, nullptr, SS + (size_t)(3 * layer + 2) * MTOK + (size_t)ch * MLPC, nullptr, nullptr};
              pg8::gemm_phase<pg8::EpiB<3>, pg8::RepOrder, GM_ALIGN, GM_SP2, true>(ldsl, g, S, E, tid); }
            GRID_BAR();
        }
    }
    if constexpr (PH(19)) { OPQ_LANE; PHASE_PTRS;
    for (int m = gw; m < MTOK; m += NGW) final_row(HN + (size_t)m * DM, X + (size_t)m * DM, final_norm, SS + (size_t)12 * MTOK + m, lane); }
}

extern "C" void kernel_launch(void* const* d_in, const int* in_sizes, int n_in, void* d_out, int out_size, void* d_ws, size_t ws_size, hipStream_t stream) {
    static int grid = 0;
    if (grid == 0) {
        if (n_in != 20 || out_size != MTOK * DM || ws_size < WS_END) { fprintf(stderr, "kernel_launch: unexpected shapes: n_in %d out %d ws %zu (need %zu)\n", n_in, out_size, ws_size, (size_t)WS_END); grid = -1; return; }
        int dev = 0, cus = 0, per_cu = 0;
        if (hipGetDevice(&dev) != hipSuccess || hipDeviceGetAttribute(&cus, hipDeviceAttributeMultiprocessorCount, dev) != hipSuccess) { grid = -1; return; }
        if (hipFuncSetAttribute((const void*)fwd_kernel, hipFuncAttributeMaxDynamicSharedMemorySize, LDS_BYTES) != hipSuccess) { fprintf(stderr, "kernel_launch: hipFuncSetAttribute failed\n"); grid = -1; return; }
        if (hipOccupancyMaxActiveBlocksPerMultiprocessor(&per_cu, (const void*)fwd_kernel, NWAVES * 64, LDS_BYTES) != hipSuccess || per_cu < 1)
            fprintf(stderr, "kernel_launch: note: occupancy query reports %d workgroups per CU\n", per_cu);
        (void)hipGetLastError();
        grid = cus;
    }
    if (grid < 0) return;
    if (hipMemsetAsync((char*)d_ws + WS_CTL, 0, CTL_ZERO_BYTES, stream) != hipSuccess) { fprintf(stderr, "kernel_launch: memset failed\n"); return; }
    Args a{};
    for (int i = 0; i < 20; ++i) a.in[i] = (const float*)d_in[i];
    a.out = (float*)d_out; a.ws = (unsigned char*)d_ws;
    hipLaunchKernelGGL(fwd_kernel, dim3(grid), dim3(NWAVES * 64), LDS_BYTES, stream, a);
    const hipError_t le = hipPeekAtLastError();
    if (le != hipSuccess) fprintf(stderr, "kernel_launch: launch failed: %s\n", hipGetErrorName(le));
}
```

```cpp
#include <hip/hip_runtime.h>
#include <cstdio>
#include <cstdint>
namespace pg8 {
#define PG8_LAS __attribute__((address_space(3)))
typedef unsigned short bf16_t;
typedef short bf16x8 __attribute__((ext_vector_type(8)));
typedef float f32x4 __attribute__((ext_vector_type(4)));
typedef unsigned u32x4 __attribute__((ext_vector_type(4)));
constexpr int BM = 256, BK = 64, HALF = 128, HTB = HALF * BK * 2  , STAGE_BYTES = 8 * HTB, NXCD = 8, WGM = 4;

__host__ __device__ __forceinline__ int lds_byte(int r, int c) { const int st = (r >> 4) * 2 + (c >> 5), rr = r & 15, cc = c & 31, ob = rr * 64 + cc * 2; return st * 1024 + (ob ^ (((ob >> 9) & 1) << 5)); }
__host__ __device__ __forceinline__ void stage_rc(int b, int& R, int& C) { const int st = b / 1024, sb = b % 1024, swz = sb ^ (((sb >> 9) & 1) << 5); R = (st >> 1) * 16 + swz / 64; C = (st & 1) * 32 + (swz % 64) / 2; }
__host__ __device__ __forceinline__ int perm32(int rho) { const int n = rho >> 4, i = rho & 15; return 8 * (i >> 2) + 4 * n + (i & 3); }

struct Unit { int pm, pn; };
struct Gemm { const bf16_t* A; const bf16_t* Bt; int M, N, K; };

struct StaticOrder {
    int nM, nN, nwg, G, c, wgm;
    __host__ __device__ void init(int M, int N, int G_, int c_, int wgm_ = WGM) { nM = M / BM; nN = N / BM; nwg = nM * nN; G = G_; c = c_; wgm = wgm_; }
    __host__ __device__ bool next(int i, Unit& u) const {
        const long L = (long)i * G + c; if (L >= nwg) return false;
        int wgid = (int)L; { const int q = nwg / NXCD, r = nwg % NXCD, xcd = wgid % NXCD, off = wgid / NXCD; wgid = (xcd < r ? xcd * (q + 1) : r * (q + 1) + (xcd - r) * q) + off; }
        const int nig = wgm * nN, gid = wgid / nig, fm = gid * wgm, gsz = (nM - fm) < wgm ? (nM - fm) : wgm;
        u.pm = fm + ((wgid % nig) % gsz); u.pn = (wgid % nig) / gsz; return true;
    }
    __device__ __forceinline__ void a_ready(const Unit&) const {}
    __device__ __forceinline__ void done(const Unit&) const {}
};

__device__ __forceinline__ unsigned cvt_pk_bf16(float lo, float hi) { unsigned r; asm volatile("v_cvt_pk_bf16_f32 %0, %1, %2" : "=v"(r) : "v"(lo), "v"(hi)); return r; }
typedef float f32x2 __attribute__((ext_vector_type(2)));
__device__ __forceinline__ f32x2 gelu_pk(f32x2 v) {
    const f32x2 av = __builtin_elementwise_abs(v), d = av * 0.2316418882f + 1.0f;
    f32x2 t; t.x = __builtin_amdgcn_rcpf(d.x); t.y = __builtin_amdgcn_rcpf(d.y);
    f32x2 q = t * 0.5307027145f + (-0.7265760135f); q = q * t + 0.7107068705f; q = q * t + (-0.142248368f); q = q * t + 0.127414796f; q = q * t;
    const f32x2 s = (v * v) * (-0.72134752044f);
    f32x2 e; e.x = __builtin_amdgcn_exp2f(s.x); e.y = __builtin_amdgcn_exp2f(s.y);
    const f32x2 m = v * (q * e), r = v - m;
    f32x2 o; o.x = v.x < 0.f ? m.x : r.x; o.y = v.y < 0.f ? m.y : r.y; return o;
}

template <int ACT  > struct EpiBf16 {
    static constexpr bool PERM = true, AFTER_DRAIN = false; static_assert(ACT == 0 || ACT == 1, "EpiBf16: ACT is 0 (none) or 1 (gelu_pk)");
    bf16_t* O; int ldc; const float* bias; int split_cols; size_t split_stride; float scale0;
    __device__ __forceinline__ void operator()(const f32x4 (&acc)[2][2][4][2], const Unit& u, int wr, int wc, int fr, int fq) const {
        const int row0 = u.pm * BM + wr * 64 + fr; int colt = u.pn * BM; bf16_t* base = O;
        float sc = 1.f; if (split_cols) { const int t = colt / split_cols; base += (size_t)t * split_stride; colt -= t * split_cols; if (t == 0) sc = scale0; }
        const int col0 = colt + wc * 32 + 8 * fq, bcol0 = u.pn * BM + wc * 32 + 8 * fq;
        f32x4 bv[2][2];
#pragma unroll
        for (int bj = 0; bj < 2; ++bj)
#pragma unroll
            for (int n = 0; n < 2; ++n) bv[bj][n] = bias ? *(const f32x4*)(bias + bcol0 + bj * HALF + 4 * n) : (f32x4){0.f, 0.f, 0.f, 0.f};
#pragma unroll
        for (int ai = 0; ai < 2; ++ai)
#pragma unroll
            for (int m = 0; m < 4; ++m) { bf16_t* rowp = base + (size_t)(row0 + ai * HALF + m * 16) * ldc + col0;
#pragma unroll
                for (int bj = 0; bj < 2; ++bj) { f32x4 v0 = acc[ai][bj][m][0] + bv[bj][0], v1 = acc[ai][bj][m][1] + bv[bj][1];
                    if (ACT == 1) { f32x2 a = gelu_pk((f32x2){v0[0], v0[1]}), b = gelu_pk((f32x2){v0[2], v0[3]}), c = gelu_pk((f32x2){v1[0], v1[1]}), d = gelu_pk((f32x2){v1[2], v1[3]});
                        v0 = (f32x4){a.x, a.y, b.x, b.y}; v1 = (f32x4){c.x, c.y, d.x, d.y}; }
                    v0 = v0 * sc; v1 = v1 * sc; u32x4 w; w.x = cvt_pk_bf16(v0[0], v0[1]); w.y = cvt_pk_bf16(v0[2], v0[3]); w.z = cvt_pk_bf16(v1[0], v1[1]); w.w = cvt_pk_bf16(v1[2], v1[3]);
                    *(u32x4*)(rowp + bj * HALF) = w; } }
    }
};

template <int MODE> struct EpiB {
    static constexpr bool PERM = true, AFTER_DRAIN = false;
    bf16_t* O; int ldc; int pn_mod; bf16_t* O2; bf16_t* O3;
    const unsigned long long* SS;
    const float* cs; const float* sn;
    __device__ __forceinline__ void operator()(const f32x4 (&acc)[2][2][4][2], const Unit& u, int wr, int wc, int fr, int fq) const {
        const int row0 = u.pm * BM + wr * 64 + fr;
        bf16_t* base = O; int ld = ldc, colt = 0, shift = 0, which = 2;
        if constexpr (MODE == 0 || MODE == 3) { colt = (u.pn % pn_mod) * BM; }
        if constexpr (MODE == 1) {
            if (u.pn < 8) { base = O; ld = 2048; colt = u.pn * BM; }
            else if (u.pn < 10) { base = O2; ld = 512; colt = (u.pn - 8) * BM; }
            else { base = O3; ld = 512; colt = (u.pn - 10) * BM; }
        }
        if constexpr (MODE == 2) {
            which = u.pn / 12; const int g = (u.pn % 12) / 4; colt = (u.pn % 4) * BM; ld = 1024; shift = 2 * g;
            base = O + (size_t)(which * 3 + g) * ((size_t)16384 * 1024);
        }
        const int col0 = colt + wc * 32 + 8 * fq;
        const int rcol = colt + (wc >> 1) * 128 + (wc & 1) * 32 + 8 * fq, rdim = (wc & 1) * 32 + 8 * fq;
#pragma unroll
        for (int ai = 0; ai < 2; ++ai)
#pragma unroll
            for (int m = 0; m < 4; ++m) {
                int r = row0 + ai * HALF + m * 16;
                float rs = 1.f;
                if (SS) rs = __builtin_amdgcn_rsqf((float)SS[r] * (1.0f / (1048576.f * 2048.f)) + 1e-6f);
                const int t = r;
                if constexpr (MODE == 2) r = ((r & ((1 << shift) - 1)) << (14 - shift)) + (r >> shift);
                if (MODE == 2 && which < 2) {
                    const f32x4 c0 = *(const f32x4*)(cs + t * 64 + rdim), c1 = *(const f32x4*)(cs + t * 64 + rdim + 4), s0 = *(const f32x4*)(sn + t * 64 + rdim), s1 = *(const f32x4*)(sn + t * 64 + rdim + 4);
                    const f32x4 l0 = acc[ai][0][m][0] * rs, l1 = acc[ai][0][m][1] * rs, h0 = acc[ai][1][m][0] * rs, h1 = acc[ai][1][m][1] * rs;
                    const f32x4 ol0 = l0 * c0 - h0 * s0, ol1 = l1 * c1 - h1 * s1, oh0 = h0 * c0 + l0 * s0, oh1 = h1 * c1 + l1 * s1;
                    bf16_t* rowp = base + (size_t)r * ld + rcol;
                    u32x4 w; w.x = cvt_pk_bf16(ol0[0], ol0[1]); w.y = cvt_pk_bf16(ol0[2], ol0[3]); w.z = cvt_pk_bf16(ol1[0], ol1[1]); w.w = cvt_pk_bf16(ol1[2], ol1[3]);
                    *(u32x4*)rowp = w;
                    w.x = cvt_pk_bf16(oh0[0], oh0[1]); w.y = cvt_pk_bf16(oh0[2], oh0[3]); w.z = cvt_pk_bf16(oh1[0], oh1[1]); w.w = cvt_pk_bf16(oh1[2], oh1[3]);
                    *(u32x4*)(rowp + 64) = w;
                } else {
                bf16_t* rowp = base + (size_t)r * ld + col0;
#pragma unroll
                for (int bj = 0; bj < 2; ++bj) { f32x4 v0 = acc[ai][bj][m][0] * rs, v1 = acc[ai][bj][m][1] * rs;
                    if constexpr (MODE == 3) {
#pragma unroll
                        for (int e = 0; e < 4; ++e) { const float a = fmaxf(v0[e], 0.f), b = fmaxf(v1[e], 0.f); v0[e] = a * a; v1[e] = b * b; }
                    }
                    u32x4 w; w.x = cvt_pk_bf16(v0[0], v0[1]); w.y = cvt_pk_bf16(v0[2], v0[3]); w.z = cvt_pk_bf16(v1[0], v1[1]); w.w = cvt_pk_bf16(v1[2], v1[3]);
                    *(u32x4*)(rowp + bj * HALF) = w; }
                }
            }
    }
};
typedef _Float16 half2v __attribute__((ext_vector_type(2)));
__device__ __forceinline__ unsigned pk_half(float lo, float hi) { const half2v v = {(_Float16)lo, (_Float16)hi}; return __builtin_bit_cast(unsigned, v); }
struct EpiRes {
    static constexpr bool PERM = true, AFTER_DRAIN = false;
    bf16_t* XB; unsigned long long* SS; int ldc; int row_off;
    __device__ __forceinline__ void operator()(const f32x4 (&acc)[2][2][4][2], const Unit& u, int wr, int wc, int fr, int fq) const {
        const int row0 = row_off + u.pm * BM + wr * 64 + fr, col0 = u.pn * BM + wc * 32 + 8 * fq;
        const int lane = fq * 16 + fr;
#pragma unroll
        for (int ai = 0; ai < 2; ++ai)
#pragma unroll
            for (int m = 0; m < 4; ++m) { const int row = row0 + ai * HALF + m * 16; bf16_t* rowb = XB + (size_t)row * ldc + col0;
                u32x4 xo[2];
#pragma unroll
                for (int bj = 0; bj < 2; ++bj) xo[bj] = *(const u32x4*)(rowb + bj * HALF);
                float s = 0.f;
#pragma unroll
                for (int bj = 0; bj < 2; ++bj) { float v[8];
#pragma unroll
                    for (int e = 0; e < 4; ++e) { const unsigned wv = xo[bj][e]; const half2v h = __builtin_bit_cast(half2v, wv);
                        v[2 * e] = (float)h[0] + acc[ai][bj][m][e >> 1][(2 * e) & 3];
                        v[2 * e + 1] = (float)h[1] + acc[ai][bj][m][e >> 1][(2 * e + 1) & 3]; }
#pragma unroll
                    for (int e = 0; e < 8; ++e) s += v[e] * v[e];
                    u32x4 w; w.x = pk_half(v[0], v[1]); w.y = pk_half(v[2], v[3]); w.z = pk_half(v[4], v[5]); w.w = pk_half(v[6], v[7]);
                    *(u32x4*)(rowb + bj * HALF) = w; }
                s += __builtin_bit_cast(float, __builtin_amdgcn_ds_bpermute((lane ^ 16) << 2, __builtin_bit_cast(int, s)));
                s += __builtin_bit_cast(float, __builtin_amdgcn_ds_bpermute((lane ^ 32) << 2, __builtin_bit_cast(int, s)));
                if (fq == 0) __hip_atomic_fetch_add(SS + row, (unsigned long long)(s * 1048576.f + 0.5f), __ATOMIC_RELAXED, __HIP_MEMORY_SCOPE_AGENT); }
    }
};
struct GroupedOrder {
    int G, c;
    __host__ __device__ void init(int G_, int c_) { G = G_; c = c_; }
    __host__ __device__ bool next(int i, Unit& u) const {
        const int L = i * G + c; if (L >= 48) return false;
        const int layer = L / 12, rem = L % 12; u.pm = layer * 3 + rem % 3; u.pn = layer * 4 + rem / 3; return true;
    }
    __device__ __forceinline__ void a_ready(const Unit&) const {}
    __device__ __forceinline__ void done(const Unit&) const {}
};
struct RepOrder : StaticOrder {
    int reps;
    __host__ __device__ bool next(int i, Unit& u) const { const int rounds = nwg / G; if (i >= rounds * reps) return false; return StaticOrder::next(i % rounds, u); }
};
typedef _Float16 half8 __attribute__((ext_vector_type(8)));
template <class Epi, class Sched, bool ALIGN_EPI = false, bool SP2 = false, bool F16IN = false>
__device__ __forceinline__ void gemm_phase(PG8_LAS unsigned char* lds, const Gemm g, const Sched& S, const Epi& E, const int tid) {
    const int wid = __builtin_amdgcn_readfirstlane(tid >> 6), lane = tid & 63, wr = wid >> 2, wc = wid & 3, fr = lane & 15, fq = lane >> 4;
    const int K = g.K, nt = K / BK;
    unsigned voffA[2], voffB[2];
#pragma unroll
    for (int i = 0; i < 2; ++i) { int R, C; stage_rc(tid * 16 + i * 8192, R, C); const int Rb = Epi::PERM ? ((R & ~31) + perm32(R & 31)) : R;
        voffA[i] = (unsigned)(R * K + C) * 2u; voffB[i] = (unsigned)(Rb * K + C) * 2u; }
    const size_t kstep = (size_t)(BK * 2);
    const size_t hstep = (size_t)HALF * K * 2;
    const size_t tstep = 2 * hstep;
    const unsigned ldsw = (unsigned)wid * 1024u;
    const int aoff = lds_byte(wr * 64 + fr, fq * 8), boff = lds_byte(wc * 32 + fr, fq * 8);
#define PG8_SA(b, h) (((b) * 2 + (h)) * HTB)
#define PG8_SB(b, h) ((4 + (b) * 2 + (h)) * HTB)
#define PG8_STAGE(bufoff, gbase, voff) do { unsigned long long gi_ = (unsigned long long)(gbase); asm volatile("" : "+s"(gi_)); const __attribute__((address_space(1))) char* gb_ = (const __attribute__((address_space(1))) char*)gi_; _Pragma("unroll") for (int _i = 0; _i < 2; ++_i) \
        __builtin_amdgcn_global_load_lds((const __attribute__((address_space(1))) unsigned*)(gb_ + (voff)[_i]), (PG8_LAS unsigned*)(lds + (bufoff) + ldsw + _i * 8192), 16, 0, 0); } while (0)
#define PG8_LDA(dst, b, h) do { _Pragma("unroll") for (int m = 0; m < 4; ++m) _Pragma("unroll") for (int k = 0; k < 2; ++k) dst[m][k] = *(const PG8_LAS bf16x8*)(lds + PG8_SA(b, h) + aoff + m * 2048 + k * 1024); } while (0)
#define PG8_LDB(dst, b, h) do { _Pragma("unroll") for (int n = 0; n < 2; ++n) _Pragma("unroll") for (int k = 0; k < 2; ++k) dst[n][k] = *(const PG8_LAS bf16x8*)(lds + PG8_SB(b, h) + boff + n * 2048 + k * 1024); } while (0)
#define PG8_MMA(ai, bj, At, Bt) do { __builtin_amdgcn_s_setprio(1); _Pragma("unroll") for (int m = 0; m < 4; ++m) _Pragma("unroll") for (int n = 0; n < 2; ++n) _Pragma("unroll") for (int k = 0; k < 2; ++k) \
        { if constexpr (F16IN) acc[ai][bj][m][n] = __builtin_amdgcn_mfma_f32_16x16x32_f16(__builtin_bit_cast(half8, Bt[n][k]), __builtin_bit_cast(half8, At[m][k]), acc[ai][bj][m][n], 0, 0, 0); \
          else acc[ai][bj][m][n] = __builtin_amdgcn_mfma_f32_16x16x32_bf16(Bt[n][k], At[m][k], acc[ai][bj][m][n], 0, 0, 0); } __builtin_amdgcn_s_setprio(0); } while (0)
#define PG8_WAIT_V(n) asm volatile("s_waitcnt vmcnt(" #n ")" ::: "memory")
#define PG8_WAIT_L(n) asm volatile("s_waitcnt lgkmcnt(" #n ")" ::: "memory")
#define PG8_BAR __builtin_amdgcn_s_barrier()
#define PG8_SCHED __builtin_amdgcn_sched_barrier(0)
    Unit cur, nxt; int ui = 0;
    if (!S.next(0, cur)) return;
    f32x4 acc[2][2][4][2];
#pragma unroll
    for (int a = 0; a < 2; ++a)
#pragma unroll
        for (int b = 0; b < 2; ++b)
#pragma unroll
            for (int m = 0; m < 4; ++m)
#pragma unroll
                for (int n = 0; n < 2; ++n) acc[a][b][m][n] = (f32x4){0.f, 0.f, 0.f, 0.f};
    bf16x8 At[4][2], B0[2][2], B1[2][2];
    const char* cA = (const char*)g.A + (size_t)cur.pm * tstep; const char* cB = (const char*)g.Bt + (size_t)cur.pn * tstep;
    S.a_ready(cur);
    if constexpr (SP2) {
        PG8_STAGE(PG8_SB(0, 0), cB, voffB); PG8_STAGE(PG8_SB(0, 1), cB + hstep, voffB); PG8_STAGE(PG8_SA(0, 0), cA, voffA); PG8_STAGE(PG8_SA(0, 1), cA + hstep, voffA);
        if (wr == 1) PG8_BAR;
        PG8_WAIT_V(2); PG8_BAR;
        PG8_STAGE(PG8_SB(1, 0), cB + kstep, voffB); PG8_STAGE(PG8_SA(1, 0), cA + kstep, voffA); PG8_STAGE(PG8_SB(1, 1), cB + hstep + kstep, voffB);
        PG8_WAIT_V(6); PG8_BAR;
    } else {
        PG8_STAGE(PG8_SB(0, 0), cB, voffB); PG8_STAGE(PG8_SA(0, 0), cA, voffA); PG8_STAGE(PG8_SB(0, 1), cB + hstep, voffB); PG8_STAGE(PG8_SA(0, 1), cA + hstep, voffA);
        if (wr == 1) PG8_BAR;
        PG8_WAIT_V(4); PG8_BAR;
        PG8_STAGE(PG8_SB(1, 0), cB + kstep, voffB); PG8_STAGE(PG8_SA(1, 0), cA + kstep, voffA); PG8_STAGE(PG8_SB(1, 1), cB + hstep + kstep, voffB);
        PG8_WAIT_V(6); PG8_BAR;
    }
    for (;;) {
        const bool has_next = S.next(ui + 1, nxt);
        const char* nA = has_next ? (const char*)g.A + (size_t)nxt.pm * tstep : cA; const char* nB = has_next ? (const char*)g.Bt + (size_t)nxt.pn * tstep : cB;
        for (int t = 0; t < nt; t += 2) {
            asm volatile("" : "+v"(voffA[0]), "+v"(voffA[1]), "+v"(voffB[0]), "+v"(voffB[1]));
            const bool last = (t == nt - 2);
            const char* a1 = cA + (size_t)(t + 1) * kstep;
            const char* a2 = last ? nA : cA + (size_t)(t + 2) * kstep; const char* b2 = last ? nB : cB + (size_t)(t + 2) * kstep;
            const char* a3 = a2 + kstep; const char* b3 = b2 + kstep;
            if (last && has_next) S.a_ready(nxt);
            if constexpr (SP2) {
            PG8_LDB(B0, 0, 0); PG8_LDB(B1, 0, 1); PG8_SCHED; PG8_LDA(At, 0, 0); PG8_STAGE(PG8_SA(1, 1), a1 + hstep, voffA);
            PG8_WAIT_V(8); PG8_WAIT_L(0); PG8_BAR; PG8_MMA(0, 0, At, B0); PG8_MMA(0, 1, At, B1); PG8_BAR; PG8_SCHED;
            PG8_LDA(At, 0, 1); PG8_STAGE(PG8_SB(0, 0), b2, voffB); PG8_STAGE(PG8_SB(0, 1), b2 + hstep, voffB); PG8_STAGE(PG8_SA(0, 0), a2, voffA);
            PG8_WAIT_V(8); PG8_WAIT_L(0); PG8_BAR; PG8_MMA(1, 0, At, B0); PG8_MMA(1, 1, At, B1); PG8_BAR; PG8_SCHED;
            PG8_LDB(B0, 1, 0); PG8_LDB(B1, 1, 1); PG8_SCHED; PG8_LDA(At, 1, 0); PG8_STAGE(PG8_SA(0, 1), a2 + hstep, voffA);
            PG8_WAIT_V(8); PG8_WAIT_L(0); PG8_BAR; PG8_MMA(0, 0, At, B0); PG8_MMA(0, 1, At, B1); PG8_BAR; PG8_SCHED;
            PG8_LDA(At, 1, 1); PG8_STAGE(PG8_SB(1, 0), b3, voffB); PG8_STAGE(PG8_SB(1, 1), b3 + hstep, voffB); PG8_STAGE(PG8_SA(1, 0), a3, voffA);
            PG8_WAIT_V(8); PG8_WAIT_L(0); PG8_BAR; PG8_MMA(1, 0, At, B0); PG8_MMA(1, 1, At, B1); PG8_BAR; PG8_SCHED;
            } else {
            PG8_LDB(B0, 0, 0); PG8_SCHED; PG8_LDA(At, 0, 0); PG8_STAGE(PG8_SA(1, 1), a1 + hstep, voffA);
            PG8_WAIT_L(8); PG8_BAR; PG8_WAIT_L(0); PG8_MMA(0, 0, At, B0); PG8_BAR; PG8_SCHED;
            PG8_LDB(B1, 0, 1); PG8_STAGE(PG8_SB(0, 0), b2, voffB);
            PG8_BAR; PG8_WAIT_L(0); PG8_MMA(0, 1, At, B1); PG8_BAR;
            PG8_LDA(At, 0, 1); PG8_STAGE(PG8_SA(0, 0), a2, voffA);
            PG8_BAR; PG8_WAIT_L(0); PG8_MMA(1, 0, At, B0); PG8_BAR; PG8_SCHED;
            PG8_STAGE(PG8_SB(0, 1), b2 + hstep, voffB);
            PG8_WAIT_V(6); PG8_BAR; PG8_MMA(1, 1, At, B1); PG8_BAR;
            PG8_LDB(B0, 1, 0); PG8_SCHED; PG8_LDA(At, 1, 0); PG8_STAGE(PG8_SA(0, 1), a2 + hstep, voffA);
            PG8_WAIT_L(8); PG8_BAR; PG8_WAIT_L(0); PG8_MMA(0, 0, At, B0); PG8_BAR; PG8_SCHED;
            PG8_LDB(B1, 1, 1); PG8_STAGE(PG8_SB(1, 0), b3, voffB);
            PG8_BAR; PG8_WAIT_L(0); PG8_MMA(0, 1, At, B1); PG8_BAR;
            PG8_LDA(At, 1, 1); PG8_STAGE(PG8_SA(1, 0), a3, voffA);
            PG8_BAR; PG8_WAIT_L(0); PG8_MMA(1, 0, At, B0); PG8_BAR; PG8_SCHED;
            PG8_STAGE(PG8_SB(1, 1), b3 + hstep, voffB);
            PG8_WAIT_V(6); PG8_BAR; PG8_MMA(1, 1, At, B1); PG8_BAR;
            }
        }
        if constexpr (ALIGN_EPI) { if (wr == 0) PG8_BAR; }
        if constexpr (!Epi::AFTER_DRAIN) { E(acc, cur, wr, wc, fr, fq); S.done(cur); }
        if (!has_next) break;
#pragma unroll
        for (int a = 0; a < 2; ++a)
#pragma unroll
            for (int b = 0; b < 2; ++b)
#pragma unroll
                for (int m = 0; m < 4; ++m)
#pragma unroll
                    for (int n = 0; n < 2; ++n) acc[a][b][m][n] = (f32x4){0.f, 0.f, 0.f, 0.f};
        cur = nxt; cA = nA; cB = nB; ++ui;
        if constexpr (ALIGN_EPI) { if (wr == 1) PG8_BAR; }
    }
    PG8_WAIT_V(0);
    if constexpr (!ALIGN_EPI) { if (wr == 0) PG8_BAR; }
    PG8_BAR;
    if constexpr (Epi::AFTER_DRAIN) { E.fused(acc, cur, wr, wc, fr, fq, lds, wid, lane); S.done(cur); }
#undef PG8_SA
#undef PG8_SB
#undef PG8_STAGE
#undef PG8_LDA
#undef PG8_LDB
#undef PG8_MMA
#undef PG8_WAIT_V
#undef PG8_WAIT_L
#undef PG8_BAR
#undef PG8_SCHED
}
}

namespace da {
using bf16 = unsigned short;
constexpr int   D = 128, NW = 8, QBLK = 32, KVBLK = 64;
constexpr float SCALE = 0.088388347648318440f;
constexpr float THR = 8.f;
constexpr size_t SHM_V = KVBLK * D * 2, SHM_K = KVBLK * D * 2, SHM_ATTN = 2 * SHM_V + 2 * SHM_K + NW * 64 * 4;
using bf16x8 = __attribute__((ext_vector_type(8))) short;
using s16x4  = __attribute__((ext_vector_type(4))) short;
using f32x16 = __attribute__((ext_vector_type(16))) float;
using u32x4  = __attribute__((ext_vector_type(4))) unsigned;
using f32x4v = __attribute__((ext_vector_type(4))) float;
#define KSWZ(row, colB) ((row) * 256 + ((colB) ^ (((row) & 7) << 4)))
#define SBAR() __builtin_amdgcn_sched_barrier(0)
__device__ __forceinline__ int crow(int r, int hi) { return (r & 3) + 8 * (r >> 2) + 4 * hi; }
__device__ __forceinline__ unsigned cvtpk(float lo, float hi) {
  unsigned r; asm volatile("v_cvt_pk_bf16_f32 %0, %1, %2" : "=v"(r) : "v"(lo), "v"(hi)); return r;
}
__device__ __forceinline__ bf16x8 ld8(const bf16* p) { return *reinterpret_cast<const bf16x8*>(p); }

__device__ __forceinline__ void partialSM(f32x16& p0, f32x16& p1, float& m_reg, float& mn, float& alpha) {
  constexpr float C = SCALE * 1.4426950408889634f;
  float pmax = p0[0]; for (int r = 1; r < 16; ++r) pmax = fmaxf(pmax, p0[r]); for (int r = 0; r < 16; ++r) pmax = fmaxf(pmax, p1[r]);
  { auto rr = __builtin_amdgcn_permlane32_swap(__float_as_uint(pmax), __float_as_uint(pmax), false, false);
    pmax = fmaxf(__uint_as_float(rr[0]), __uint_as_float(rr[1])); }
  if (__builtin_expect(__all(pmax - m_reg <= THR / SCALE), 1)) { mn = m_reg; alpha = 1.f; }
  else { mn = fmaxf(m_reg, pmax); alpha = __builtin_amdgcn_exp2f((m_reg - mn) * C); m_reg = mn; }
  float mnC = -mn * C;
  for (int r = 0; r < 16; ++r) p0[r] = fmaf(p0[r], C, mnC); for (int r = 0; r < 16; ++r) p1[r] = fmaf(p1[r], C, mnC);
  for (int r = 0; r < 16; ++r) p0[r] = __builtin_amdgcn_exp2f(p0[r]);
}
#define PK4(P, BASE, OUT) do { unsigned a0 = cvtpk(P[BASE + 0], P[BASE + 1]), a1 = cvtpk(P[BASE + 2], P[BASE + 3]);   \
    unsigned b0 = cvtpk(P[BASE + 4], P[BASE + 5]), b1 = cvtpk(P[BASE + 6], P[BASE + 7]);                              \
    auto r0 = __builtin_amdgcn_permlane32_swap(a0, b0, false, false); auto r1 = __builtin_amdgcn_permlane32_swap(a1, b1, false, false); \
    u32x4 w = {r0[0], r1[0], r0[1], r1[1]}; OUT = *reinterpret_cast<bf16x8*>(&w); } while (0)
__device__ __forceinline__ void finishSM(f32x16& p0, f32x16& p1, float alpha, float& l_reg, bf16x8& pa0, bf16x8& pa1, bf16x8& pa2, bf16x8& pa3) {
  for (int r = 0; r < 16; ++r) p1[r] = __builtin_amdgcn_exp2f(p1[r]);
  float ps = 0; for (int r = 0; r < 16; ++r) ps += p0[r]; for (int r = 0; r < 16; ++r) ps += p1[r];
  { auto rr = __builtin_amdgcn_permlane32_swap(__float_as_uint(ps), __float_as_uint(ps), false, false);
    ps = __uint_as_float(rr[0]) + __uint_as_float(rr[1]); }
  l_reg = l_reg * alpha + ps;
  PK4(p0, 0, pa0); PK4(p0, 8, pa1); PK4(p1, 0, pa2); PK4(p1, 8, pa3);
}
__device__ __forceinline__ void qkt(f32x16& p0, f32x16& p1, const bf16* Ks, const bf16x8* qr, int r32, int hi) {
  p0 = f32x16{}; p1 = f32x16{};
  for (int d0 = 0; d0 < 8; ++d0) { int cb = (d0 * 16 + hi * 8) * 2;
    bf16x8 b0 = *reinterpret_cast<const bf16x8*>((const char*)Ks + KSWZ(r32, cb));
    bf16x8 b1 = *reinterpret_cast<const bf16x8*>((const char*)Ks + KSWZ(32 + r32, cb));
    p0 = __builtin_amdgcn_mfma_f32_32x32x16_bf16(b0, qr[d0], p0, 0, 0, 0);
    p1 = __builtin_amdgcn_mfma_f32_32x32x16_bf16(b1, qr[d0], p1, 0, 0, 0); }
}
constexpr float CQ = SCALE * 1.4426950408889634f, THR2 = THR * 1.4426950408889634f;
__device__ __forceinline__ void qkt_n(f32x16& p0, f32x16& p1, const bf16* Ks, const bf16x8* qr, const f32x16& negm, int r32, int hi) {
  { const int cb = (hi * 8) * 2;
    bf16x8 b0 = *reinterpret_cast<const bf16x8*>((const char*)Ks + KSWZ(r32, cb));
    bf16x8 b1 = *reinterpret_cast<const bf16x8*>((const char*)Ks + KSWZ(32 + r32, cb));
    p0 = __builtin_amdgcn_mfma_f32_32x32x16_bf16(b0, qr[0], negm, 0, 0, 0);
    p1 = __builtin_amdgcn_mfma_f32_32x32x16_bf16(b1, qr[0], negm, 0, 0, 0); }
  for (int d0 = 1; d0 < 8; ++d0) { int cb = (d0 * 16 + hi * 8) * 2;
    bf16x8 b0 = *reinterpret_cast<const bf16x8*>((const char*)Ks + KSWZ(r32, cb));
    bf16x8 b1 = *reinterpret_cast<const bf16x8*>((const char*)Ks + KSWZ(32 + r32, cb));
    p0 = __builtin_amdgcn_mfma_f32_32x32x16_bf16(b0, qr[d0], p0, 0, 0, 0);
    p1 = __builtin_amdgcn_mfma_f32_32x32x16_bf16(b1, qr[d0], p1, 0, 0, 0); }
}
__device__ __forceinline__ void partialSM_b(f32x16& p0, float& alpha) { alpha = 1.f; for (int r = 0; r < 16; ++r) p0[r] = __builtin_amdgcn_exp2f(p0[r]); }
template <bool FIRST>
__device__ __forceinline__ void partialSM_n(f32x16& p0, f32x16& p1, float& mhat, f32x16& negm, float& alpha) {
  float pmax = p0[0]; for (int r = 1; r < 16; ++r) pmax = fmaxf(pmax, p0[r]); for (int r = 0; r < 16; ++r) pmax = fmaxf(pmax, p1[r]);
  { auto rr = __builtin_amdgcn_permlane32_swap(__float_as_uint(pmax), __float_as_uint(pmax), false, false);
    pmax = fmaxf(__uint_as_float(rr[0]), __uint_as_float(rr[1])); }
  alpha = 1.f;
  if (FIRST || !__builtin_expect(__all(pmax <= THR2), 1)) {
    const float dl = FIRST ? pmax : fmaxf(pmax, 0.f); mhat += dl;
    for (int r = 0; r < 16; ++r) { p0[r] -= dl; p1[r] -= dl; }
    for (int r = 0; r < 16; ++r) negm[r] = -mhat;
    asm volatile("" : "+v"(negm));
    if (!FIRST) alpha = __builtin_amdgcn_exp2f(-dl);
  }
  for (int r = 0; r < 16; ++r) p0[r] = __builtin_amdgcn_exp2f(p0[r]);
}
__device__ __forceinline__ void decide_n(f32x16& p0, f32x16& p1, float& mhat, f32x16& negm, float& alpha) {
  float pmax = p0[0]; for (int r = 1; r < 16; ++r) pmax = fmaxf(pmax, p0[r]); for (int r = 0; r < 16; ++r) pmax = fmaxf(pmax, p1[r]);
  { auto rr = __builtin_amdgcn_permlane32_swap(__float_as_uint(pmax), __float_as_uint(pmax), false, false);
    pmax = fmaxf(__uint_as_float(rr[0]), __uint_as_float(rr[1])); }
  alpha = 1.f;
  if (!__builtin_expect(__all(pmax <= THR2), 1)) {
    const float dl = fmaxf(pmax, 0.f); mhat += dl;
    for (int r = 0; r < 16; ++r) { p0[r] -= dl; p1[r] -= dl; }
    for (int r = 0; r < 16; ++r) negm[r] = -mhat;
    asm volatile("" : "+v"(negm));
    alpha = __builtin_amdgcn_exp2f(-dl);
  }
}
typedef __attribute__((address_space(3))) const char* lds_cp;
typedef short v4i16_t __attribute__((ext_vector_type(4)));
__device__ __forceinline__ s16x4 vtr(lds_cp p) { return __builtin_bit_cast(s16x4, __builtin_amdgcn_ds_read_tr16_b64_v4i16((__attribute__((address_space(3))) v4i16_t*)p)); }
__device__ __forceinline__ int v_st(int k, int c) { const int kk = (k & ~0xC) | ((k & 4) << 1) | ((k & 8) >> 1); return ((kk >> 3) * 4 + (c >> 5)) * 512 + ((kk & 7) * 32 + (c & 31)) * 2; }
__device__ __forceinline__ int v_rd_base(int lane) { return ((lane & 3) << 3) | (((lane >> 2) & 3) << 6) | (((lane >> 4) & 1) << 5) | (((lane >> 5) & 1) << 8); }
constexpr int v_rd_off(int d0, int ks, int half) { return d0 * 512 + ks * 4096 + half * 2048; }
template <int OFF> __device__ __forceinline__ s16x4 tr_read(int vb) {
  s16x4 r; asm volatile("ds_read_b64_tr_b16 %0, %1 offset:%2" : "=&v"(r) : "v"(vb), "i"(OFF) : "memory"); return r;
}
template <int D0> __device__ __forceinline__ void pv_one(f32x16& od, int vb, bf16x8 pa0, bf16x8 pa1, bf16x8 pa2, bf16x8 pa3) {
  const s16x4 l0 = tr_read<v_rd_off(D0, 0, 0)>(vb), h0 = tr_read<v_rd_off(D0, 0, 1)>(vb), l1 = tr_read<v_rd_off(D0, 1, 0)>(vb), h1 = tr_read<v_rd_off(D0, 1, 1)>(vb);
  const s16x4 l2 = tr_read<v_rd_off(D0, 2, 0)>(vb), h2 = tr_read<v_rd_off(D0, 2, 1)>(vb), l3 = tr_read<v_rd_off(D0, 3, 0)>(vb), h3 = tr_read<v_rd_off(D0, 3, 1)>(vb);
  asm volatile("s_waitcnt lgkmcnt(0)" ::: "memory"); SBAR();
#define PK(L, H) (bf16x8){L[0], L[1], L[2], L[3], H[0], H[1], H[2], H[3]}
  od = __builtin_amdgcn_mfma_f32_32x32x16_bf16(pa0, PK(l0, h0), od, 0, 0, 0);
  od = __builtin_amdgcn_mfma_f32_32x32x16_bf16(pa1, PK(l1, h1), od, 0, 0, 0);
  od = __builtin_amdgcn_mfma_f32_32x32x16_bf16(pa2, PK(l2, h2), od, 0, 0, 0);
  od = __builtin_amdgcn_mfma_f32_32x32x16_bf16(pa3, PK(l3, h3), od, 0, 0, 0);
#undef PK
}
__device__ __forceinline__ void pv_d0(f32x16* o, int vb, bf16x8 pa0, bf16x8 pa1, bf16x8 pa2, bf16x8 pa3) {
  pv_one<0>(o[0], vb, pa0, pa1, pa2, pa3); pv_one<1>(o[1], vb, pa0, pa1, pa2, pa3); pv_one<2>(o[2], vb, pa0, pa1, pa2, pa3); pv_one<3>(o[3], vb, pa0, pa1, pa2, pa3);
}

__device__ __forceinline__ bf16x8 pack8(const f32x16& p, int base) {
  u32x4 w = {cvtpk(p[base + 0], p[base + 1]), cvtpk(p[base + 2], p[base + 3]), cvtpk(p[base + 4], p[base + 5]), cvtpk(p[base + 6], p[base + 7])}; return *reinterpret_cast<bf16x8*>(&w); }
__device__ __forceinline__ void finishSM_ot(f32x16& p0, f32x16& p1, float alpha, float& l_reg, bf16x8& pa0, bf16x8& pa1, bf16x8& pa2, bf16x8& pa3) {
  for (int r = 0; r < 16; ++r) p1[r] = __builtin_amdgcn_exp2f(p1[r]);
  float ps = 0; for (int r = 0; r < 16; ++r) ps += p0[r]; for (int r = 0; r < 16; ++r) ps += p1[r];
  { auto rr = __builtin_amdgcn_permlane32_swap(__float_as_uint(ps), __float_as_uint(ps), false, false);
    ps = __uint_as_float(rr[0]) + __uint_as_float(rr[1]); }
  l_reg = l_reg * alpha + ps;
  pa0 = pack8(p0, 0); pa1 = pack8(p0, 8); pa2 = pack8(p1, 0); pa3 = pack8(p1, 8);
}
template <int D0> __device__ __forceinline__ void pv_one_ot(f32x16& od, int vb, bf16x8 pa0, bf16x8 pa1, bf16x8 pa2, bf16x8 pa3) {
  const s16x4 l0 = tr_read<v_rd_off(D0, 0, 0)>(vb), h0 = tr_read<v_rd_off(D0, 0, 1)>(vb), l1 = tr_read<v_rd_off(D0, 1, 0)>(vb), h1 = tr_read<v_rd_off(D0, 1, 1)>(vb);
  const s16x4 l2 = tr_read<v_rd_off(D0, 2, 0)>(vb), h2 = tr_read<v_rd_off(D0, 2, 1)>(vb), l3 = tr_read<v_rd_off(D0, 3, 0)>(vb), h3 = tr_read<v_rd_off(D0, 3, 1)>(vb);
  asm volatile("s_waitcnt lgkmcnt(0)" ::: "memory"); SBAR();
#define PK(L, H) (bf16x8){L[0], L[1], L[2], L[3], H[0], H[1], H[2], H[3]}
  od = __builtin_amdgcn_mfma_f32_32x32x16_bf16(PK(l0, h0), pa0, od, 0, 0, 0);
  od = __builtin_amdgcn_mfma_f32_32x32x16_bf16(PK(l1, h1), pa1, od, 0, 0, 0);
  od = __builtin_amdgcn_mfma_f32_32x32x16_bf16(PK(l2, h2), pa2, od, 0, 0, 0);
  od = __builtin_amdgcn_mfma_f32_32x32x16_bf16(PK(l3, h3), pa3, od, 0, 0, 0);
#undef PK
}
__device__ __forceinline__ void pv_ot(f32x16* o, int vb, bf16x8 pa0, bf16x8 pa1, bf16x8 pa2, bf16x8 pa3) {
  pv_one_ot<0>(o[0], vb, pa0, pa1, pa2, pa3); pv_one_ot<1>(o[1], vb, pa0, pa1, pa2, pa3); pv_one_ot<2>(o[2], vb, pa0, pa1, pa2, pa3); pv_one_ot<3>(o[3], vb, pa0, pa1, pa2, pa3);
}
constexpr int ASLOT = 16384, RING_ATTN = 6 * ASLOT + NW * 64 * 4;
#define AWAIT_BAR(N) asm volatile("s_waitcnt vmcnt(" #N ") lgkmcnt(0)\n\ts_barrier" ::: "memory")
template <int LDQ, int LDK, int LDO, bool QN, bool BND = false, bool HS = false>
__device__ __forceinline__ void attn_dense_body(const bf16* Qb, const bf16* __restrict__ Kh, const bf16* __restrict__ Vh, bf16* Ob, int seq, char* lds,
                                                __attribute__((address_space(3))) unsigned char* ldsl, const int wave_s, const float* qg = nullptr, const float* axt = nullptr, int tok0 = 0, float bnd = 0.f) {
  constexpr bool OT = HS;
  int lane; asm volatile("v_mbcnt_lo_u32_b32 %0, -1, 0\n\tv_mbcnt_hi_u32_b32 %0, -1, %0" : "=v"(lane));
  const int wid = wave_s, r32 = lane & 31, hi = lane >> 5;
  char* K_lds = lds; char* V_lds = lds + 3 * ASLOT;
  float* ws = (float*)(lds + 6 * ASLOT) + wid * 64; float* li_l = ws; float* al_l = ws + 32;
  float mhat = 0.f, l_reg = 0; f32x16 o[4] = {}; bf16x8 qr[8]; f32x16 negm;
  unsigned ksrc[2], vsrc[2];
#pragma unroll
  for (int i = 0; i < 2; ++i) { const int p = 2 * wid + i;
    const int krow = 4 * p + (lane >> 4), kch = (lane & 15) ^ (krow & 7); ksrc[i] = (unsigned)(krow * LDK + kch * 8) * 2u;
    const int sub = 2 * p + (lane >> 5), kk = ((sub >> 2) << 3) | ((lane & 31) >> 2), key = OT ? kk : ((kk & ~0xC) | ((kk & 4) << 1) | ((kk & 8) >> 1)), vc = ((sub & 3) << 5) | ((lane & 3) << 3);
    vsrc[i] = (unsigned)(key * LDK + vc) * 2u; }
#define DMA_K1(t, sl, i_) __builtin_amdgcn_global_load_lds((const unsigned*)((const char*)Kh + (ksrc[i_] + (unsigned)(t) * (unsigned)(KVBLK * LDK * 2))), (__attribute__((address_space(3))) unsigned*)(ldsl + (sl) + (2 * wid + (i_)) * 1024), 16, 0, 0)
#define DMA_V1(t, sl, i_) __builtin_amdgcn_global_load_lds((const unsigned*)((const char*)Vh + (vsrc[i_] + (unsigned)(t) * (unsigned)(KVBLK * LDK * 2))), (__attribute__((address_space(3))) unsigned*)(ldsl + 3 * ASLOT + (sl) + (2 * wid + (i_)) * 1024), 16, 0, 0)
#define DMA_K(t, sl) do { DMA_K1(t, sl, 0); DMA_K1(t, sl, 1); } while (0)
#define DMA_V(t, sl) do { DMA_V1(t, sl, 0); DMA_V1(t, sl, 1); } while (0)
  const int NT = seq / KVBLK;
  DMA_K(0, 0); DMA_V(0, 0); DMA_K(1, ASLOT);
  const bf16* Qw = Qb + (long)(wid * QBLK + r32) * LDQ + hi * 8;
#pragma unroll
  for (int d0 = 0; d0 < 8; ++d0) qr[d0] = ld8(Qw + d0 * 16);
  if constexpr (QN) {
    const int t = tok0 + wid * QBLK + r32, prow = t >> 6, pcol = t & 63;
    float x[8][8]; float ss = 0.f;
#pragma unroll
    for (int d0 = 0; d0 < 8; ++d0)
#pragma unroll
      for (int e = 0; e < 8; ++e) { x[d0][e] = __builtin_bit_cast(float, (unsigned)(unsigned short)qr[d0][e] << 16); ss += x[d0][e] * x[d0][e]; }
    { auto rr = __builtin_amdgcn_permlane32_swap(__float_as_uint(ss), __float_as_uint(ss), false, false); ss = __uint_as_float(rr[0]) + __uint_as_float(rr[1]); }
    const float rstd = CQ / sqrtf(ss * (1.f / 128.f) + 1e-6f);
#pragma unroll
    for (int d0 = 0; d0 < 8; ++d0) { const float* gp = qg + d0 * 16 + hi * 8; const f32x4v g0 = *(const f32x4v*)gp, g1 = *(const f32x4v*)(gp + 4);
#pragma unroll
      for (int e = 0; e < 8; ++e) x[d0][e] *= rstd * (e < 4 ? g0[e] : g1[e - 4]); }
#pragma unroll
    for (int half = 0; half < 2; ++half) { const float* ct = half == 0 ? axt + prow * 32 : axt + 16384 + pcol * 32; const float* st = ct + (half == 0 ? 8192 : 2048);
#pragma unroll
      for (int dd = 0; dd < 2; ++dd) { const int ix = dd * 16 + hi * 8;
        const f32x4v c0 = *(const f32x4v*)(ct + ix), c1 = *(const f32x4v*)(ct + ix + 4), s0 = *(const f32x4v*)(st + ix), s1 = *(const f32x4v*)(st + ix + 4);
#pragma unroll
        for (int e = 0; e < 8; ++e) { const float c = e < 4 ? c0[e] : c1[e - 4], sn = e < 4 ? s0[e] : s1[e - 4];
          const float a = x[half * 4 + dd][e], b = x[half * 4 + 2 + dd][e]; x[half * 4 + dd][e] = a * c - b * sn; x[half * 4 + 2 + dd][e] = b * c + a * sn; } } }
#pragma unroll
    for (int d0 = 0; d0 < 8; ++d0) { u32x4 w = {cvtpk(x[d0][0], x[d0][1]), cvtpk(x[d0][2], x[d0][3]), cvtpk(x[d0][4], x[d0][5]), cvtpk(x[d0][6], x[d0][7])}; qr[d0] = *reinterpret_cast<bf16x8*>(&w); }
  }
  if constexpr (!QN) {
#pragma unroll
    for (int d0 = 0; d0 < 8; ++d0) { float x[8];
#pragma unroll
      for (int e = 0; e < 8; ++e) x[e] = __builtin_bit_cast(float, (unsigned)(unsigned short)qr[d0][e] << 16) * CQ;
      u32x4 w = {cvtpk(x[0], x[1]), cvtpk(x[2], x[3]), cvtpk(x[4], x[5]), cvtpk(x[6], x[7])}; qr[d0] = *reinterpret_cast<bf16x8*>(&w); }
  }
  const bool onl = !BND || !(bnd <= 60.f);
  { float nb = (BND && !onl) ? -bnd : 0.f; asm volatile("" : "+v"(nb));
    for (int r = 0; r < 16; ++r) negm[r] = nb; asm volatile("" : "+v"(negm)); }
  const int vb0 = (int)(uintptr_t)V_lds + v_rd_base(lane);
#define RESC(a) do { if ((!BND || onl) && __any((a) < 1.f)) { if constexpr (OT) { for (int d = 0; d < 4; ++d) for (int r = 0; r < 16; ++r) o[d][r] *= (a); } else { \
    if (hi == 0) al_l[r32] = (a); asm volatile("s_waitcnt lgkmcnt(0)" ::: "memory"); \
    for (int d = 0; d < 4; ++d) for (int r = 0; r < 16; ++r) o[d][r] *= al_l[crow(r, hi)]; } } } while (0)
  f32x16 pA0, pA1, pB0, pB1; float alA, alB; bf16x8 pa0, pa1, pa2, pa3;
  int s0 = 2 * ASLOT, s1 = 0, s2 = ASLOT;
#define ROT() do { const int t_ = s0; s0 = s1; s1 = s2; s2 = t_; } while (0)
  AWAIT_BAR(0);
  if (wid >= 4) __builtin_amdgcn_s_setprio(1);
  DMA_K(2, s0); DMA_V(1, s2);
  qkt_n(pA0, pA1, (const bf16*)(K_lds + s1), qr, negm, r32, hi); if (BND && !onl) partialSM_b(pA0, alA); else partialSM_n<true>(pA0, pA1, mhat, negm, alA);
  AWAIT_BAR(4); ROT();
  if constexpr (HS) {
    const lds_cp kb_l = (lds_cp)ldsl + r32 * 256, vb_l = (lds_cp)ldsl + 3 * ASLOT + v_rd_base(lane);
    const int ksw = (r32 & 7) << 4, khi = hi * 16;
    bf16x8 kf[3][2]; s16x4 vl[4], vh[4];
#define H_KRD(kp, i) do { const unsigned a_ = (unsigned)(uintptr_t)(kp) + (unsigned)((((i) * 32 + khi) ^ ksw)); \
      asm volatile("ds_read_b128 %0, %2\n\tds_read_b128 %1, %2 offset:8192" : "=&v"(kf[(i) % 3][0]), "=&v"(kf[(i) % 3][1]) : "v"(a_) : "memory"); } while (0)
#define H_KWAIT(N, i) asm volatile("s_waitcnt lgkmcnt(" #N ")" : "+v"(kf[(i) % 3][0]), "+v"(kf[(i) % 3][1]) :: "memory")
#define H_VRD(vp, j) do { const unsigned a_ = (unsigned)(uintptr_t)(vp); \
      asm volatile("ds_read_b64_tr_b16 %0, %2 offset:%3\n\tds_read_b64_tr_b16 %1, %2 offset:%4" : "=&v"(vl[(j) & 3]), "=&v"(vh[(j) & 3]) : "v"(a_), "i"(v_rd_off((j) >> 2, (j) & 3, 0)), "i"(v_rd_off((j) >> 2, (j) & 3, 1)) : "memory"); } while (0)
#define H_VWAIT(N, j) asm volatile("s_waitcnt lgkmcnt(" #N ")" : "+v"(vl[(j) & 3]), "+v"(vh[(j) & 3]) :: "memory")
#define H_PIN(x) asm volatile("" : "+v"(x))
#define H_VF(j) (bf16x8){vl[(j) & 3][0], vl[(j) & 3][1], vl[(j) & 3][2], vl[(j) & 3][3], vh[(j) & 3][0], vh[(j) & 3][1], vh[(j) & 3][2], vh[(j) & 3][3]}
#define H_PA(j) (((j) & 3) == 0 ? pa0 : ((j) & 3) == 1 ? pa1 : ((j) & 3) == 2 ? pa2 : pa3)
#define H_GA(i, C0, C1, P0, P1, kp) do { \
      if (((i) & 1) == 0 && ((i) >> 1) + 2 < 8) H_KRD(kp, ((i) >> 1) + 2); \
      if (((i) & 1) == 0) { if ((i) < 12) H_KWAIT(4, (i) >> 1); else if ((i) == 12) H_KWAIT(2, 6); else H_KWAIT(0, 7); } \
      if ((i) == 8) DMA_K1(tkk, s0, 0); else if ((i) == 10) DMA_K1(tkk, s0, 1); else if ((i) == 12) DMA_V1(tvv, s2, 0); else if ((i) == 14) DMA_V1(tvv, s2, 1); \
      if (((i) & 1) == 0) C0 = __builtin_amdgcn_mfma_f32_32x32x16_bf16(kf[((i) >> 1) % 3][0], qr[(i) >> 1], (i) < 2 ? negm : C0, 0, 0, 0); \
      else C1 = __builtin_amdgcn_mfma_f32_32x32x16_bf16(kf[((i) >> 1) % 3][1], qr[(i) >> 1], (i) < 2 ? negm : C1, 0, 0, 0); \
      if ((i) < 8) { P1[2 * (i)] = __builtin_amdgcn_exp2f(P1[2 * (i)]); P1[2 * (i) + 1] = __builtin_amdgcn_exp2f(P1[2 * (i) + 1]); sacc += P0[2 * (i)]; sacc += P0[2 * (i) + 1]; H_PIN(P1); H_PIN(sacc); } \
      else { sacc += P1[2 * ((i) - 8)]; sacc += P1[2 * ((i) - 8) + 1]; H_PIN(sacc); \
        if (((i) & 1) == 0) { if ((i) < 12) { ca0 = cvtpk(P0[((i) - 8) * 4 + 0], P0[((i) - 8) * 4 + 1]); ca1 = cvtpk(P0[((i) - 8) * 4 + 2], P0[((i) - 8) * 4 + 3]); } \
                              else { ca0 = cvtpk(P1[((i) - 12) * 4 + 0], P1[((i) - 12) * 4 + 1]); ca1 = cvtpk(P1[((i) - 12) * 4 + 2], P1[((i) - 12) * 4 + 3]); } H_PIN(ca0); H_PIN(ca1); } \
        else { unsigned cb0, cb1; if ((i) < 12) { cb0 = cvtpk(P0[((i) - 9) * 4 + 4], P0[((i) - 9) * 4 + 5]); cb1 = cvtpk(P0[((i) - 9) * 4 + 6], P0[((i) - 9) * 4 + 7]); } \
                              else { cb0 = cvtpk(P1[((i) - 13) * 4 + 4], P1[((i) - 13) * 4 + 5]); cb1 = cvtpk(P1[((i) - 13) * 4 + 6], P1[((i) - 13) * 4 + 7]); } \
          u32x4 w_ = {ca0, ca1, cb0, cb1};     \
          if ((i) == 9) { pa0 = *reinterpret_cast<bf16x8*>(&w_); H_PIN(pa0); } else if ((i) == 11) { pa1 = *reinterpret_cast<bf16x8*>(&w_); H_PIN(pa1); } \
          else if ((i) == 13) { pa2 = *reinterpret_cast<bf16x8*>(&w_); H_PIN(pa2); } else { pa3 = *reinterpret_cast<bf16x8*>(&w_); H_PIN(pa3); } } } \
      SBAR(); } while (0)
#define H_GB(j, C0, vp) do { if ((j) + 3 < 16) H_VRD(vp, (j) + 3); \
      if ((j) < 13) H_VWAIT(6, j); else if ((j) == 13) H_VWAIT(4, 13); else if ((j) == 14) H_VWAIT(2, 14); else H_VWAIT(0, 15); \
      o[(j) >> 2] = __builtin_amdgcn_mfma_f32_32x32x16_bf16(H_VF(j), H_PA(j), o[(j) >> 2], 0, 0, 0);     \
      C0[j] = __builtin_amdgcn_exp2f(C0[j]); H_PIN(C0); SBAR(); } while (0)
#define H_STEP(C0, C1, P0, P1, alP, alC, tk_, tv_) do { \
      const lds_cp kp_ = kb_l + s1, vp_ = vb_l + s0; float sacc = 0.f; unsigned ca0 = 0, ca1 = 0; const int tkk = (tk_), tvv = (tv_); \
      SBAR(); H_KRD(kp_, 0); H_KRD(kp_, 1); SBAR(); \
      H_GA(0, C0, C1, P0, P1, kp_); H_GA(1, C0, C1, P0, P1, kp_); H_GA(2, C0, C1, P0, P1, kp_); H_GA(3, C0, C1, P0, P1, kp_); \
      H_GA(4, C0, C1, P0, P1, kp_); H_GA(5, C0, C1, P0, P1, kp_); H_GA(6, C0, C1, P0, P1, kp_); H_GA(7, C0, C1, P0, P1, kp_); \
      H_GA(8, C0, C1, P0, P1, kp_); H_GA(9, C0, C1, P0, P1, kp_); H_GA(10, C0, C1, P0, P1, kp_); H_GA(11, C0, C1, P0, P1, kp_); \
      H_GA(12, C0, C1, P0, P1, kp_); H_GA(13, C0, C1, P0, P1, kp_); H_GA(14, C0, C1, P0, P1, kp_); H_GA(15, C0, C1, P0, P1, kp_); \
      { auto rr_ = __builtin_amdgcn_permlane32_swap(__float_as_uint(sacc), __float_as_uint(sacc), false, false); l_reg = l_reg * (alP) + (__uint_as_float(rr_[0]) + __uint_as_float(rr_[1])); } \
      if (onl) decide_n(C0, C1, mhat, negm, alC); else alC = 1.f; \
      H_VRD(vp_, 0); H_VRD(vp_, 1); H_VRD(vp_, 2); SBAR(); \
      H_GB(0, C0, vp_); H_GB(1, C0, vp_); H_GB(2, C0, vp_); H_GB(3, C0, vp_); H_GB(4, C0, vp_); H_GB(5, C0, vp_); H_GB(6, C0, vp_); H_GB(7, C0, vp_); \
      H_GB(8, C0, vp_); H_GB(9, C0, vp_); H_GB(10, C0, vp_); H_GB(11, C0, vp_); H_GB(12, C0, vp_); H_GB(13, C0, vp_); H_GB(14, C0, vp_); H_GB(15, C0, vp_); \
    } while (0)
    for (int j = 1; j + 1 < NT; j += 2) {
      { const int tk = j + 2 < NT ? j + 2 : NT - 1, tv = j + 1;
      H_STEP(pB0, pB1, pA0, pA1, alA, alB, tk, tv); }
      RESC(alB); AWAIT_BAR(4); ROT();
      { const int tk = j + 3 < NT ? j + 3 : NT - 1, tv = j + 2 < NT ? j + 2 : NT - 1;
      H_STEP(pA0, pA1, pB0, pB1, alB, alA, tk, tv); }
      RESC(alA); AWAIT_BAR(4); ROT();
    }
#undef H_KRD
#undef H_VRD
#undef H_KWAIT
#undef H_VWAIT
#undef H_PIN
#undef H_VF
#undef H_PA
#undef H_GA
#undef H_GB
#undef H_STEP
  } else {
  for (int j = 1; j + 1 < NT; j += 2) {
    { const int tk = j + 2 < NT ? j + 2 : NT - 1, tv = j + 1; DMA_K(tk, s0); DMA_V(tv, s2); }
    SBAR(); qkt_n(pB0, pB1, (const bf16*)(K_lds + s1), qr, negm, r32, hi);
    finishSM(pA0, pA1, alA, l_reg, pa0, pa1, pa2, pa3); SBAR();
    pv_d0(o, vb0 + s0, pa0, pa1, pa2, pa3); if (BND && !onl) partialSM_b(pB0, alB); else partialSM_n<false>(pB0, pB1, mhat, negm, alB);
    RESC(alB); AWAIT_BAR(4); ROT();
    { const int tk = j + 3 < NT ? j + 3 : NT - 1, tv = j + 2 < NT ? j + 2 : NT - 1; DMA_K(tk, s0); DMA_V(tv, s2); }
    SBAR(); qkt_n(pA0, pA1, (const bf16*)(K_lds + s1), qr, negm, r32, hi);
    finishSM(pB0, pB1, alB, l_reg, pa0, pa1, pa2, pa3); SBAR();
    pv_d0(o, vb0 + s0, pa0, pa1, pa2, pa3); if (BND && !onl) partialSM_b(pA0, alA); else partialSM_n<false>(pA0, pA1, mhat, negm, alA);
    RESC(alA); AWAIT_BAR(4); ROT();
  }
  }
  { DMA_K(NT - 1, s0); DMA_V(NT - 1, s2); }
  SBAR(); qkt_n(pB0, pB1, (const bf16*)(K_lds + s1), qr, negm, r32, hi);
  if constexpr (OT) finishSM_ot(pA0, pA1, alA, l_reg, pa0, pa1, pa2, pa3); else finishSM(pA0, pA1, alA, l_reg, pa0, pa1, pa2, pa3);
  SBAR();
  if constexpr (OT) pv_ot(o, vb0 + s0, pa0, pa1, pa2, pa3); else pv_d0(o, vb0 + s0, pa0, pa1, pa2, pa3);
  if (BND && !onl) partialSM_b(pB0, alB); else partialSM_n<false>(pB0, pB1, mhat, negm, alB);
  RESC(alB); AWAIT_BAR(4); ROT();
  if constexpr (OT) finishSM_ot(pB0, pB1, alB, l_reg, pa0, pa1, pa2, pa3); else finishSM(pB0, pB1, alB, l_reg, pa0, pa1, pa2, pa3);
  SBAR();
  if constexpr (OT) pv_ot(o, vb0 + s0, pa0, pa1, pa2, pa3); else pv_d0(o, vb0 + s0, pa0, pa1, pa2, pa3);
  __builtin_amdgcn_s_setprio(0);
  int lane2; asm volatile("v_mbcnt_lo_u32_b32 %0, -1, 0\n\tv_mbcnt_hi_u32_b32 %0, -1, %0" : "=v"(lane2));
  const int r32b = lane2 & 31, hib = lane2 >> 5;
  if constexpr (OT) {
    const float rl = __builtin_amdgcn_rcpf(l_reg);
    bf16* Ow = Ob + (long)(wid * QBLK + r32b) * LDO + 4 * hib;
#pragma unroll
    for (int d0 = 0; d0 < 4; ++d0)
#pragma unroll
      for (int g = 0; g < 4; ++g) { const unsigned long long w = (unsigned long long)cvtpk(o[d0][4 * g] * rl, o[d0][4 * g + 1] * rl) | ((unsigned long long)cvtpk(o[d0][4 * g + 2] * rl, o[d0][4 * g + 3] * rl) << 32);
        *(unsigned long long*)(Ow + d0 * 32 + g * 8) = w; }
  } else {
  if (hi == 0) li_l[r32] = l_reg; asm volatile("s_waitcnt lgkmcnt(0)" ::: "memory");
  float rli[16];
#pragma unroll
  for (int r = 0; r < 16; ++r) rli[r] = __builtin_amdgcn_rcpf(li_l[crow(r, hib)]);
  bf16* Ow = Ob + (long)(wid * QBLK) * LDO + r32b;
#pragma unroll
  for (int r = 0; r < 16; ++r) { int orow = crow(r, hib);
    for (int d0 = 0; d0 < 4; ++d0) Ow[(long)orow * LDO + d0 * 32] = (bf16)(cvtpk(o[d0][r] * rli[r], 0.f) & 0xffffu); }
  }
  AWAIT_BAR(0);
#undef DMA_K
#undef DMA_V
#undef DMA_K1
#undef DMA_V1
#undef RESC
#undef ROT
}
template <int LDQ, int LDK, int LDO>
__device__ __forceinline__ void attn_dense_stg(const bf16* Qb, const bf16* __restrict__ Kh, const bf16* __restrict__ Vh, bf16* Ob, int seq, char* lds,
                                                __attribute__((address_space(3))) unsigned char* ldsl, const int wave_s, const float* qg = nullptr, const float* axt = nullptr, int tok0 = 0, float bnd = 0.f) {
  constexpr bool OT = true, QN = true, BND = true;
  int lane; asm volatile("v_mbcnt_lo_u32_b32 %0, -1, 0\n\tv_mbcnt_hi_u32_b32 %0, -1, %0" : "=v"(lane));
  const int wid = wave_s, r32 = lane & 31, hi = lane >> 5;
  float mhat = 0.f, l_reg = 0; f32x16 o[4] = {}; bf16x8 qr[8]; f32x16 negm;
  unsigned ksrc[2], vsrc[2];
#pragma unroll
  for (int i = 0; i < 2; ++i) { const int p = 2 * wid + i;
    const int krow = 4 * p + (lane >> 4), kch = (lane & 15) ^ (krow & 15); ksrc[i] = (unsigned)(krow * LDK + kch * 8) * 2u;
    const int sub = 2 * p + (lane >> 5), kk = ((sub >> 2) << 3) | ((lane & 31) >> 2), key = OT ? kk : ((kk & ~0xC) | ((kk & 4) << 1) | ((kk & 8) >> 1)), vc = ((sub & 3) << 5) | ((lane & 3) << 3);
    vsrc[i] = (unsigned)(key * LDK + vc) * 2u; }
#define DMA_K1(t, sl, i_) __builtin_amdgcn_global_load_lds((const unsigned*)((const char*)Kh + (ksrc[i_] + (unsigned)(t) * (unsigned)(KVBLK * LDK * 2))), (__attribute__((address_space(3))) unsigned*)(ldsl + (sl) + (2 * wid + (i_)) * 1024), 16, 0, 0)
#define DMA_V1(t, sl, i_) __builtin_amdgcn_global_load_lds((const unsigned*)((const char*)Vh + (vsrc[i_] + (unsigned)(t) * (unsigned)(KVBLK * LDK * 2))), (__attribute__((address_space(3))) unsigned*)(ldsl + 4 * ASLOT + (sl) + (2 * wid + (i_)) * 1024), 16, 0, 0)
#define DMA_K(t, sl) do { DMA_K1(t, sl, 0); DMA_K1(t, sl, 1); } while (0)
#define DMA_V(t, sl) do { DMA_V1(t, sl, 0); DMA_V1(t, sl, 1); } while (0)
  const int NT = seq / KVBLK;
  DMA_K(0, 0); DMA_V(0, 0); DMA_K(1, ASLOT); DMA_K(2, 2 * ASLOT);
  const bf16* Qw = Qb + (long)(wid * QBLK + r32) * LDQ + hi * 8;
#pragma unroll
  for (int d0 = 0; d0 < 8; ++d0) qr[d0] = ld8(Qw + d0 * 16);
  if constexpr (QN) {
    const int t = tok0 + wid * QBLK + r32, prow = t >> 6, pcol = t & 63;
    float x[8][8]; float ss = 0.f;
#pragma unroll
    for (int d0 = 0; d0 < 8; ++d0)
#pragma unroll
      for (int e = 0; e < 8; ++e) { x[d0][e] = __builtin_bit_cast(float, (unsigned)(unsigned short)qr[d0][e] << 16); ss += x[d0][e] * x[d0][e]; }
    { auto rr = __builtin_amdgcn_permlane32_swap(__float_as_uint(ss), __float_as_uint(ss), false, false); ss = __uint_as_float(rr[0]) + __uint_as_float(rr[1]); }
    const float rstd = CQ / sqrtf(ss * (1.f / 128.f) + 1e-6f);
#pragma unroll
    for (int d0 = 0; d0 < 8; ++d0) { const float* gp = qg + d0 * 16 + hi * 8; const f32x4v g0 = *(const f32x4v*)gp, g1 = *(const f32x4v*)(gp + 4);
#pragma unroll
      for (int e = 0; e < 8; ++e) x[d0][e] *= rstd * (e < 4 ? g0[e] : g1[e - 4]); }
#pragma unroll
    for (int half = 0; half < 2; ++half) { const float* ct = half == 0 ? axt + prow * 32 : axt + 16384 + pcol * 32; const float* st = ct + (half == 0 ? 8192 : 2048);
#pragma unroll
      for (int dd = 0; dd < 2; ++dd) { const int ix = dd * 16 + hi * 8;
        const f32x4v c0 = *(const f32x4v*)(ct + ix), c1 = *(const f32x4v*)(ct + ix + 4), s0 = *(const f32x4v*)(st + ix), s1 = *(const f32x4v*)(st + ix + 4);
#pragma unroll
        for (int e = 0; e < 8; ++e) { const float c = e < 4 ? c0[e] : c1[e - 4], sn = e < 4 ? s0[e] : s1[e - 4];
          const float a = x[half * 4 + dd][e], b = x[half * 4 + 2 + dd][e]; x[half * 4 + dd][e] = a * c - b * sn; x[half * 4 + 2 + dd][e] = b * c + a * sn; } } }
#pragma unroll
    for (int d0 = 0; d0 < 8; ++d0) { u32x4 w = {cvtpk(x[d0][0], x[d0][1]), cvtpk(x[d0][2], x[d0][3]), cvtpk(x[d0][4], x[d0][5]), cvtpk(x[d0][6], x[d0][7])}; qr[d0] = *reinterpret_cast<bf16x8*>(&w); }
  }
  if constexpr (!QN) {
#pragma unroll
    for (int d0 = 0; d0 < 8; ++d0) { float x[8];
#pragma unroll
      for (int e = 0; e < 8; ++e) x[e] = __builtin_bit_cast(float, (unsigned)(unsigned short)qr[d0][e] << 16) * CQ;
      u32x4 w = {cvtpk(x[0], x[1]), cvtpk(x[2], x[3]), cvtpk(x[4], x[5]), cvtpk(x[6], x[7])}; qr[d0] = *reinterpret_cast<bf16x8*>(&w); }
  }
  const bool onl = !BND || !(bnd <= 60.f);
  { float nb = (BND && !onl) ? -bnd : 0.f; asm volatile("" : "+v"(nb));
    for (int r = 0; r < 16; ++r) negm[r] = nb; asm volatile("" : "+v"(negm)); }
  f32x16 S0, S1; float al = 1.f; bf16x8 pa0, pa1, pa2, pa3;
  int s0 = 2 * ASLOT, s1 = 0, s2 = ASLOT;
#define ROT() do { const int t_ = s0; s0 = s1; s1 = s2; s2 = t_; } while (0)
#define VBAR() asm volatile("s_waitcnt lgkmcnt(0)\n\ts_barrier" ::: "memory")
  const lds_cp kb_l = (lds_cp)ldsl + r32 * 256, vb_l = (lds_cp)ldsl + 4 * ASLOT + v_rd_base(lane);
  const int ksw = (r32 & 15) << 4, khi = hi * 16;
  bf16x8 kf[4][2]; s16x4 vl[8], vh[8];
#define G_KRD(kp, i) do { const unsigned a_ = (unsigned)(uintptr_t)(kp) + (unsigned)((((i) * 32 + khi) ^ ksw)); \
    asm volatile("ds_read_b128 %0, %2\n\tds_read_b128 %1, %2 offset:8192" : "=&v"(kf[(i) & 3][0]), "=&v"(kf[(i) & 3][1]) : "v"(a_) : "memory"); } while (0)
#define G_KWAIT(N, i) do { asm volatile("s_waitcnt lgkmcnt(" #N ")" ::: "memory"); SBAR(); } while (0)
#define G_VRD(vp, j) do { const unsigned a_ = (unsigned)(uintptr_t)(vp); \
    asm volatile("ds_read_b64_tr_b16 %0, %2 offset:%3\n\tds_read_b64_tr_b16 %1, %2 offset:%4" : "=&v"(vl[(j) & 7]), "=&v"(vh[(j) & 7]) : "v"(a_), "i"(v_rd_off((j) & 3, (j) >> 2, 0)), "i"(v_rd_off((j) & 3, (j) >> 2, 1)) : "memory"); } while (0)
#define G_VWAIT(N, j) do { asm volatile("s_waitcnt lgkmcnt(" #N ")" ::: "memory"); SBAR(); } while (0)
#define G_VF(j) (bf16x8){vl[(j) & 7][0], vl[(j) & 7][1], vl[(j) & 7][2], vl[(j) & 7][3], vh[(j) & 7][0], vh[(j) & 7][1], vh[(j) & 7][2], vh[(j) & 7][3]}
#define G_PA(j) (((j) >> 2) == 0 ? pa0 : ((j) >> 2) == 1 ? pa1 : ((j) >> 2) == 2 ? pa2 : pa3)
#define G_QK(i, HASPV, kp, vp, tk, tv) do { \
    if (((i) & 1) == 0 && ((i) >> 1) + 3 < 8) G_KRD(kp, ((i) >> 1) + 3); \
    if ((HASPV) && (i) >= 10) G_VRD(vp, (i) - 10); \
    if (((i) & 1) == 0) { if ((i) < 10) G_KWAIT(6, (i) >> 1); \
      else if ((i) == 10) { if (HASPV) G_KWAIT(6, 5); else G_KWAIT(4, 5); } \
      else if ((i) == 12) { if (HASPV) G_KWAIT(8, 6); else G_KWAIT(2, 6); } \
      else { if (HASPV) G_KWAIT(10, 7); else G_KWAIT(0, 7); } } \
    if (((i) & 1) == 0) S0 = __builtin_amdgcn_mfma_f32_32x32x16_bf16(kf[((i) >> 1) & 3][0], qr[(i) >> 1], (i) < 2 ? negm : S0, 0, 0, 0); \
    else S1 = __builtin_amdgcn_mfma_f32_32x32x16_bf16(kf[((i) >> 1) & 3][1], qr[(i) >> 1], (i) < 2 ? negm : S1, 0, 0, 0); \
    SBAR(); } while (0)
#define G_PV(j, vp) do { if ((j) + 6 < 16) G_VRD(vp, (j) + 6); \
    if ((j) < 10) G_VWAIT(12, j); else if ((j) == 10) G_VWAIT(10, 10); else if ((j) == 11) G_VWAIT(8, 11); else if ((j) == 12) G_VWAIT(6, 12); \
    else if ((j) == 13) G_VWAIT(4, 13); else if ((j) == 14) G_VWAIT(2, 14); else G_VWAIT(0, 15); \
    o[(j) & 3] = __builtin_amdgcn_mfma_f32_32x32x16_bf16(G_VF(j), G_PA(j), o[(j) & 3], 0, 0, 0); SBAR(); } while (0)
#define G_KPRE(kp) do { SBAR(); G_KRD(kp, 0); G_KRD(kp, 1); G_KRD(kp, 2); SBAR(); } while (0)
#define G_QK16(HASPV, kp, vp, tk, tv) do { \
    G_QK(0, HASPV, kp, vp, tk, tv); G_QK(1, HASPV, kp, vp, tk, tv); G_QK(2, HASPV, kp, vp, tk, tv); G_QK(3, HASPV, kp, vp, tk, tv); \
    G_QK(4, HASPV, kp, vp, tk, tv); G_QK(5, HASPV, kp, vp, tk, tv); G_QK(6, HASPV, kp, vp, tk, tv); G_QK(7, HASPV, kp, vp, tk, tv); \
    G_QK(8, HASPV, kp, vp, tk, tv); G_QK(9, HASPV, kp, vp, tk, tv); G_QK(10, HASPV, kp, vp, tk, tv); G_QK(11, HASPV, kp, vp, tk, tv); \
    G_QK(12, HASPV, kp, vp, tk, tv); G_QK(13, HASPV, kp, vp, tk, tv); G_QK(14, HASPV, kp, vp, tk, tv); G_QK(15, HASPV, kp, vp, tk, tv); } while (0)
#define G_PV16(vp) do { G_PV(0, vp); G_PV(1, vp); G_PV(2, vp); G_PV(3, vp); G_PV(4, vp); G_PV(5, vp); G_PV(6, vp); G_PV(7, vp); \
    G_PV(8, vp); G_PV(9, vp); G_PV(10, vp); G_PV(11, vp); G_PV(12, vp); G_PV(13, vp); G_PV(14, vp); G_PV(15, vp); } while (0)
#define G_SOFTMAX(FIRST) do { al = 1.f; \
    if (onl) { float pmax = S0[0]; for (int r = 1; r < 16; ++r) pmax = fmaxf(pmax, S0[r]); for (int r = 0; r < 16; ++r) pmax = fmaxf(pmax, S1[r]); \
      { auto rr = __builtin_amdgcn_permlane32_swap(__float_as_uint(pmax), __float_as_uint(pmax), false, false); pmax = fmaxf(__uint_as_float(rr[0]), __uint_as_float(rr[1])); } \
      if ((FIRST) || !__all(pmax <= THR2)) { const float dl = (FIRST) ? pmax : fmaxf(pmax, 0.f); mhat += dl; \
        for (int r = 0; r < 16; ++r) { S0[r] -= dl; S1[r] -= dl; } for (int r = 0; r < 16; ++r) negm[r] = -mhat; asm volatile("" : "+v"(negm)); \
        if (!(FIRST)) { al = __builtin_amdgcn_exp2f(-dl); for (int d = 0; d < 4; ++d) for (int r = 0; r < 16; ++r) o[d][r] *= al; } } } \
    for (int r = 0; r < 16; ++r) S0[r] = __builtin_amdgcn_exp2f(S0[r]); for (int r = 0; r < 16; ++r) S1[r] = __builtin_amdgcn_exp2f(S1[r]); \
    { float ps = 0.f; for (int r = 0; r < 16; ++r) ps += S0[r]; for (int r = 0; r < 16; ++r) ps += S1[r]; \
      auto rr = __builtin_amdgcn_permlane32_swap(__float_as_uint(ps), __float_as_uint(ps), false, false); l_reg = l_reg * al + (__uint_as_float(rr[0]) + __uint_as_float(rr[1])); } \
    pa0 = pack8(S0, 0); pa1 = pack8(S0, 8); pa2 = pack8(S1, 0); pa3 = pack8(S1, 8); } while (0)
  AWAIT_BAR(0);
  const bool grpB = wid >= 4;
  G_KPRE(kb_l);
  if (grpB) VBAR();
  { const lds_cp kp_ = kb_l, vp_ = vb_l + s0; __builtin_amdgcn_s_setprio(1);
    G_QK16(false, kp_, vp_, 2, 1);
    __builtin_amdgcn_s_setprio(0); AWAIT_BAR(0); ROT(); }
  DMA_K(3, 3 * ASLOT); DMA_V(1, s1);
  G_SOFTMAX(true); G_KPRE(kb_l + ASLOT); VBAR();
#pragma unroll 1
  for (int t = 1; t < NT; ++t) {
    { const int tk = t + 3 < NT ? t + 3 : NT - 1, tv = t + 1 < NT ? t + 1 : NT - 1;
      const lds_cp kp_ = kb_l + ((t & 3) << 14), vp_ = vb_l + s0; __builtin_amdgcn_s_setprio(1);
      G_QK16(true, kp_, vp_, tk, tv);
      G_PV16(vp_);
      __builtin_amdgcn_s_setprio(0); AWAIT_BAR(0); ROT(); }
    G_SOFTMAX(false);
    { const lds_cp kn_ = kb_l + (((t + 1) & 3) << 14); G_KPRE(kn_); }
    { const int tk = t + 3 < NT ? t + 3 : NT - 1, tv = t + 1 < NT ? t + 1 : NT - 1; SBAR();
      DMA_K(tk, ((t + 3) & 3) << 14); DMA_V(tv, s1); }
    VBAR();
  }
  { const lds_cp vp_ = vb_l + s0; __builtin_amdgcn_s_setprio(1);
    SBAR(); G_VRD(vp_, 0); G_VRD(vp_, 1); G_VRD(vp_, 2); G_VRD(vp_, 3); G_VRD(vp_, 4); G_VRD(vp_, 5); SBAR();
    G_PV16(vp_);
    __builtin_amdgcn_s_setprio(0); }
  if (!grpB) VBAR();
#undef G_KRD
#undef G_KWAIT
#undef G_VRD
#undef G_VWAIT
#undef G_VF
#undef G_PA
#undef G_QK
#undef G_PV
#undef G_QK16
#undef G_KPRE
#undef G_PV16
#undef G_SOFTMAX
  int lane2; asm volatile("v_mbcnt_lo_u32_b32 %0, -1, 0\n\tv_mbcnt_hi_u32_b32 %0, -1, %0" : "=v"(lane2));
  const int r32b = lane2 & 31, hib = lane2 >> 5;
  { const float rl = __builtin_amdgcn_rcpf(l_reg);
    bf16* Ow = Ob + (long)(wid * QBLK + r32b) * LDO + 4 * hib;
#pragma unroll
    for (int d0 = 0; d0 < 4; ++d0)
#pragma unroll
      for (int g = 0; g < 4; ++g) { const unsigned long long w = (unsigned long long)cvtpk(o[d0][4 * g] * rl, o[d0][4 * g + 1] * rl) | ((unsigned long long)cvtpk(o[d0][4 * g + 2] * rl, o[d0][4 * g + 3] * rl) << 32);
        *(unsigned long long*)(Ow + d0 * 32 + g * 8) = w; } }
  AWAIT_BAR(0);
#undef DMA_K
#undef DMA_V
#undef DMA_K1
#undef DMA_V1
#undef ROT
#undef VBAR
}
}

namespace ba {
using namespace da;
constexpr float C2 = SCALE * 1.4426950408889634f;
__device__ __forceinline__ void battn_wg_unit(const bf16* __restrict__ Q, const bf16* __restrict__ K, const bf16* __restrict__ V, bf16* __restrict__ OG, float* __restrict__ LSE,
                                              int q0, int seg_lo, int seg_hi, int h, char* lds, __attribute__((address_space(3))) unsigned char* ldsl, const int wave_s,
                                              const bool preloaded = false, const bool has_next = false, const bf16* __restrict__ Kn = nullptr, const bf16* __restrict__ Vn = nullptr, int q0n = 0, int seg_lon = 0, int seg_hin = 0, int hn = 0) {
  constexpr int LD = 1024;
  int lane; asm volatile("v_mbcnt_lo_u32_b32 %0, -1, 0\n\tv_mbcnt_hi_u32_b32 %0, -1, %0" : "=v"(lane));
  const int wid = wave_s, r32 = lane & 31, hi = lane >> 5;
  char* K_lds = lds; char* V_lds = lds + 3 * ASLOT;
  float* ws = (float*)(lds + 6 * ASLOT) + wid * 64; float* li_l = ws; float* al_l = ws + 32;
  float mhat = 0.f, l_reg = 0; f32x16 o[4] = {}; bf16x8 qr[8]; f32x16 negm = {}; asm volatile("" : "+v"(negm));
  const int kb0 = q0 - 64;
  int krow[2], kcol[2], vrow[2], vcol[2];
#pragma unroll
  for (int i = 0; i < 2; ++i) { const int p = 2 * wid + i;
    krow[i] = 4 * p + (lane >> 4); kcol[i] = ((lane & 15) ^ (krow[i] & 7)) * 8;
    const int sub = 2 * p + (lane >> 5), kk = ((sub >> 2) << 3) | ((lane & 31) >> 2); vrow[i] = (kk & ~0xC) | ((kk & 4) << 1) | ((kk & 8) >> 1); vcol[i] = ((sub & 3) << 5) | ((lane & 3) << 3); }
  const bf16* Kh = K + h * 128; const bf16* Vh = V + h * 128;
#define BDMA(t, sl) BDMAX(Kh, Vh, kb0, seg_lo, seg_hi, t, sl)
#define BDMAX(Kh_, Vh_, kb0_, slo_, shi_, t, sl) do { const int kb_ = (kb0_) + 64 * (t); _Pragma("unroll") for (int i_ = 0; i_ < 2; ++i_) { \
    int rk_ = kb_ + krow[i_]; rk_ = rk_ < (slo_) ? (slo_) : (rk_ >= (shi_) ? (shi_) - 1 : rk_); int rv_ = kb_ + vrow[i_]; rv_ = rv_ < (slo_) ? (slo_) : (rv_ >= (shi_) ? (shi_) - 1 : rv_); \
    __builtin_amdgcn_global_load_lds((const unsigned*)((Kh_) + (long)rk_ * LD + kcol[i_]), (__attribute__((address_space(3))) unsigned*)(ldsl + (sl) + (2 * wid + i_) * 1024), 16, 0, 0); \
    __builtin_amdgcn_global_load_lds((const unsigned*)((Vh_) + (long)rv_ * LD + vcol[i_]), (__attribute__((address_space(3))) unsigned*)(ldsl + 3 * ASLOT + (sl) + (2 * wid + i_) * 1024), 16, 0, 0); } } while (0)
  if (!preloaded) { BDMA(0, 0); BDMA(1, ASLOT); }
  const bf16* Khn = Kn + hn * 128; const bf16* Vhn = Vn + hn * 128; const int kb0n = q0n - 64;
  { const bf16* Qw = Q + (long)(q0 + wid * QBLK + r32) * LD + h * 128 + hi * 8;
#pragma unroll
    for (int d0 = 0; d0 < 8; ++d0) { const bf16x8 raw = ld8(Qw + d0 * 16); float x[8];
#pragma unroll
      for (int e = 0; e < 8; ++e) x[e] = __builtin_bit_cast(float, (unsigned)(unsigned short)raw[e] << 16) * CQ;
      u32x4 w = {cvtpk(x[0], x[1]), cvtpk(x[2], x[3]), cvtpk(x[4], x[5]), cvtpk(x[6], x[7])}; qr[d0] = *reinterpret_cast<bf16x8*>(&w); } }
  const int vb0 = (int)(uintptr_t)V_lds + v_rd_base(lane);
  const int qi = q0 + wid * QBLK + r32, t_lo = wid >> 1;
  int s0 = 2 * ASLOT, s1 = 0, s2 = ASLOT;
  bool started = false;
  AWAIT_BAR(0);
#pragma unroll 1
  for (int t = 0; t < 6; ++t) {
    if (t >= 4 && has_next) BDMAX(Khn, Vhn, kb0n, seg_lon, seg_hin, t - 4, s0);
    else { const int tn = t + 2 < 6 ? t + 2 : 5; BDMA(tn, s0); }
    const int kb = kb0 + 64 * t;
    const bool active = (t >= t_lo) && (t <= t_lo + 2) && (kb + 64 > seg_lo) && (kb < seg_hi);
    if (active) {
      f32x16 S0, S1; float al; bf16x8 pa0, pa1, pa2, pa3;
      qkt_n(S0, S1, (const bf16*)(K_lds + s1), qr, negm, r32, hi);
#pragma unroll
      for (int r = 0; r < 16; ++r) { const int ka = kb + crow(r, hi), kc = ka + 32;
        const bool oka = (ka - qi <= 64) & (qi - ka <= 64), okc = (kc - qi <= 64) & (qi - kc <= 64);
        S0[r] = oka ? S0[r] : -1e30f; S1[r] = okc ? S1[r] : -1e30f; }
      float pmax = S0[0];
#pragma unroll
      for (int r = 1; r < 16; ++r) pmax = fmaxf(pmax, S0[r]);
#pragma unroll
      for (int r = 0; r < 16; ++r) pmax = fmaxf(pmax, S1[r]);
      { auto rr = __builtin_amdgcn_permlane32_swap(__float_as_uint(pmax), __float_as_uint(pmax), false, false); pmax = fmaxf(__uint_as_float(rr[0]), __uint_as_float(rr[1])); }
      al = 1.f;
      if (!started || !__all(pmax <= THR2)) {
        const float dl = !started ? pmax : fmaxf(pmax, 0.f); mhat += dl;
#pragma unroll
        for (int r = 0; r < 16; ++r) { S0[r] -= dl; S1[r] -= dl; }
#pragma unroll
        for (int r = 0; r < 16; ++r) negm[r] = -mhat;
        asm volatile("" : "+v"(negm));
        if (started) al = __builtin_amdgcn_exp2f(-dl);
      }
      started = true;
      float ps = 0.f;
#pragma unroll
      for (int r = 0; r < 16; ++r) { S0[r] = __builtin_amdgcn_exp2f(S0[r]); S1[r] = __builtin_amdgcn_exp2f(S1[r]); ps += S0[r] + S1[r]; }
      { auto rr = __builtin_amdgcn_permlane32_swap(__float_as_uint(ps), __float_as_uint(ps), false, false); ps = __uint_as_float(rr[0]) + __uint_as_float(rr[1]); }
      l_reg = l_reg * al + ps;
      PK4(S0, 0, pa0); PK4(S0, 8, pa1); PK4(S1, 0, pa2); PK4(S1, 8, pa3);
      if (__any(al < 1.f)) { if (hi == 0) al_l[r32] = al; asm volatile("s_waitcnt lgkmcnt(0)" ::: "memory");
#pragma unroll
        for (int d = 0; d < 4; ++d)
#pragma unroll
          for (int r = 0; r < 16; ++r) o[d][r] *= al_l[crow(r, hi)]; }
      pv_d0(o, vb0 + s1, pa0, pa1, pa2, pa3);
    }
    AWAIT_BAR(4); { const int t_ = s0; s0 = s1; s1 = s2; s2 = t_; }
  }
  if (hi == 0) li_l[r32] = l_reg; asm volatile("s_waitcnt lgkmcnt(0)" ::: "memory");
  int lane2; asm volatile("v_mbcnt_lo_u32_b32 %0, -1, 0\n\tv_mbcnt_hi_u32_b32 %0, -1, %0" : "=v"(lane2));
  const int r32b = lane2 & 31, hib = lane2 >> 5;
  float rli[16];
#pragma unroll
  for (int r = 0; r < 16; ++r) rli[r] = __builtin_amdgcn_rcpf(li_l[crow(r, hib)]);
  bf16* Ow = OG + (long)(q0 + wid * QBLK) * LD + h * 128 + r32b;
#pragma unroll
  for (int r = 0; r < 16; ++r) { const int orow = crow(r, hib);
#pragma unroll
    for (int d0 = 0; d0 < 4; ++d0) Ow[(long)orow * LD + d0 * 32] = (bf16)(cvtpk(o[d0][r] * rli[r], 0.f) & 0xffffu); }
  if (hib == 0) LSE[(size_t)(q0 + wid * QBLK + r32b) * 8 + h] = (mhat + __builtin_amdgcn_logf(l_reg)) * 0.6931471805599453f;
  if (has_next) asm volatile("s_waitcnt lgkmcnt(0)\n\ts_barrier" ::: "memory"); else AWAIT_BAR(0);
#undef BDMA
#undef BDMAX
}
}
#define GAS __attribute__((address_space(1)))
#define LAS __attribute__((address_space(3)))
typedef unsigned short bf16;
typedef unsigned v4u __attribute__((ext_vector_type(4)));
typedef float f32x4 __attribute__((ext_vector_type(4)));
typedef short bf16x8 __attribute__((ext_vector_type(8)));
typedef GAS unsigned gu32;
typedef GAS unsigned long long gu64;
#define RLX_AGENT __ATOMIC_RELAXED, __HIP_MEMORY_SCOPE_AGENT
#define LDS_WAIT() asm volatile("s_waitcnt lgkmcnt(0)" ::: "memory")
#define VM_WAIT() asm volatile("s_waitcnt vmcnt(0)" ::: "memory")
__device__ __forceinline__ unsigned long long rt() { return __builtin_amdgcn_s_memrealtime(); }
__device__ __forceinline__ unsigned f2bf(float f) { unsigned u = __builtin_bit_cast(unsigned, f); return (u + 0x7fffu + ((u >> 16) & 1u)) >> 16; }
__device__ __forceinline__ unsigned pk2(float lo, float hi) { return f2bf(lo) | (f2bf(hi) << 16); }

#define XB_TMO      128
#define XB_XCNT(j)  (256  + 64 * (j))
#define XB_XSUB(j)  (1280 + 64 * (j))
#define XB_XGEN(j)  (2304 + 64 * (j))
#define XB_TOP      3328
#define XB_TOPGEN   3392
#define XCD_BAR_WORDS 3456
#define XB_SPIN_CAP (1u << 18)

__device__ __forceinline__ unsigned xb_ld(unsigned* p)              { return __hip_atomic_load(p, __ATOMIC_RELAXED, __HIP_MEMORY_SCOPE_AGENT); }
__device__ __forceinline__ unsigned xb_add(unsigned* p, unsigned v) { return __hip_atomic_fetch_add(p, v, __ATOMIC_RELAXED, __HIP_MEMORY_SCOPE_AGENT); }
__device__ __forceinline__ unsigned xb_xcc_id() { return (unsigned)__builtin_amdgcn_s_getreg((3 << 11) | 20) & 0xFu; }
#define XB_SPIN(cond, bar) do { unsigned _sp = 0; while (cond) { __builtin_amdgcn_s_sleep(1); \
    if ((++_sp & 255u) == 0u) { if (xb_ld(&(bar)[XB_TMO])) break; if (_sp > XB_SPIN_CAP) { atomicAdd(&(bar)[XB_TMO], 1u); break; } } } } while (0)

struct XcdBarrier {
    unsigned* bar; unsigned x;
    volatile LAS unsigned* st;
};

__device__ __forceinline__ XcdBarrier xcd_barrier_post(unsigned* bar, volatile LAS unsigned* st) {
    XcdBarrier b; b.bar = bar; b.x = xb_xcc_id(); b.st = st;
    if (threadIdx.x == 0) (void)xb_add(&bar[XB_XCNT(b.x)], 1u);
    return b;
}
__device__ __forceinline__ void xcd_barrier_complete(unsigned* bar, unsigned x, unsigned& nloc, unsigned& nx) {
    const unsigned G = gridDim.x * gridDim.y * gridDim.z;
    unsigned sum, cnt, mine, sp = 0u;
    for (;;) {
        sum = 0u; cnt = 0u; mine = 0u;
#pragma unroll
        for (unsigned j = 0; j < 16; ++j) { const unsigned c = xb_ld(&bar[XB_XCNT(j)]); sum += c; cnt += (c > 0u) ? 1u : 0u; mine = (j == x) ? c : mine; }
        if (sum == G) break;
        __builtin_amdgcn_s_sleep(1);
        if ((++sp & 255u) == 0u) { if (xb_ld(&bar[XB_TMO])) break; if (sp > XB_SPIN_CAP) { atomicAdd(&bar[XB_TMO], 1u); break; } }
    }
    nloc = mine > 0u ? mine : 1u; nx = cnt > 0u ? cnt : 1u;
}

__device__ __forceinline__ void xcd_barrier(const XcdBarrier& b) {
    asm volatile("s_waitcnt vmcnt(0)" ::: "memory");
    __syncthreads();
    if (threadIdx.x == 0) {
        unsigned* bar = b.bar;
        __builtin_amdgcn_s_waitcnt(0);
        unsigned nloc = b.st[0], nx = b.st[1];
        if (nloc == 0u) { xcd_barrier_complete(bar, b.x, nloc, nx); b.st[0] = nloc; b.st[1] = nx; }
        const unsigned old = xb_add(&bar[XB_XSUB(b.x)], 1u);
        const unsigned gen = old / nloc;
        if (old + 1u == (gen + 1u) * nloc) {
            __builtin_amdgcn_fence(__ATOMIC_RELEASE, "agent");
            asm volatile("s_waitcnt vmcnt(0)" ::: "memory");
            const unsigned og = xb_add(&bar[XB_TOP], 1u);
            const unsigned tg = og / nx;
            if (og + 1u == (tg + 1u) * nx) xb_add(&bar[XB_TOPGEN], 1u);
            else XB_SPIN(xb_ld(&bar[XB_TOPGEN]) == tg, bar);
            __builtin_amdgcn_fence(__ATOMIC_ACQUIRE, "agent");
            xb_add(&bar[XB_XGEN(b.x)], 1u);
            asm volatile("s_waitcnt vmcnt(0)" ::: "memory");
        } else {
            XB_SPIN(xb_ld(&bar[XB_XGEN(b.x)]) == gen, bar);
            __builtin_amdgcn_fence(__ATOMIC_ACQUIRE, "agent");
            asm volatile("s_waitcnt vmcnt(0)" ::: "memory");
        }
    }
    __syncthreads();
}

constexpr int DM = 2048, SEQ = 16384, NSEQ = 3, MTOK = NSEQ * SEQ, HD = 128, DFF = 8192, MEMR = 768, DEPTH = 4;
constexpr float EPS = 1e-6f;
constexpr int NWAVES = 8;
#ifndef GM_ALIGN
#define GM_ALIGN true
#endif
#ifndef GM_SP2
#define GM_SP2 true
#endif
constexpr int MLPC = 8192;
#ifndef PHMASK
#define PHMASK 0xFFFFFFu
#endif
#define PH(n) (((PHMASK) >> (n)) & 1u)
#ifndef WGM_QKVB
#define WGM_QKVB 8
#define WGM_QKVA 8
#endif
#ifndef EXPN
#define EXPN 0
#endif
#define REPS(k) for (int rep_ = 0; rep_ < (((EXPN) == (k) || ((EXPN) == 9 && ((k) == 2 || (k) == 3 || (k) == 7))) ? 2 : 1); ++rep_)
constexpr size_t MiB = 1u << 20;
constexpr size_t WS_CTL = 0, CTL_ZERO_BYTES = 8 * MiB;
constexpr size_t WS_SS = 1 * MiB;
constexpr size_t WS_COS1 = 8 * MiB, WS_SIN1 = 12 * MiB;
constexpr size_t WS_AXT = 16 * MiB;
constexpr size_t WS_MEMN = 17 * MiB;
constexpr size_t WS_CKVT = 29 * MiB;
constexpr size_t WS_CKV = 45 * MiB;
constexpr size_t WS_WQKV = 51 * MiB;
constexpr size_t WS_WO = 87 * MiB;
constexpr size_t WS_CWQ = 95 * MiB, WS_CWO = 97 * MiB;
constexpr size_t WS_WUP = 99 * MiB, WS_WDN = 131 * MiB;
constexpr size_t WS_HN = 163 * MiB;
constexpr size_t WS_QKV = 355 * MiB;
constexpr size_t WS_BIG = 643 * MiB;
constexpr size_t WS_END = 899 * MiB;
constexpr size_t BIG_OB = 0, BIG_OG = 96 * MiB, BIG_LSE = 192 * MiB;
constexpr int CW_BAR = 4096;
constexpr int RING_BYTES = 131072;
constexpr int LDSCTL_OFF = RING_BYTES, MISC_OFF = LDSCTL_OFF + 320;
constexpr int PTAB_OFF = RING_BYTES + 512;
constexpr int BSCR_OFF = RING_BYTES + 1024;
constexpr int LDS_BYTES = 147456;

__device__ __forceinline__ float shflx(float v, int mask, int lane) { return __builtin_bit_cast(float, __builtin_amdgcn_ds_bpermute((lane ^ mask) << 2, __builtin_bit_cast(int, v))); }
__device__ __forceinline__ float wave_sum(float v, int lane) {
#pragma unroll
    for (int o = 1; o < 64; o <<= 1) v += shflx(v, o, lane);
    return v;
}
__device__ __forceinline__ int pair_row(int L) { const int w = L & 255, d = w & 127; return (L & ~255) + (d >> 6) * 128 + (w >> 7) * 64 + (d & 63); }
typedef _Float16 half2k __attribute__((ext_vector_type(2)));
__device__ __forceinline__ unsigned pkh(float lo, float hi) { const half2k v = {(_Float16)lo, (_Float16)hi}; return __builtin_bit_cast(unsigned, v); }
__device__ __forceinline__ unsigned pkhb(float lo, float hi) { const unsigned t = pk2(lo, hi); return pkh(__builtin_bit_cast(float, t << 16), __builtin_bit_cast(float, t & 0xFFFF0000u)); }
__device__ __forceinline__ void transpose_item(const float* W, const float* gain, int K, int N, bf16* WT, LAS float* scr, int item, int lane, int nperm = 0, bool f16 = false) {
    const int nblk = N / 32, kb = item / nblk, nb = item % nblk, k0 = 64 * kb, n0 = 32 * nb;
    float wv[32];
#pragma unroll
    for (int i = 0; i < 32; ++i) { const int kk = 2 * i + (lane >> 5); wv[i] = W[(size_t)(k0 + kk) * N + n0 + (lane & 31)]; }
    if (gain) {
#pragma unroll
        for (int i = 0; i < 32; ++i) wv[i] *= gain[k0 + 2 * i + (lane >> 5)];
    }
#pragma unroll
    for (int i = 0; i < 32; ++i) { const int kk = 2 * i + (lane >> 5); scr[kk * 33 + (lane & 31)] = wv[i]; }
    LDS_WAIT(); asm volatile("" ::: "memory");
    const int c = lane & 7;
#pragma unroll
    for (int j = 0; j < 4; ++j) { const int n = (lane >> 3) + 8 * j; const LAS float* s = scr + (8 * c) * 33 + n;
        v4u o;
        if (f16) { o.x = pkhb(s[0 * 33], s[1 * 33]); o.y = pkhb(s[2 * 33], s[3 * 33]); o.z = pkhb(s[4 * 33], s[5 * 33]); o.w = pkhb(s[6 * 33], s[7 * 33]); }
        else { o.x = pk2(s[0 * 33], s[1 * 33]); o.y = pk2(s[2 * 33], s[3 * 33]); o.z = pk2(s[4 * 33], s[5 * 33]); o.w = pk2(s[6 * 33], s[7 * 33]); }
        const int nr = (n0 + n) < nperm ? pair_row(n0 + n) : (n0 + n);
        *(GAS v4u*)(WT + (size_t)nr * K + k0 + 8 * c) = o; }
    LDS_WAIT(); asm volatile("" ::: "memory");
}
__device__ __forceinline__ void transpose_all(const float* W, const float* gain, int K, int N, bf16* WT, LAS float* scr, int gw, int NGW, int lane, int nperm = 0, bool f16 = false) {
    const int nitems = (K / 64) * (N / 32);
    for (int it = gw; it < nitems; it += NGW) transpose_item(W, gain, K, N, WT, scr, it, lane, nperm, f16);
}
__device__ __forceinline__ void rms_row_bf16(const float* xrow, const float* gain, bf16* orow, float* copy, int lane) {
    const GAS f32x4* xr = (const GAS f32x4*)xrow + lane; const GAS f32x4* gr = (const GAS f32x4*)gain + lane;
    f32x4 v[8]; float s = 0.f;
#pragma unroll
    for (int j = 0; j < 8; ++j) { v[j] = xr[64 * j]; s += (v[j].x * v[j].x + v[j].y * v[j].y) + (v[j].z * v[j].z + v[j].w * v[j].w); }
    const float rstd = 1.0f / sqrtf(wave_sum(s, lane) * (1.f / DM) + EPS);
    if (copy) { GAS f32x4* c4 = (GAS f32x4*)copy + lane;
#pragma unroll
        for (int j = 0; j < 8; ++j) c4[64 * j] = v[j]; }
    GAS unsigned long long* o8 = (GAS unsigned long long*)orow + lane;
#pragma unroll
    for (int j = 0; j < 8; ++j) { const f32x4 g = gr[64 * j];
        o8[64 * j] = (unsigned long long)pk2(v[j].x * rstd * g.x, v[j].y * rstd * g.y) | ((unsigned long long)pk2(v[j].z * rstd * g.z, v[j].w * rstd * g.w) << 32); }
}
__device__ __forceinline__ void prep_row(const float* xrow, bf16* brow, unsigned long long* ss, int lane) {
    const GAS f32x4* xr = (const GAS f32x4*)xrow + lane; GAS unsigned long long* o8 = (GAS unsigned long long*)brow + lane;
    f32x4 v[8]; float s = 0.f;
#pragma unroll
    for (int j = 0; j < 8; ++j) { v[j] = xr[64 * j]; s += (v[j].x * v[j].x + v[j].y * v[j].y) + (v[j].z * v[j].z + v[j].w * v[j].w); }
    s = wave_sum(s, lane);
#pragma unroll
    for (int j = 0; j < 8; ++j) o8[64 * j] = (unsigned long long)pkh(v[j].x, v[j].y) | ((unsigned long long)pkh(v[j].z, v[j].w) << 32);
    if (lane == 0) *ss = (unsigned long long)(s * 1048576.f + 0.5f);
}
__device__ __forceinline__ void final_row(const bf16* brow, float* orow, const float* gain, const unsigned long long* ss, int lane) {
    const GAS unsigned long long* b8 = (const GAS unsigned long long*)brow + lane; GAS f32x4* xr = (GAS f32x4*)orow + lane; const GAS f32x4* gr = (const GAS f32x4*)gain + lane;
    const float rstd = 1.0f / sqrtf((float)*ss * (1.0f / (1048576.f * 2048.f)) + EPS);
#pragma unroll
    for (int j = 0; j < 8; ++j) { const f32x4 g = gr[64 * j]; const unsigned long long w = b8[64 * j];
        const half2k lo = __builtin_bit_cast(half2k, (unsigned)w), hi = __builtin_bit_cast(half2k, (unsigned)(w >> 32));
        f32x4 v; v.x = (float)lo[0]; v.y = (float)lo[1]; v.z = (float)hi[0]; v.w = (float)hi[1];
        xr[64 * j] = v * rstd * g; }
}
__device__ __forceinline__ float bf2f(unsigned short b) { return __builtin_bit_cast(float, (unsigned)b << 16); }
typedef unsigned short us8 __attribute__((ext_vector_type(8)));

typedef const __attribute__((address_space(4))) unsigned long long* kargp_t;
#define P_IN(i) ((const float*)(const GAS float*)kp[(i)])
#define PHASE_PTRS kargp_t kp = (kargp_t)__builtin_amdgcn_kernarg_segment_ptr(); asm volatile("" : "+s"(kp)); unsigned char* ws = (unsigned char*)(GAS unsigned char*)kp[21]; \
    const float* x_prompt = P_IN(0); const float* x_sample = P_IN(1); const float* mem_prompt = P_IN(2); const float* mem_sample = P_IN(3); \
    const float* norm_mix = P_IN(4); const float* a_wqkv = P_IN(5); const float* a_q_gain = P_IN(6); const float* a_k_gain = P_IN(7); const float* a_wo = P_IN(8); \
    const float* b_wqkv = P_IN(9); const float* b_wo = P_IN(10); const float* norm_cross = P_IN(11); const float* norm_mem = P_IN(12); \
    const float* c_wq = P_IN(13); const float* c_wkv = P_IN(14); const float* c_wo = P_IN(15); const float* norm_mlp = P_IN(16); \
    const float* w_up = P_IN(17); const float* w_down = P_IN(18); const float* final_norm = P_IN(19); \
    float* X = (float*)(GAS float*)kp[20]; \
    unsigned long long* SS = (unsigned long long*)(ws + WS_SS); float* COS1 = (float*)(ws + WS_COS1); float* SIN1 = (float*)(ws + WS_SIN1); float* AXT = (float*)(ws + WS_AXT); \
    bf16* MEMN = (bf16*)(ws + WS_MEMN); bf16* CKVT = (bf16*)(ws + WS_CKVT); bf16* CKV = (bf16*)(ws + WS_CKV); \
    bf16* WQKV = (bf16*)(ws + WS_WQKV); bf16* WO = (bf16*)(ws + WS_WO); bf16* CWQ = (bf16*)(ws + WS_CWQ); bf16* CWO = (bf16*)(ws + WS_CWO); \
    bf16* WUP = (bf16*)(ws + WS_WUP); bf16* WDN = (bf16*)(ws + WS_WDN); bf16* HN = (bf16*)(ws + WS_HN); \
    bf16* QKV = (bf16*)(ws + WS_QKV); bf16* HB = (bf16*)(ws + WS_BIG); \
    bf16* OB = (bf16*)(ws + WS_BIG + BIG_OB); bf16* OG = (bf16*)(ws + WS_BIG + BIG_OG); float* LSE = (float*)(ws + WS_BIG + BIG_LSE); \
    bf16* QA = QKV; bf16* KA = QKV + (size_t)MTOK * 2048; bf16* VA = KA + (size_t)MTOK * 512;
struct Args { const float* in[20]; float* out; unsigned char* ws; };
__global__ void __launch_bounds__(NWAVES * 64, 2) fwd_kernel(Args args) {
    extern __shared__ __attribute__((aligned(16))) unsigned char lds[];
    LAS unsigned char* ldsl = (LAS unsigned char*)lds;
    volatile LAS unsigned* MISC = (volatile LAS unsigned*)(ldsl + MISC_OFF);
    const int wave = __builtin_amdgcn_readfirstlane(threadIdx.x >> 6);
#define OPQ_LANE int lane, G = G_k, bx = bx_k; asm volatile("v_mbcnt_lo_u32_b32 %0, -1, 0\n\tv_mbcnt_hi_u32_b32 %0, -1, %0" : "=v"(lane)); asm volatile("" : "+s"(G), "+s"(bx)); const int tid = wave * 64 + lane; const int gw = bx * NWAVES + wave, NGW = G * NWAVES; LAS float* tscr = (LAS float*)(ldsl + wave * 16384)
    const int G_k = gridDim.x, bx_k = blockIdx.x;
    for (int u = threadIdx.x; u < (LDS_BYTES - LDSCTL_OFF) / 4; u += NWAVES * 64) ((LAS unsigned*)(ldsl + LDSCTL_OFF))[u] = 0u;
    __syncthreads();
    XcdBarrier bar = xcd_barrier_post((unsigned*)(args.ws + WS_CTL) + CW_BAR, MISC + 8);
#define GRID_BAR() do { XcdBarrier b2_ = bar; unsigned long long bp_ = (unsigned long long)bar.bar; asm volatile("" : "+s"(bp_), "+s"(b2_.x)); b2_.bar = (unsigned*)(GAS unsigned*)bp_; xcd_barrier(b2_); } while (0)


    if constexpr (PH(0))
    { OPQ_LANE; PHASE_PTRS;
        for (int e = bx * 512 + tid; e < SEQ * 64; e += G * 512) {
            const int t = e >> 6, i = e & 63;
            const double inv = exp2(-(double)i * (13.287712379549449 / 64.0));
            const double a = (double)t * inv, rev = a * 0.15915494309189535; const float fr = (float)(rev - floor(rev));
            COS1[e] = __builtin_amdgcn_cosf(fr); SIN1[e] = __builtin_amdgcn_sinf(fr);
        }
        for (int e = bx * 512 + tid; e < 320 * 32; e += G * 512) {
            const int p = e >> 5, i = e & 31; const int pos = p < 256 ? p : p - 256;
            const double inv = exp2(-(double)i * (13.287712379549449 / 32.0));
            const double a = (double)pos * inv, rev = a * 0.15915494309189535; const float fr = (float)(rev - floor(rev));
            const float c = __builtin_amdgcn_cosf(fr), s = __builtin_amdgcn_sinf(fr);
            if (p < 256) { AXT[p * 32 + i] = c; AXT[8192 + p * 32 + i] = s; } else { AXT[16384 + pos * 32 + i] = c; AXT[16384 + 2048 + pos * 32 + i] = s; }
        }
        for (int r = gw; r < DEPTH * MEMR; r += NGW) { const int l = r / MEMR, m = r % MEMR;
            const float* src = m < 256 ? mem_prompt + (size_t)m * DM : mem_sample + (size_t)(m - 256) * DM;
            rms_row_bf16(src, norm_mem + l * DM, MEMN + (size_t)r * DM, nullptr, lane); }
        for (int l = 0; l < DEPTH; ++l) transpose_all(c_wkv + (size_t)l * DM * 1024, nullptr, DM, 1024, CKVT + (size_t)l * 1024 * DM, tscr, gw, NGW, lane);
    }

    for (int layer = 0; layer < DEPTH; ++layer) {
        const int j = layer >> 1; const bool isA = (layer & 1) == 0;
        if constexpr (PH(1))
        { OPQ_LANE; PHASE_PTRS;
            REPS(3) {
            const float* gmix = norm_mix + layer * DM;
            if (isA) { transpose_all(a_wqkv + (size_t)j * DM * 3072, gmix, DM, 3072, WQKV, tscr, gw, NGW, lane, 0, true); transpose_all(a_wo + (size_t)j * DM * DM, nullptr, DM, DM, WO, tscr, gw, NGW, lane); }
            else { transpose_all(b_wqkv + (size_t)j * DM * 9216, gmix, DM, 9216, WQKV, tscr, gw, NGW, lane, 6144, true); transpose_all(b_wo + (size_t)j * 1024 * DM, nullptr, 1024, DM, WO, tscr, gw, NGW, lane); }
            transpose_all(c_wq + (size_t)layer * DM * 512, norm_cross + layer * DM, DM, 512, CWQ, tscr, gw, NGW, lane, 0, true);
            transpose_all(c_wo + (size_t)layer * 512 * DM, nullptr, 512, DM, CWO, tscr, gw, NGW, lane);
            transpose_all(w_up + (size_t)layer * DM * DFF, norm_mlp + layer * DM, DM, DFF, WUP, tscr, gw, NGW, lane, 0, true);
            transpose_all(w_down + (size_t)layer * DFF * DM, nullptr, DFF, DM, WDN, tscr, gw, NGW, lane);
            if (layer == 0) {
                for (int m = gw; m < MTOK; m += NGW) { const float* src = m < SEQ ? x_prompt + (size_t)m * DM : x_sample + (size_t)(m - SEQ) * DM;
                    prep_row(src, HN + (size_t)m * DM, SS + m, lane); }
            }
            GRID_BAR(); }
        }
        if (isA) {
            if constexpr (PH(3))
            { OPQ_LANE; PHASE_PTRS; pg8::Gemm g{HN, WQKV, MTOK, 3072, DM}; pg8::RepOrder S; S.init(MTOK, 3072, G, bx, WGM_QKVA); S.reps = (EXPN == 11) ? 2 : 1;
              pg8::EpiB<1> E{QA, 2048, 1, KA, VA, SS + (size_t)(3 * layer) * MTOK, nullptr, nullptr};
              pg8::gemm_phase<pg8::EpiB<1>, pg8::RepOrder, GM_ALIGN, GM_SP2, true>(ldsl, g, S, E, tid); GRID_BAR(); }
            if constexpr (PH(4))
            { OPQ_LANE; PHASE_PTRS;
                const float* qg = a_q_gain + j * HD; const float* kg = a_k_gain + j * HD;
                const int jl = lane & 15, sub = lane >> 4;
                const long nq = (long)MTOK * 16, nk = (long)MTOK * 4;
                for (long hr4 = nq / 4 + gw; hr4 < (nq + nk) / 4; hr4 += NGW) {
                    long hr = hr4 * 4 + sub; const bool isq = hr < nq; bf16* p; int tok; const float* gp;
                    if (isq) { p = QA + hr * 128; tok = (int)(hr >> 4); gp = qg; } else { hr -= nq; p = KA + hr * 128; tok = (int)(hr >> 2); gp = kg; }
                    const int t = tok & (SEQ - 1), prow = t >> 6, pcol = t & 63;
                    const us8 raw = *(const GAS us8*)(p + jl * 8);
                    float v[8]; float ss = 0.f;
#pragma unroll
                    for (int e = 0; e < 8; ++e) { v[e] = bf2f(raw[e]); ss += v[e] * v[e]; }
                    ss += shflx(ss, 1, lane); ss += shflx(ss, 2, lane); ss += shflx(ss, 4, lane); ss += shflx(ss, 8, lane);
                    const float rstd = 1.0f / sqrtf(ss * (1.f / 128.f) + EPS);
                    const float* ct = (jl < 8) ? AXT + prow * 32 + (jl & 3) * 8 : AXT + 16384 + pcol * 32 + (jl & 3) * 8;
                    const float* st = ct + ((jl < 8) ? 8192 : 2048);
                    const f32x4 g0 = *(const GAS f32x4*)(gp + jl * 8), g1 = *(const GAS f32x4*)(gp + jl * 8 + 4);
                    const f32x4 c0 = *(const GAS f32x4*)ct, c1 = *(const GAS f32x4*)(ct + 4), s0 = *(const GAS f32x4*)st, s1 = *(const GAS f32x4*)(st + 4);
                    const float sgn = (jl & 4) ? 1.f : -1.f;
                    float o[8];
#pragma unroll
                    for (int e = 0; e < 8; ++e) { const float y = v[e] * rstd * (e < 4 ? g0[e] : g1[e - 4]); const float pr = shflx(y, 4, lane);
                        const float c = e < 4 ? c0[e] : c1[e - 4], s = e < 4 ? s0[e] : s1[e - 4]; o[e] = y * c + sgn * pr * s; }
                    v4u w; w.x = pk2(o[0], o[1]); w.y = pk2(o[2], o[3]); w.z = pk2(o[4], o[5]); w.w = pk2(o[6], o[7]);
                    *(GAS v4u*)(p + jl * 8) = w;
                }
                GRID_BAR();
            }
            if constexpr (PH(5))
            { OPQ_LANE; PHASE_PTRS;
                float gqm = 0.f, gkm = 0.f;
                for (int d = 0; d < HD; ++d) { gqm = fmaxf(gqm, fabsf(a_q_gain[j * HD + d])); gkm = fmaxf(gkm, fabsf(a_k_gain[j * HD + d])); }
                const float bnd = gqm * gkm * (128.f * da::CQ * 1.02f) + 0.5f;
                REPS(1) {
                for (int u = bx; u < NSEQ * 16 * 64; u += G) {
                    const int qb = u & 63, hg = (u >> 6) & 3, kvh = (u >> 8) & 3, b = u >> 10, h = kvh * 4 + hg;
                    const size_t qoff = ((size_t)b * SEQ + (size_t)qb * 256) * 2048 + h * 128;
                    const bf16* Kh = KA + (size_t)b * SEQ * 512 + kvh * 128; const bf16* Vh = VA + (size_t)b * SEQ * 512 + kvh * 128;
                    da::attn_dense_stg<2048, 512, 2048>(QA + qoff, Kh, Vh, HB + qoff, SEQ, (char*)lds, ldsl, wave, a_q_gain + j * HD, AXT, qb * 256, bnd);
                }
                GRID_BAR(); }
            }
            if constexpr (PH(6))
            { OPQ_LANE; PHASE_PTRS; pg8::Gemm g{HB, WO, MTOK, DM, DM}; pg8::StaticOrder S; S.init(MTOK, DM, G, bx);
              pg8::EpiRes E{HN, SS + (size_t)(3 * layer + 1) * MTOK, DM, 0};
              pg8::gemm_phase<pg8::EpiRes, pg8::StaticOrder, GM_ALIGN, GM_SP2>(ldsl, g, S, E, tid); GRID_BAR(); }
        } else {
            for (int sq = 0; sq <= NSEQ; ++sq) {
                if constexpr (PH(7)) if (sq < NSEQ)
                { OPQ_LANE; PHASE_PTRS; pg8::Gemm g{HN + (size_t)sq * SEQ * DM, WQKV, SEQ, 9216, DM}; pg8::RepOrder S; S.init(SEQ, 9216, G, bx, WGM_QKVB); S.reps = (EXPN == 10) ? 2 : 1;
                  pg8::EpiB<2> E{QKV, 1024, 1, nullptr, nullptr, SS + (size_t)(3 * layer) * MTOK + (size_t)sq * SEQ, COS1, SIN1};
                  pg8::gemm_phase<pg8::EpiB<2>, pg8::RepOrder, GM_ALIGN, GM_SP2, true>(ldsl, g, S, E, tid); }
                if constexpr (PH(10)) if (sq > 0)
                { OPQ_LANE; PHASE_PTRS;
                    const int jl = lane & 15, sub = lane >> 4;
                    REPS(7) {
                    for (int r4 = gw; r4 < SEQ * 8 / 4; r4 += NGW) {
                        const int rr = r4 * 4 + sub, t = rr >> 3, h = rr & 7;
                        float ls[3]; us8 ov[3];
#pragma unroll
                        for (int g = 0; g < 3; ++g) { const int shift = 2 * g; const int pp = ((t & ((1 << shift) - 1)) << (14 - shift)) + (t >> shift);
                            ls[g] = LSE[(size_t)g * SEQ * 8 + (size_t)pp * 8 + h]; ov[g] = *(const GAS us8*)(OG + (size_t)g * SEQ * 1024 + (size_t)pp * 1024 + h * 128 + jl * 8); }
                        const float mx = fmaxf(ls[0], fmaxf(ls[1], ls[2]));
                        float w0 = __expf(ls[0] - mx), w1 = __expf(ls[1] - mx), w2 = __expf(ls[2] - mx); const float inv = 1.f / (w0 + w1 + w2); w0 *= inv; w1 *= inv; w2 *= inv;
                        float o[8];
#pragma unroll
                        for (int e = 0; e < 8; ++e) o[e] = w0 * bf2f(ov[0][e]) + w1 * bf2f(ov[1][e]) + w2 * bf2f(ov[2][e]);
                        v4u w; w.x = pk2(o[0], o[1]); w.y = pk2(o[2], o[3]); w.z = pk2(o[4], o[5]); w.w = pk2(o[6], o[7]);
                        *(GAS v4u*)(OB + ((size_t)(sq - 1) * SEQ + t) * 1024 + h * 128 + jl * 8) = w;
                    }
                    }
                }
                { OPQ_LANE; GRID_BAR(); }
                if constexpr (PH(9)) if (sq < NSEQ)
                { OPQ_LANE; PHASE_PTRS;
                    REPS(4) {
                    for (int u = bx; u < 3 * 8 * (SEQ / 256); u += G) {
                        const int blkq = u & 63, gh = u >> 6, g = gh >> 3, h = gh & 7, q0 = blkq * 256;
                        const int seglen = SEQ >> (2 * g), seg_lo = q0 & ~(seglen - 1), seg_hi = seg_lo + seglen;
                        const size_t blk = (size_t)SEQ * 1024;
                        const int u2 = u + G; const bool hasn = u2 < 3 * 8 * (SEQ / 256);
                        const int blkq2 = u2 & 63, gh2 = u2 >> 6, g2 = hasn ? (gh2 >> 3) : g, h2 = gh2 & 7, q02 = blkq2 * 256;
                        const int seglen2 = SEQ >> (2 * g2), seg_lo2 = q02 & ~(seglen2 - 1), seg_hi2 = seg_lo2 + seglen2;
                        ba::battn_wg_unit(QKV + (size_t)g * blk, QKV + (size_t)(3 + g) * blk, QKV + (size_t)(6 + g) * blk, OG + (size_t)g * blk, LSE + (size_t)g * SEQ * 8,
                                          q0, seg_lo, seg_hi, h, (char*)lds, ldsl, wave, u != bx, hasn, QKV + (size_t)(3 + g2) * blk, QKV + (size_t)(6 + g2) * blk, q02, seg_lo2, seg_hi2, h2);
                    }
                    GRID_BAR(); }
                }
            }
            if constexpr (PH(11))
            { OPQ_LANE; PHASE_PTRS; pg8::Gemm g{OB, WO, MTOK, DM, 1024}; pg8::StaticOrder S; S.init(MTOK, DM, G, bx);
              pg8::EpiRes E{HN, SS + (size_t)(3 * layer + 1) * MTOK, DM, 0};
              pg8::gemm_phase<pg8::EpiRes, pg8::StaticOrder, GM_ALIGN, GM_SP2>(ldsl, g, S, E, tid); GRID_BAR(); }
        }
        if constexpr (PH(13))
        { OPQ_LANE; PHASE_PTRS; pg8::Gemm g{HN, CWQ, MTOK, 512, DM}; pg8::StaticOrder S; S.init(MTOK, 512, G, bx);
          pg8::EpiB<0> E{QKV, 512, 1 << 20, nullptr, nullptr, SS + (size_t)(3 * layer + 1) * MTOK, nullptr, nullptr};
          pg8::gemm_phase<pg8::EpiB<0>, pg8::StaticOrder, GM_ALIGN, GM_SP2, true>(ldsl, g, S, E, tid);
          if (PH(2) && layer == 0 && bx >= 128) {
            pg8::Gemm g2{MEMN, CKVT, DEPTH * MEMR, DEPTH * 1024, DM}; pg8::GroupedOrder S2; S2.init(128, bx - 128);
            pg8::EpiB<0> E2{CKV, 1024, 4, nullptr, nullptr, nullptr, nullptr, nullptr};
            pg8::gemm_phase<pg8::EpiB<0>, pg8::GroupedOrder, GM_ALIGN, GM_SP2>(ldsl, g2, S2, E2, tid); }
          GRID_BAR(); }
        if constexpr (PH(14))
        { OPQ_LANE; PHASE_PTRS;
            const bf16* ckv = CKV + (size_t)layer * MEMR * 1024;
            REPS(2) {
            for (int u = bx; u < NSEQ * 4 * 64; u += G) {
                const int qb = u & 63, h = (u >> 6) & 3, b = u >> 8;
                const size_t qoff = ((size_t)b * SEQ + (size_t)qb * 256) * 512 + h * 128;
                const bf16* Kh = ckv + (size_t)b * 256 * 1024 + h * 128; const bf16* Vh = Kh + 512;
                da::attn_dense_body<512, 1024, 512, false>(QKV + qoff, Kh, Vh, HB + qoff, 256, (char*)lds, ldsl, wave);
            }
            GRID_BAR(); }
        }
        if constexpr (PH(15))
        { OPQ_LANE; PHASE_PTRS; pg8::Gemm g{HB, CWO, MTOK, DM, 512}; pg8::StaticOrder S; S.init(MTOK, DM, G, bx);
          pg8::EpiRes E{HN, SS + (size_t)(3 * layer + 2) * MTOK, DM, 0};
          pg8::gemm_phase<pg8::EpiRes, pg8::StaticOrder, GM_ALIGN, GM_SP2>(ldsl, g, S, E, tid); GRID_BAR(); }
        for (int ch = 0; ch <= MTOK / MLPC; ++ch) {
            if constexpr (PH(18)) if (ch > 0)
            { OPQ_LANE; PHASE_PTRS; const int c = ch - 1; pg8::Gemm g{HB + (size_t)(c & 1) * MLPC * DFF, WDN, MLPC, DM, DFF}; pg8::StaticOrder S; S.init(MLPC, DM, G, bx);
              if (EXPN == 6) {
                  pg8::EpiRes E2{(bf16*)(ws + WS_END + 64 * MiB), (unsigned long long*)(ws + WS_END + 96 * MiB), DM, 0};
                  pg8::gemm_phase<pg8::EpiRes, pg8::StaticOrder, GM_ALIGN, GM_SP2>(ldsl, g, S, E2, tid); }
              pg8::EpiRes E{HN, SS + (size_t)(3 * layer + 3) * MTOK, DM, c * MLPC};
              pg8::gemm_phase<pg8::EpiRes, pg8::StaticOrder, GM_ALIGN, GM_SP2>(ldsl, g, S, E, tid); }
            if constexpr (PH(17)) if (ch < MTOK / MLPC)
            { OPQ_LANE; PHASE_PTRS; pg8::Gemm g{HN + (size_t)ch * MLPC * DM, WUP, MLPC, DFF, DM}; pg8::RepOrder S; S.init(MLPC, DFF, G, bx); S.reps = (EXPN == 5) ? 2 : 1;
              pg8::EpiB<3> E{HB + (size_t)(ch & 1) * MLPC * DFF, DFF, 1 << 20, nullptr, nullptr, SS + (size_t)(3 * layer + 2) * MTOK + (size_t)ch * MLPC, nullptr, nullptr};
              pg8::gemm_phase<pg8::EpiB<3>, pg8::RepOrder, GM_ALIGN, GM_SP2, true>(ldsl, g, S, E, tid); }
            GRID_BAR();
        }
    }
    if constexpr (PH(19)) { OPQ_LANE; PHASE_PTRS;
    for (int m = gw; m < MTOK; m += NGW) final_row(HN + (size_t)m * DM, X + (size_t)m * DM, final_norm, SS + (size_t)12 * MTOK + m, lane); }
}

extern "C" void kernel_launch(void* const* d_in, const int* in_sizes, int n_in, void* d_out, int out_size, void* d_ws, size_t ws_size, hipStream_t stream) {
    static int grid = 0;
    if (grid == 0) {
        if (n_in != 20 || out_size != MTOK * DM || ws_size < WS_END) { fprintf(stderr, "kernel_launch: unexpected shapes: n_in %d out %d ws %zu (need %zu)\n", n_in, out_size, ws_size, (size_t)WS_END); grid = -1; return; }
        int dev = 0, cus = 0, per_cu = 0;
        if (hipGetDevice(&dev) != hipSuccess || hipDeviceGetAttribute(&cus, hipDeviceAttributeMultiprocessorCount, dev) != hipSuccess) { grid = -1; return; }
        if (hipFuncSetAttribute((const void*)fwd_kernel, hipFuncAttributeMaxDynamicSharedMemorySize, LDS_BYTES) != hipSuccess) { fprintf(stderr, "kernel_launch: hipFuncSetAttribute failed\n"); grid = -1; return; }
        if (hipOccupancyMaxActiveBlocksPerMultiprocessor(&per_cu, (const void*)fwd_kernel, NWAVES * 64, LDS_BYTES) != hipSuccess || per_cu < 1)
            fprintf(stderr, "kernel_launch: note: occupancy query reports %d workgroups per CU\n", per_cu);
        (void)hipGetLastError();
        grid = cus;
    }
    if (grid < 0) return;
    if (hipMemsetAsync((char*)d_ws + WS_CTL, 0, CTL_ZERO_BYTES, stream) != hipSuccess) { fprintf(stderr, "kernel_launch: memset failed\n"); return; }
    Args a{};
    for (int i = 0; i < 20; ++i) a.in[i] = (const float*)d_in[i];
    a.out = (float*)d_out; a.ws = (unsigned char*)d_ws;
    hipLaunchKernelGGL(fwd_kernel, dim3(grid), dim3(NWAVES * 64), LDS_BYTES, stream, a);
    const hipError_t le = hipPeekAtLastError();
    if (le != hipSuccess) fprintf(stderr, "kernel_launch: launch failed: %s\n", hipGetErrorName(le));
}
```

```cpp
#include <hip/hip_runtime.h>
#include <cstdio>
#include <cstdint>
namespace pg8 {
#define PG8_LAS __attribute__((address_space(3)))
typedef unsigned short bf16_t;
typedef short bf16x8 __attribute__((ext_vector_type(8)));
typedef float f32x4 __attribute__((ext_vector_type(4)));
typedef unsigned u32x4 __attribute__((ext_vector_type(4)));
constexpr int BM = 256, BK = 64, HALF = 128, HTB = HALF * BK * 2  , STAGE_BYTES = 8 * HTB, NXCD = 8, WGM = 4;

__host__ __device__ __forceinline__ int lds_byte(int r, int c) { const int st = (r >> 4) * 2 + (c >> 5), rr = r & 15, cc = c & 31, ob = rr * 64 + cc * 2; return st * 1024 + (ob ^ (((ob >> 9) & 1) << 5)); }
__host__ __device__ __forceinline__ void stage_rc(int b, int& R, int& C) { const int st = b / 1024, sb = b % 1024, swz = sb ^ (((sb >> 9) & 1) << 5); R = (st >> 1) * 16 + swz / 64; C = (st & 1) * 32 + (swz % 64) / 2; }
__host__ __device__ __forceinline__ int perm32(int rho) { const int n = rho >> 4, i = rho & 15; return 8 * (i >> 2) + 4 * n + (i & 3); }

struct Unit { int pm, pn; };
struct Gemm { const bf16_t* A; const bf16_t* Bt; int M, N, K; };

struct StaticOrder {
    int nM, nN, nwg, G, c, wgm;
    __host__ __device__ void init(int M, int N, int G_, int c_, int wgm_ = WGM) { nM = M / BM; nN = N / BM; nwg = nM * nN; G = G_; c = c_; wgm = wgm_; }
    __host__ __device__ bool next(int i, Unit& u) const {
        const long L = (long)i * G + c; if (L >= nwg) return false;
        int wgid = (int)L; { const int q = nwg / NXCD, r = nwg % NXCD, xcd = wgid % NXCD, off = wgid / NXCD; wgid = (xcd < r ? xcd * (q + 1) : r * (q + 1) + (xcd - r) * q) + off; }
        const int nig = wgm * nN, gid = wgid / nig, fm = gid * wgm, gsz = (nM - fm) < wgm ? (nM - fm) : wgm;
        u.pm = fm + ((wgid % nig) % gsz); u.pn = (wgid % nig) / gsz; return true;
    }
    __device__ __forceinline__ void a_ready(const Unit&) const {}
    __device__ __forceinline__ void done(const Unit&) const {}
};

__device__ __forceinline__ unsigned cvt_pk_bf16(float lo, float hi) { unsigned r; asm volatile("v_cvt_pk_bf16_f32 %0, %1, %2" : "=v"(r) : "v"(lo), "v"(hi)); return r; }
typedef float f32x2 __attribute__((ext_vector_type(2)));
__device__ __forceinline__ f32x2 gelu_pk(f32x2 v) {
    const f32x2 av = __builtin_elementwise_abs(v), d = av * 0.2316418882f + 1.0f;
    f32x2 t; t.x = __builtin_amdgcn_rcpf(d.x); t.y = __builtin_amdgcn_rcpf(d.y);
    f32x2 q = t * 0.5307027145f + (-0.7265760135f); q = q * t + 0.7107068705f; q = q * t + (-0.142248368f); q = q * t + 0.127414796f; q = q * t;
    const f32x2 s = (v * v) * (-0.72134752044f);
    f32x2 e; e.x = __builtin_amdgcn_exp2f(s.x); e.y = __builtin_amdgcn_exp2f(s.y);
    const f32x2 m = v * (q * e), r = v - m;
    f32x2 o; o.x = v.x < 0.f ? m.x : r.x; o.y = v.y < 0.f ? m.y : r.y; return o;
}

template <int ACT  > struct EpiBf16 {
    static constexpr bool PERM = true, AFTER_DRAIN = false; static_assert(ACT == 0 || ACT == 1, "EpiBf16: ACT is 0 (none) or 1 (gelu_pk)");
    bf16_t* O; int ldc; const float* bias; int split_cols; size_t split_stride; float scale0;
    __device__ __forceinline__ void operator()(const f32x4 (&acc)[2][2][4][2], const Unit& u, int wr, int wc, int fr, int fq) const {
        const int row0 = u.pm * BM + wr * 64 + fr; int colt = u.pn * BM; bf16_t* base = O;
        float sc = 1.f; if (split_cols) { const int t = colt / split_cols; base += (size_t)t * split_stride; colt -= t * split_cols; if (t == 0) sc = scale0; }
        const int col0 = colt + wc * 32 + 8 * fq, bcol0 = u.pn * BM + wc * 32 + 8 * fq;
        f32x4 bv[2][2];
#pragma unroll
        for (int bj = 0; bj < 2; ++bj)
#pragma unroll
            for (int n = 0; n < 2; ++n) bv[bj][n] = bias ? *(const f32x4*)(bias + bcol0 + bj * HALF + 4 * n) : (f32x4){0.f, 0.f, 0.f, 0.f};
#pragma unroll
        for (int ai = 0; ai < 2; ++ai)
#pragma unroll
            for (int m = 0; m < 4; ++m) { bf16_t* rowp = base + (size_t)(row0 + ai * HALF + m * 16) * ldc + col0;
#pragma unroll
                for (int bj = 0; bj < 2; ++bj) { f32x4 v0 = acc[ai][bj][m][0] + bv[bj][0], v1 = acc[ai][bj][m][1] + bv[bj][1];
                    if (ACT == 1) { f32x2 a = gelu_pk((f32x2){v0[0], v0[1]}), b = gelu_pk((f32x2){v0[2], v0[3]}), c = gelu_pk((f32x2){v1[0], v1[1]}), d = gelu_pk((f32x2){v1[2], v1[3]});
                        v0 = (f32x4){a.x, a.y, b.x, b.y}; v1 = (f32x4){c.x, c.y, d.x, d.y}; }
                    v0 = v0 * sc; v1 = v1 * sc; u32x4 w; w.x = cvt_pk_bf16(v0[0], v0[1]); w.y = cvt_pk_bf16(v0[2], v0[3]); w.z = cvt_pk_bf16(v1[0], v1[1]); w.w = cvt_pk_bf16(v1[2], v1[3]);
                    *(u32x4*)(rowp + bj * HALF) = w; } }
    }
};

template <int MODE> struct EpiB {
    static constexpr bool PERM = true, AFTER_DRAIN = false;
    bf16_t* O; int ldc; int pn_mod; bf16_t* O2; bf16_t* O3;
    const unsigned long long* SS;
    const float* cs; const float* sn;
    __device__ __forceinline__ void operator()(const f32x4 (&acc)[2][2][4][2], const Unit& u, int wr, int wc, int fr, int fq) const {
        const int row0 = u.pm * BM + wr * 64 + fr;
        bf16_t* base = O; int ld = ldc, colt = 0, shift = 0, which = 2;
        if constexpr (MODE == 0 || MODE == 3) { colt = (u.pn % pn_mod) * BM; }
        if constexpr (MODE == 1) {
            if (u.pn < 8) { base = O; ld = 2048; colt = u.pn * BM; }
            else if (u.pn < 10) { base = O2; ld = 512; colt = (u.pn - 8) * BM; }
            else { base = O3; ld = 512; colt = (u.pn - 10) * BM; }
        }
        if constexpr (MODE == 2) {
            which = u.pn / 12; const int g = (u.pn % 12) / 4; colt = (u.pn % 4) * BM; ld = 1024; shift = 2 * g;
            base = O + (size_t)(which * 3 + g) * ((size_t)16384 * 1024);
        }
        const int col0 = colt + wc * 32 + 8 * fq;
        const int rcol = colt + (wc >> 1) * 128 + (wc & 1) * 32 + 8 * fq, rdim = (wc & 1) * 32 + 8 * fq;
#pragma unroll
        for (int ai = 0; ai < 2; ++ai)
#pragma unroll
            for (int m = 0; m < 4; ++m) {
                int r = row0 + ai * HALF + m * 16;
                float rs = 1.f;
                if (SS) rs = __builtin_amdgcn_rsqf((float)SS[r] * (1.0f / (1048576.f * 2048.f)) + 1e-6f);
                const int t = r;
                if constexpr (MODE == 2) r = ((r & ((1 << shift) - 1)) << (14 - shift)) + (r >> shift);
                if (MODE == 2 && which < 2) {
                    const f32x4 c0 = *(const f32x4*)(cs + t * 64 + rdim), c1 = *(const f32x4*)(cs + t * 64 + rdim + 4), s0 = *(const f32x4*)(sn + t * 64 + rdim), s1 = *(const f32x4*)(sn + t * 64 + rdim + 4);
                    const f32x4 l0 = acc[ai][0][m][0] * rs, l1 = acc[ai][0][m][1] * rs, h0 = acc[ai][1][m][0] * rs, h1 = acc[ai][1][m][1] * rs;
                    const f32x4 ol0 = l0 * c0 - h0 * s0, ol1 = l1 * c1 - h1 * s1, oh0 = h0 * c0 + l0 * s0, oh1 = h1 * c1 + l1 * s1;
                    bf16_t* rowp = base + (size_t)r * ld + rcol;
                    u32x4 w; w.x = cvt_pk_bf16(ol0[0], ol0[1]); w.y = cvt_pk_bf16(ol0[2], ol0[3]); w.z = cvt_pk_bf16(ol1[0], ol1[1]); w.w = cvt_pk_bf16(ol1[2], ol1[3]);
                    *(u32x4*)rowp = w;
                    w.x = cvt_pk_bf16(oh0[0], oh0[1]); w.y = cvt_pk_bf16(oh0[2], oh0[3]); w.z = cvt_pk_bf16(oh1[0], oh1[1]); w.w = cvt_pk_bf16(oh1[2], oh1[3]);
                    *(u32x4*)(rowp + 64) = w;
                } else {
                bf16_t* rowp = base + (size_t)r * ld + col0;
#pragma unroll
                for (int bj = 0; bj < 2; ++bj) { f32x4 v0 = acc[ai][bj][m][0] * rs, v1 = acc[ai][bj][m][1] * rs;
                    if constexpr (MODE == 3) {
#pragma unroll
                        for (int e = 0; e < 4; ++e) { const float a = fmaxf(v0[e], 0.f), b = fmaxf(v1[e], 0.f); v0[e] = a * a; v1[e] = b * b; }
                    }
                    u32x4 w; w.x = cvt_pk_bf16(v0[0], v0[1]); w.y = cvt_pk_bf16(v0[2], v0[3]); w.z = cvt_pk_bf16(v1[0], v1[1]); w.w = cvt_pk_bf16(v1[2], v1[3]);
                    *(u32x4*)(rowp + bj * HALF) = w; }
                }
            }
    }
};
typedef _Float16 half2v __attribute__((ext_vector_type(2)));
__device__ __forceinline__ unsigned pk_half(float lo, float hi) { const half2v v = {(_Float16)lo, (_Float16)hi}; return __builtin_bit_cast(unsigned, v); }
struct EpiRes {
    static constexpr bool PERM = true, AFTER_DRAIN = false;
    bf16_t* XB; unsigned long long* SS; int ldc; int row_off;
    __device__ __forceinline__ void operator()(const f32x4 (&acc)[2][2][4][2], const Unit& u, int wr, int wc, int fr, int fq) const {
        const int row0 = row_off + u.pm * BM + wr * 64 + fr, col0 = u.pn * BM + wc * 32 + 8 * fq;
        const int lane = fq * 16 + fr;
#pragma unroll
        for (int ai = 0; ai < 2; ++ai)
#pragma unroll
            for (int m = 0; m < 4; ++m) { const int row = row0 + ai * HALF + m * 16; bf16_t* rowb = XB + (size_t)row * ldc + col0;
                u32x4 xo[2];
#pragma unroll
                for (int bj = 0; bj < 2; ++bj) xo[bj] = *(const u32x4*)(rowb + bj * HALF);
                float s = 0.f;
#pragma unroll
                for (int bj = 0; bj < 2; ++bj) { float v[8];
#pragma unroll
                    for (int e = 0; e < 4; ++e) { const unsigned wv = xo[bj][e]; const half2v h = __builtin_bit_cast(half2v, wv);
                        v[2 * e] = (float)h[0] + acc[ai][bj][m][e >> 1][(2 * e) & 3];
                        v[2 * e + 1] = (float)h[1] + acc[ai][bj][m][e >> 1][(2 * e + 1) & 3]; }
#pragma unroll
                    for (int e = 0; e < 8; ++e) s += v[e] * v[e];
                    u32x4 w; w.x = pk_half(v[0], v[1]); w.y = pk_half(v[2], v[3]); w.z = pk_half(v[4], v[5]); w.w = pk_half(v[6], v[7]);
                    *(u32x4*)(rowb + bj * HALF) = w; }
                s += __builtin_bit_cast(float, __builtin_amdgcn_ds_bpermute((lane ^ 16) << 2, __builtin_bit_cast(int, s)));
                s += __builtin_bit_cast(float, __builtin_amdgcn_ds_bpermute((lane ^ 32) << 2, __builtin_bit_cast(int, s)));
                if (fq == 0) __hip_atomic_fetch_add(SS + row, (unsigned long long)(s * 1048576.f + 0.5f), __ATOMIC_RELAXED, __HIP_MEMORY_SCOPE_AGENT); }
    }
};
struct GroupedOrder {
    int G, c;
    __host__ __device__ void init(int G_, int c_) { G = G_; c = c_; }
    __host__ __device__ bool next(int i, Unit& u) const {
        const int L = i * G + c; if (L >= 48) return false;
        const int layer = L / 12, rem = L % 12; u.pm = layer * 3 + rem % 3; u.pn = layer * 4 + rem / 3; return true;
    }
    __device__ __forceinline__ void a_ready(const Unit&) const {}
    __device__ __forceinline__ void done(const Unit&) const {}
};
struct RepOrder : StaticOrder {
    int reps;
    __host__ __device__ bool next(int i, Unit& u) const { const int rounds = nwg / G; if (i >= rounds * reps) return false; return StaticOrder::next(i % rounds, u); }
};
typedef _Float16 half8 __attribute__((ext_vector_type(8)));
template <class Epi, class Sched, bool ALIGN_EPI = false, bool SP2 = false, bool F16IN = false>
__device__ __forceinline__ void gemm_phase(PG8_LAS unsigned char* lds, const Gemm g, const Sched& S, const Epi& E, const int tid) {
    const int wid = __builtin_amdgcn_readfirstlane(tid >> 6), lane = tid & 63, wr = wid >> 2, wc = wid & 3, fr = lane & 15, fq = lane >> 4;
    const int K = g.K, nt = K / BK;
    unsigned voffA[2], voffB[2];
#pragma unroll
    for (int i = 0; i < 2; ++i) { int R, C; stage_rc(tid * 16 + i * 8192, R, C); const int Rb = Epi::PERM ? ((R & ~31) + perm32(R & 31)) : R;
        voffA[i] = (unsigned)(R * K + C) * 2u; voffB[i] = (unsigned)(Rb * K + C) * 2u; }
    const size_t kstep = (size_t)(BK * 2);
    const size_t hstep = (size_t)HALF * K * 2;
    const size_t tstep = 2 * hstep;
    const unsigned ldsw = (unsigned)wid * 1024u;
    const int aoff = lds_byte(wr * 64 + fr, fq * 8), boff = lds_byte(wc * 32 + fr, fq * 8);
#define PG8_SA(b, h) (((b) * 2 + (h)) * HTB)
#define PG8_SB(b, h) ((4 + (b) * 2 + (h)) * HTB)
#define PG8_STAGE(bufoff, gbase, voff) do { unsigned long long gi_ = (unsigned long long)(gbase); asm volatile("" : "+s"(gi_)); const __attribute__((address_space(1))) char* gb_ = (const __attribute__((address_space(1))) char*)gi_; _Pragma("unroll") for (int _i = 0; _i < 2; ++_i) \
        __builtin_amdgcn_global_load_lds((const __attribute__((address_space(1))) unsigned*)(gb_ + (voff)[_i]), (PG8_LAS unsigned*)(lds + (bufoff) + ldsw + _i * 8192), 16, 0, 0); } while (0)
#define PG8_LDA(dst, b, h) do { _Pragma("unroll") for (int m = 0; m < 4; ++m) _Pragma("unroll") for (int k = 0; k < 2; ++k) dst[m][k] = *(const PG8_LAS bf16x8*)(lds + PG8_SA(b, h) + aoff + m * 2048 + k * 1024); } while (0)
#define PG8_LDB(dst, b, h) do { _Pragma("unroll") for (int n = 0; n < 2; ++n) _Pragma("unroll") for (int k = 0; k < 2; ++k) dst[n][k] = *(const PG8_LAS bf16x8*)(lds + PG8_SB(b, h) + boff + n * 2048 + k * 1024); } while (0)
#define PG8_MMAB(ai, bj, At, Bt) do { _Pragma("unroll") for (int n = 0; n < 2; ++n) _Pragma("unroll") for (int m = 0; m < 4; ++m) _Pragma("unroll") for (int k = 0; k < 2; ++k) \
        { if constexpr (F16IN) acc[ai][bj][m][n] = __builtin_amdgcn_mfma_f32_16x16x32_f16(__builtin_bit_cast(half8, Bt[n][k]), __builtin_bit_cast(half8, At[m][k]), acc[ai][bj][m][n], 0, 0, 0); \
          else acc[ai][bj][m][n] = __builtin_amdgcn_mfma_f32_16x16x32_bf16(Bt[n][k], At[m][k], acc[ai][bj][m][n], 0, 0, 0); __builtin_amdgcn_sched_barrier(0); } } while (0)
#define PG8_MMA(ai, bj, At, Bt) do { __builtin_amdgcn_s_setprio(1); PG8_MMAB(ai, bj, At, Bt); __builtin_amdgcn_s_setprio(0); } while (0)
#define PG8_MMA2(ai, At, Ba, Bb) do { __builtin_amdgcn_s_setprio(1); PG8_MMAB(ai, 0, At, Ba); PG8_MMAB(ai, 1, At, Bb); __builtin_amdgcn_s_setprio(0); } while (0)
#define PG8_WAIT_V(n) asm volatile("s_waitcnt vmcnt(" #n ")" ::: "memory")
#define PG8_WAIT_L(n) asm volatile("s_waitcnt lgkmcnt(" #n ")" ::: "memory")
#define PG8_BAR __builtin_amdgcn_s_barrier()
#define PG8_SCHED __builtin_amdgcn_sched_barrier(0)
    Unit cur, nxt; int ui = 0;
    if (!S.next(0, cur)) return;
    f32x4 acc[2][2][4][2];
#pragma unroll
    for (int a = 0; a < 2; ++a)
#pragma unroll
        for (int b = 0; b < 2; ++b)
#pragma unroll
            for (int m = 0; m < 4; ++m)
#pragma unroll
                for (int n = 0; n < 2; ++n) acc[a][b][m][n] = (f32x4){0.f, 0.f, 0.f, 0.f};
    bf16x8 At[4][2], B0[2][2], B1[2][2];
    const char* cA = (const char*)g.A + (size_t)cur.pm * tstep; const char* cB = (const char*)g.Bt + (size_t)cur.pn * tstep;
    S.a_ready(cur);
    if constexpr (SP2) {
        PG8_STAGE(PG8_SB(0, 0), cB, voffB); PG8_STAGE(PG8_SB(0, 1), cB + hstep, voffB); PG8_STAGE(PG8_SA(0, 0), cA, voffA); PG8_STAGE(PG8_SA(0, 1), cA + hstep, voffA);
        if (wr == 1) PG8_BAR;
        PG8_WAIT_V(2); PG8_BAR;
        PG8_STAGE(PG8_SB(1, 0), cB + kstep, voffB); PG8_STAGE(PG8_SA(1, 0), cA + kstep, voffA); PG8_STAGE(PG8_SB(1, 1), cB + hstep + kstep, voffB);
        PG8_WAIT_V(6); PG8_BAR;
    } else {
        PG8_STAGE(PG8_SB(0, 0), cB, voffB); PG8_STAGE(PG8_SA(0, 0), cA, voffA); PG8_STAGE(PG8_SB(0, 1), cB + hstep, voffB); PG8_STAGE(PG8_SA(0, 1), cA + hstep, voffA);
        if (wr == 1) PG8_BAR;
        PG8_WAIT_V(4); PG8_BAR;
        PG8_STAGE(PG8_SB(1, 0), cB + kstep, voffB); PG8_STAGE(PG8_SA(1, 0), cA + kstep, voffA); PG8_STAGE(PG8_SB(1, 1), cB + hstep + kstep, voffB);
        PG8_WAIT_V(6); PG8_BAR;
    }
    for (;;) {
        const bool has_next = S.next(ui + 1, nxt);
        const char* nA = has_next ? (const char*)g.A + (size_t)nxt.pm * tstep : cA; const char* nB = has_next ? (const char*)g.Bt + (size_t)nxt.pn * tstep : cB;
        for (int t = 0; t < nt; t += 2) {
            asm volatile("" : "+v"(voffA[0]), "+v"(voffA[1]), "+v"(voffB[0]), "+v"(voffB[1]));
            const bool last = (t == nt - 2);
            const char* a1 = cA + (size_t)(t + 1) * kstep;
            const char* a2 = last ? nA : cA + (size_t)(t + 2) * kstep; const char* b2 = last ? nB : cB + (size_t)(t + 2) * kstep;
            const char* a3 = a2 + kstep; const char* b3 = b2 + kstep;
            if (last && has_next) S.a_ready(nxt);
            if constexpr (SP2) {
            PG8_LDB(B0, 0, 0); PG8_LDB(B1, 0, 1); PG8_SCHED; PG8_LDA(At, 0, 0); PG8_STAGE(PG8_SA(1, 1), a1 + hstep, voffA);
            PG8_WAIT_V(8); PG8_WAIT_L(0); PG8_BAR; PG8_MMA2(0, At, B0, B1); PG8_BAR; PG8_SCHED;
            PG8_LDA(At, 0, 1); PG8_STAGE(PG8_SB(0, 0), b2, voffB); PG8_STAGE(PG8_SB(0, 1), b2 + hstep, voffB); PG8_STAGE(PG8_SA(0, 0), a2, voffA);
            PG8_WAIT_V(8); PG8_WAIT_L(0); PG8_BAR; PG8_MMA2(1, At, B0, B1); PG8_BAR; PG8_SCHED;
            PG8_LDB(B0, 1, 0); PG8_LDB(B1, 1, 1); PG8_SCHED; PG8_LDA(At, 1, 0); PG8_STAGE(PG8_SA(0, 1), a2 + hstep, voffA);
            PG8_WAIT_V(8); PG8_WAIT_L(0); PG8_BAR; PG8_MMA2(0, At, B0, B1); PG8_BAR; PG8_SCHED;
            PG8_LDA(At, 1, 1); PG8_STAGE(PG8_SB(1, 0), b3, voffB); PG8_STAGE(PG8_SB(1, 1), b3 + hstep, voffB); PG8_STAGE(PG8_SA(1, 0), a3, voffA);
            PG8_WAIT_V(8); PG8_WAIT_L(0); PG8_BAR; PG8_MMA2(1, At, B0, B1); PG8_BAR; PG8_SCHED;
            } else {
            PG8_LDB(B0, 0, 0); PG8_SCHED; PG8_LDA(At, 0, 0); PG8_STAGE(PG8_SA(1, 1), a1 + hstep, voffA);
            PG8_WAIT_L(8); PG8_BAR; PG8_WAIT_L(0); PG8_MMA(0, 0, At, B0); PG8_BAR; PG8_SCHED;
            PG8_LDB(B1, 0, 1); PG8_STAGE(PG8_SB(0, 0), b2, voffB);
            PG8_BAR; PG8_WAIT_L(0); PG8_MMA(0, 1, At, B1); PG8_BAR;
            PG8_LDA(At, 0, 1); PG8_STAGE(PG8_SA(0, 0), a2, voffA);
            PG8_BAR; PG8_WAIT_L(0); PG8_MMA(1, 0, At, B0); PG8_BAR; PG8_SCHED;
            PG8_STAGE(PG8_SB(0, 1), b2 + hstep, voffB);
            PG8_WAIT_V(6); PG8_BAR; PG8_MMA(1, 1, At, B1); PG8_BAR;
            PG8_LDB(B0, 1, 0); PG8_SCHED; PG8_LDA(At, 1, 0); PG8_STAGE(PG8_SA(0, 1), a2 + hstep, voffA);
            PG8_WAIT_L(8); PG8_BAR; PG8_WAIT_L(0); PG8_MMA(0, 0, At, B0); PG8_BAR; PG8_SCHED;
            PG8_LDB(B1, 1, 1); PG8_STAGE(PG8_SB(1, 0), b3, voffB);
            PG8_BAR; PG8_WAIT_L(0); PG8_MMA(0, 1, At, B1); PG8_BAR;
            PG8_LDA(At, 1, 1); PG8_STAGE(PG8_SA(1, 0), a3, voffA);
            PG8_BAR; PG8_WAIT_L(0); PG8_MMA(1, 0, At, B0); PG8_BAR; PG8_SCHED;
            PG8_STAGE(PG8_SB(1, 1), b3 + hstep, voffB);
            PG8_WAIT_V(6); PG8_BAR; PG8_MMA(1, 1, At, B1); PG8_BAR;
            }
        }
        if constexpr (ALIGN_EPI) { if (wr == 0) PG8_BAR; }
        if constexpr (!Epi::AFTER_DRAIN) { E(acc, cur, wr, wc, fr, fq); S.done(cur); }
        if (!has_next) break;
#pragma unroll
        for (int a = 0; a < 2; ++a)
#pragma unroll
            for (int b = 0; b < 2; ++b)
#pragma unroll
                for (int m = 0; m < 4; ++m)
#pragma unroll
                    for (int n = 0; n < 2; ++n) acc[a][b][m][n] = (f32x4){0.f, 0.f, 0.f, 0.f};
        cur = nxt; cA = nA; cB = nB; ++ui;
        if constexpr (ALIGN_EPI) { if (wr == 1) PG8_BAR; }
    }
    PG8_WAIT_V(0);
    if constexpr (!ALIGN_EPI) { if (wr == 0) PG8_BAR; }
    PG8_BAR;
    if constexpr (Epi::AFTER_DRAIN) { E.fused(acc, cur, wr, wc, fr, fq, lds, wid, lane); S.done(cur); }
#undef PG8_SA
#undef PG8_SB
#undef PG8_STAGE
#undef PG8_LDA
#undef PG8_LDB
#undef PG8_MMA
#undef PG8_MMAB
#undef PG8_MMA2
#undef PG8_WAIT_V
#undef PG8_WAIT_L
#undef PG8_BAR
#undef PG8_SCHED
}
}

namespace da {
using bf16 = unsigned short;
constexpr int   D = 128, NW = 8, QBLK = 32, KVBLK = 64;
constexpr float SCALE = 0.088388347648318440f;
constexpr float THR = 8.f;
constexpr size_t SHM_V = KVBLK * D * 2, SHM_K = KVBLK * D * 2, SHM_ATTN = 2 * SHM_V + 2 * SHM_K + NW * 64 * 4;
using bf16x8 = __attribute__((ext_vector_type(8))) short;
using s16x4  = __attribute__((ext_vector_type(4))) short;
using f32x16 = __attribute__((ext_vector_type(16))) float;
using u32x4  = __attribute__((ext_vector_type(4))) unsigned;
using f32x4v = __attribute__((ext_vector_type(4))) float;
#define KSWZ(row, colB) ((row) * 256 + ((colB) ^ (((row) & 7) << 4)))
#define SBAR() __builtin_amdgcn_sched_barrier(0)
__device__ __forceinline__ int crow(int r, int hi) { return (r & 3) + 8 * (r >> 2) + 4 * hi; }
__device__ __forceinline__ unsigned cvtpk(float lo, float hi) {
  unsigned r; asm volatile("v_cvt_pk_bf16_f32 %0, %1, %2" : "=v"(r) : "v"(lo), "v"(hi)); return r;
}
__device__ __forceinline__ bf16x8 ld8(const bf16* p) { return *reinterpret_cast<const bf16x8*>(p); }

__device__ __forceinline__ void partialSM(f32x16& p0, f32x16& p1, float& m_reg, float& mn, float& alpha) {
  constexpr float C = SCALE * 1.4426950408889634f;
  float pmax = p0[0]; for (int r = 1; r < 16; ++r) pmax = fmaxf(pmax, p0[r]); for (int r = 0; r < 16; ++r) pmax = fmaxf(pmax, p1[r]);
  { auto rr = __builtin_amdgcn_permlane32_swap(__float_as_uint(pmax), __float_as_uint(pmax), false, false);
    pmax = fmaxf(__uint_as_float(rr[0]), __uint_as_float(rr[1])); }
  if (__builtin_expect(__all(pmax - m_reg <= THR / SCALE), 1)) { mn = m_reg; alpha = 1.f; }
  else { mn = fmaxf(m_reg, pmax); alpha = __builtin_amdgcn_exp2f((m_reg - mn) * C); m_reg = mn; }
  float mnC = -mn * C;
  for (int r = 0; r < 16; ++r) p0[r] = fmaf(p0[r], C, mnC); for (int r = 0; r < 16; ++r) p1[r] = fmaf(p1[r], C, mnC);
  for (int r = 0; r < 16; ++r) p0[r] = __builtin_amdgcn_exp2f(p0[r]);
}
#define PK4(P, BASE, OUT) do { unsigned a0 = cvtpk(P[BASE + 0], P[BASE + 1]), a1 = cvtpk(P[BASE + 2], P[BASE + 3]);   \
    unsigned b0 = cvtpk(P[BASE + 4], P[BASE + 5]), b1 = cvtpk(P[BASE + 6], P[BASE + 7]);                              \
    auto r0 = __builtin_amdgcn_permlane32_swap(a0, b0, false, false); auto r1 = __builtin_amdgcn_permlane32_swap(a1, b1, false, false); \
    u32x4 w = {r0[0], r1[0], r0[1], r1[1]}; OUT = *reinterpret_cast<bf16x8*>(&w); } while (0)
__device__ __forceinline__ void finishSM(f32x16& p0, f32x16& p1, float alpha, float& l_reg, bf16x8& pa0, bf16x8& pa1, bf16x8& pa2, bf16x8& pa3) {
  for (int r = 0; r < 16; ++r) p1[r] = __builtin_amdgcn_exp2f(p1[r]);
  float ps = 0; for (int r = 0; r < 16; ++r) ps += p0[r]; for (int r = 0; r < 16; ++r) ps += p1[r];
  { auto rr = __builtin_amdgcn_permlane32_swap(__float_as_uint(ps), __float_as_uint(ps), false, false);
    ps = __uint_as_float(rr[0]) + __uint_as_float(rr[1]); }
  l_reg = l_reg * alpha + ps;
  PK4(p0, 0, pa0); PK4(p0, 8, pa1); PK4(p1, 0, pa2); PK4(p1, 8, pa3);
}
__device__ __forceinline__ void qkt(f32x16& p0, f32x16& p1, const bf16* Ks, const bf16x8* qr, int r32, int hi) {
  p0 = f32x16{}; p1 = f32x16{};
  for (int d0 = 0; d0 < 8; ++d0) { int cb = (d0 * 16 + hi * 8) * 2;
    bf16x8 b0 = *reinterpret_cast<const bf16x8*>((const char*)Ks + KSWZ(r32, cb));
    bf16x8 b1 = *reinterpret_cast<const bf16x8*>((const char*)Ks + KSWZ(32 + r32, cb));
    p0 = __builtin_amdgcn_mfma_f32_32x32x16_bf16(b0, qr[d0], p0, 0, 0, 0);
    p1 = __builtin_amdgcn_mfma_f32_32x32x16_bf16(b1, qr[d0], p1, 0, 0, 0); }
}
constexpr float CQ = SCALE * 1.4426950408889634f, THR2 = THR * 1.4426950408889634f;
__device__ __forceinline__ void qkt_n(f32x16& p0, f32x16& p1, const bf16* Ks, const bf16x8* qr, const f32x16& negm, int r32, int hi) {
  { const int cb = (hi * 8) * 2;
    bf16x8 b0 = *reinterpret_cast<const bf16x8*>((const char*)Ks + KSWZ(r32, cb));
    bf16x8 b1 = *reinterpret_cast<const bf16x8*>((const char*)Ks + KSWZ(32 + r32, cb));
    p0 = __builtin_amdgcn_mfma_f32_32x32x16_bf16(b0, qr[0], negm, 0, 0, 0);
    p1 = __builtin_amdgcn_mfma_f32_32x32x16_bf16(b1, qr[0], negm, 0, 0, 0); }
  for (int d0 = 1; d0 < 8; ++d0) { int cb = (d0 * 16 + hi * 8) * 2;
    bf16x8 b0 = *reinterpret_cast<const bf16x8*>((const char*)Ks + KSWZ(r32, cb));
    bf16x8 b1 = *reinterpret_cast<const bf16x8*>((const char*)Ks + KSWZ(32 + r32, cb));
    p0 = __builtin_amdgcn_mfma_f32_32x32x16_bf16(b0, qr[d0], p0, 0, 0, 0);
    p1 = __builtin_amdgcn_mfma_f32_32x32x16_bf16(b1, qr[d0], p1, 0, 0, 0); }
}
__device__ __forceinline__ void partialSM_b(f32x16& p0, float& alpha) { alpha = 1.f; for (int r = 0; r < 16; ++r) p0[r] = __builtin_amdgcn_exp2f(p0[r]); }
template <bool FIRST>
__device__ __forceinline__ void partialSM_n(f32x16& p0, f32x16& p1, float& mhat, f32x16& negm, float& alpha) {
  float pmax = p0[0]; for (int r = 1; r < 16; ++r) pmax = fmaxf(pmax, p0[r]); for (int r = 0; r < 16; ++r) pmax = fmaxf(pmax, p1[r]);
  { auto rr = __builtin_amdgcn_permlane32_swap(__float_as_uint(pmax), __float_as_uint(pmax), false, false);
    pmax = fmaxf(__uint_as_float(rr[0]), __uint_as_float(rr[1])); }
  alpha = 1.f;
  if (FIRST || !__builtin_expect(__all(pmax <= THR2), 1)) {
    const float dl = FIRST ? pmax : fmaxf(pmax, 0.f); mhat += dl;
    for (int r = 0; r < 16; ++r) { p0[r] -= dl; p1[r] -= dl; }
    for (int r = 0; r < 16; ++r) negm[r] = -mhat;
    asm volatile("" : "+v"(negm));
    if (!FIRST) alpha = __builtin_amdgcn_exp2f(-dl);
  }
  for (int r = 0; r < 16; ++r) p0[r] = __builtin_amdgcn_exp2f(p0[r]);
}
__device__ __forceinline__ void decide_n(f32x16& p0, f32x16& p1, float& mhat, f32x16& negm, float& alpha) {
  float pmax = p0[0]; for (int r = 1; r < 16; ++r) pmax = fmaxf(pmax, p0[r]); for (int r = 0; r < 16; ++r) pmax = fmaxf(pmax, p1[r]);
  { auto rr = __builtin_amdgcn_permlane32_swap(__float_as_uint(pmax), __float_as_uint(pmax), false, false);
    pmax = fmaxf(__uint_as_float(rr[0]), __uint_as_float(rr[1])); }
  alpha = 1.f;
  if (!__builtin_expect(__all(pmax <= THR2), 1)) {
    const float dl = fmaxf(pmax, 0.f); mhat += dl;
    for (int r = 0; r < 16; ++r) { p0[r] -= dl; p1[r] -= dl; }
    for (int r = 0; r < 16; ++r) negm[r] = -mhat;
    asm volatile("" : "+v"(negm));
    alpha = __builtin_amdgcn_exp2f(-dl);
  }
}
typedef __attribute__((address_space(3))) const char* lds_cp;
typedef short v4i16_t __attribute__((ext_vector_type(4)));
__device__ __forceinline__ s16x4 vtr(lds_cp p) { return __builtin_bit_cast(s16x4, __builtin_amdgcn_ds_read_tr16_b64_v4i16((__attribute__((address_space(3))) v4i16_t*)p)); }
__device__ __forceinline__ int v_st(int k, int c) { const int kk = (k & ~0xC) | ((k & 4) << 1) | ((k & 8) >> 1); return ((kk >> 3) * 4 + (c >> 5)) * 512 + ((kk & 7) * 32 + (c & 31)) * 2; }
__device__ __forceinline__ int v_rd_base(int lane) { return ((lane & 3) << 3) | (((lane >> 2) & 3) << 6) | (((lane >> 4) & 1) << 5) | (((lane >> 5) & 1) << 8); }
constexpr int v_rd_off(int d0, int ks, int half) { return d0 * 512 + ks * 4096 + half * 2048; }
template <int OFF> __device__ __forceinline__ s16x4 tr_read(int vb) {
  s16x4 r; asm volatile("ds_read_b64_tr_b16 %0, %1 offset:%2" : "=&v"(r) : "v"(vb), "i"(OFF) : "memory"); return r;
}
template <int D0> __device__ __forceinline__ void pv_one(f32x16& od, int vb, bf16x8 pa0, bf16x8 pa1, bf16x8 pa2, bf16x8 pa3) {
  const s16x4 l0 = tr_read<v_rd_off(D0, 0, 0)>(vb), h0 = tr_read<v_rd_off(D0, 0, 1)>(vb), l1 = tr_read<v_rd_off(D0, 1, 0)>(vb), h1 = tr_read<v_rd_off(D0, 1, 1)>(vb);
  const s16x4 l2 = tr_read<v_rd_off(D0, 2, 0)>(vb), h2 = tr_read<v_rd_off(D0, 2, 1)>(vb), l3 = tr_read<v_rd_off(D0, 3, 0)>(vb), h3 = tr_read<v_rd_off(D0, 3, 1)>(vb);
  asm volatile("s_waitcnt lgkmcnt(0)" ::: "memory"); SBAR();
#define PK(L, H) (bf16x8){L[0], L[1], L[2], L[3], H[0], H[1], H[2], H[3]}
  od = __builtin_amdgcn_mfma_f32_32x32x16_bf16(pa0, PK(l0, h0), od, 0, 0, 0);
  od = __builtin_amdgcn_mfma_f32_32x32x16_bf16(pa1, PK(l1, h1), od, 0, 0, 0);
  od = __builtin_amdgcn_mfma_f32_32x32x16_bf16(pa2, PK(l2, h2), od, 0, 0, 0);
  od = __builtin_amdgcn_mfma_f32_32x32x16_bf16(pa3, PK(l3, h3), od, 0, 0, 0);
#undef PK
}
__device__ __forceinline__ void pv_d0(f32x16* o, int vb, bf16x8 pa0, bf16x8 pa1, bf16x8 pa2, bf16x8 pa3) {
  pv_one<0>(o[0], vb, pa0, pa1, pa2, pa3); pv_one<1>(o[1], vb, pa0, pa1, pa2, pa3); pv_one<2>(o[2], vb, pa0, pa1, pa2, pa3); pv_one<3>(o[3], vb, pa0, pa1, pa2, pa3);
}

__device__ __forceinline__ bf16x8 pack8(const f32x16& p, int base) {
  u32x4 w = {cvtpk(p[base + 0], p[base + 1]), cvtpk(p[base + 2], p[base + 3]), cvtpk(p[base + 4], p[base + 5]), cvtpk(p[base + 6], p[base + 7])}; return *reinterpret_cast<bf16x8*>(&w); }
__device__ __forceinline__ void finishSM_ot(f32x16& p0, f32x16& p1, float alpha, float& l_reg, bf16x8& pa0, bf16x8& pa1, bf16x8& pa2, bf16x8& pa3) {
  for (int r = 0; r < 16; ++r) p1[r] = __builtin_amdgcn_exp2f(p1[r]);
  float ps = 0; for (int r = 0; r < 16; ++r) ps += p0[r]; for (int r = 0; r < 16; ++r) ps += p1[r];
  { auto rr = __builtin_amdgcn_permlane32_swap(__float_as_uint(ps), __float_as_uint(ps), false, false);
    ps = __uint_as_float(rr[0]) + __uint_as_float(rr[1]); }
  l_reg = l_reg * alpha + ps;
  pa0 = pack8(p0, 0); pa1 = pack8(p0, 8); pa2 = pack8(p1, 0); pa3 = pack8(p1, 8);
}
template <int D0> __device__ __forceinline__ void pv_one_ot(f32x16& od, int vb, bf16x8 pa0, bf16x8 pa1, bf16x8 pa2, bf16x8 pa3) {
  const s16x4 l0 = tr_read<v_rd_off(D0, 0, 0)>(vb), h0 = tr_read<v_rd_off(D0, 0, 1)>(vb), l1 = tr_read<v_rd_off(D0, 1, 0)>(vb), h1 = tr_read<v_rd_off(D0, 1, 1)>(vb);
  const s16x4 l2 = tr_read<v_rd_off(D0, 2, 0)>(vb), h2 = tr_read<v_rd_off(D0, 2, 1)>(vb), l3 = tr_read<v_rd_off(D0, 3, 0)>(vb), h3 = tr_read<v_rd_off(D0, 3, 1)>(vb);
  asm volatile("s_waitcnt lgkmcnt(0)" ::: "memory"); SBAR();
#define PK(L, H) (bf16x8){L[0], L[1], L[2], L[3], H[0], H[1], H[2], H[3]}
  od = __builtin_amdgcn_mfma_f32_32x32x16_bf16(PK(l0, h0), pa0, od, 0, 0, 0);
  od = __builtin_amdgcn_mfma_f32_32x32x16_bf16(PK(l1, h1), pa1, od, 0, 0, 0);
  od = __builtin_amdgcn_mfma_f32_32x32x16_bf16(PK(l2, h2), pa2, od, 0, 0, 0);
  od = __builtin_amdgcn_mfma_f32_32x32x16_bf16(PK(l3, h3), pa3, od, 0, 0, 0);
#undef PK
}
__device__ __forceinline__ void pv_ot(f32x16* o, int vb, bf16x8 pa0, bf16x8 pa1, bf16x8 pa2, bf16x8 pa3) {
  pv_one_ot<0>(o[0], vb, pa0, pa1, pa2, pa3); pv_one_ot<1>(o[1], vb, pa0, pa1, pa2, pa3); pv_one_ot<2>(o[2], vb, pa0, pa1, pa2, pa3); pv_one_ot<3>(o[3], vb, pa0, pa1, pa2, pa3);
}
constexpr int ASLOT = 16384, RING_ATTN = 6 * ASLOT + NW * 64 * 4;
#define AWAIT_BAR(N) asm volatile("s_waitcnt vmcnt(" #N ") lgkmcnt(0)\n\ts_barrier" ::: "memory")
template <int LDQ, int LDK, int LDO, bool QN, bool BND = false, bool HS = false>
__device__ __forceinline__ void attn_dense_body(const bf16* Qb, const bf16* __restrict__ Kh, const bf16* __restrict__ Vh, bf16* Ob, int seq, char* lds,
                                                __attribute__((address_space(3))) unsigned char* ldsl, const int wave_s, const float* qg = nullptr, const float* axt = nullptr, int tok0 = 0, float bnd = 0.f) {
  constexpr bool OT = HS;
  int lane; asm volatile("v_mbcnt_lo_u32_b32 %0, -1, 0\n\tv_mbcnt_hi_u32_b32 %0, -1, %0" : "=v"(lane));
  const int wid = wave_s, r32 = lane & 31, hi = lane >> 5;
  char* K_lds = lds; char* V_lds = lds + 3 * ASLOT;
  float* ws = (float*)(lds + 6 * ASLOT) + wid * 64; float* li_l = ws; float* al_l = ws + 32;
  float mhat = 0.f, l_reg = 0; f32x16 o[4] = {}; bf16x8 qr[8]; f32x16 negm;
  unsigned ksrc[2], vsrc[2];
#pragma unroll
  for (int i = 0; i < 2; ++i) { const int p = 2 * wid + i;
    const int krow = 4 * p + (lane >> 4), kch = (lane & 15) ^ (krow & 7); ksrc[i] = (unsigned)(krow * LDK + kch * 8) * 2u;
    const int sub = 2 * p + (lane >> 5), kk = ((sub >> 2) << 3) | ((lane & 31) >> 2), key = OT ? kk : ((kk & ~0xC) | ((kk & 4) << 1) | ((kk & 8) >> 1)), vc = ((sub & 3) << 5) | ((lane & 3) << 3);
    vsrc[i] = (unsigned)(key * LDK + vc) * 2u; }
#define DMA_K1(t, sl, i_) __builtin_amdgcn_global_load_lds((const unsigned*)((const char*)Kh + (ksrc[i_] + (unsigned)(t) * (unsigned)(KVBLK * LDK * 2))), (__attribute__((address_space(3))) unsigned*)(ldsl + (sl) + (2 * wid + (i_)) * 1024), 16, 0, 0)
#define DMA_V1(t, sl, i_) __builtin_amdgcn_global_load_lds((const unsigned*)((const char*)Vh + (vsrc[i_] + (unsigned)(t) * (unsigned)(KVBLK * LDK * 2))), (__attribute__((address_space(3))) unsigned*)(ldsl + 3 * ASLOT + (sl) + (2 * wid + (i_)) * 1024), 16, 0, 0)
#define DMA_K(t, sl) do { DMA_K1(t, sl, 0); DMA_K1(t, sl, 1); } while (0)
#define DMA_V(t, sl) do { DMA_V1(t, sl, 0); DMA_V1(t, sl, 1); } while (0)
  const int NT = seq / KVBLK;
  DMA_K(0, 0); DMA_V(0, 0); DMA_K(1, ASLOT);
  const bf16* Qw = Qb + (long)(wid * QBLK + r32) * LDQ + hi * 8;
#pragma unroll
  for (int d0 = 0; d0 < 8; ++d0) qr[d0] = ld8(Qw + d0 * 16);
  if constexpr (QN) {
    const int t = tok0 + wid * QBLK + r32, prow = t >> 6, pcol = t & 63;
    float x[8][8]; float ss = 0.f;
#pragma unroll
    for (int d0 = 0; d0 < 8; ++d0)
#pragma unroll
      for (int e = 0; e < 8; ++e) { x[d0][e] = __builtin_bit_cast(float, (unsigned)(unsigned short)qr[d0][e] << 16); ss += x[d0][e] * x[d0][e]; }
    { auto rr = __builtin_amdgcn_permlane32_swap(__float_as_uint(ss), __float_as_uint(ss), false, false); ss = __uint_as_float(rr[0]) + __uint_as_float(rr[1]); }
    const float rstd = CQ / sqrtf(ss * (1.f / 128.f) + 1e-6f);
#pragma unroll
    for (int d0 = 0; d0 < 8; ++d0) { const float* gp = qg + d0 * 16 + hi * 8; const f32x4v g0 = *(const f32x4v*)gp, g1 = *(const f32x4v*)(gp + 4);
#pragma unroll
      for (int e = 0; e < 8; ++e) x[d0][e] *= rstd * (e < 4 ? g0[e] : g1[e - 4]); }
#pragma unroll
    for (int half = 0; half < 2; ++half) { const float* ct = half == 0 ? axt + prow * 32 : axt + 16384 + pcol * 32; const float* st = ct + (half == 0 ? 8192 : 2048);
#pragma unroll
      for (int dd = 0; dd < 2; ++dd) { const int ix = dd * 16 + hi * 8;
        const f32x4v c0 = *(const f32x4v*)(ct + ix), c1 = *(const f32x4v*)(ct + ix + 4), s0 = *(const f32x4v*)(st + ix), s1 = *(const f32x4v*)(st + ix + 4);
#pragma unroll
        for (int e = 0; e < 8; ++e) { const float c = e < 4 ? c0[e] : c1[e - 4], sn = e < 4 ? s0[e] : s1[e - 4];
          const float a = x[half * 4 + dd][e], b = x[half * 4 + 2 + dd][e]; x[half * 4 + dd][e] = a * c - b * sn; x[half * 4 + 2 + dd][e] = b * c + a * sn; } } }
#pragma unroll
    for (int d0 = 0; d0 < 8; ++d0) { u32x4 w = {cvtpk(x[d0][0], x[d0][1]), cvtpk(x[d0][2], x[d0][3]), cvtpk(x[d0][4], x[d0][5]), cvtpk(x[d0][6], x[d0][7])}; qr[d0] = *reinterpret_cast<bf16x8*>(&w); }
  }
  if constexpr (!QN) {
#pragma unroll
    for (int d0 = 0; d0 < 8; ++d0) { float x[8];
#pragma unroll
      for (int e = 0; e < 8; ++e) x[e] = __builtin_bit_cast(float, (unsigned)(unsigned short)qr[d0][e] << 16) * CQ;
      u32x4 w = {cvtpk(x[0], x[1]), cvtpk(x[2], x[3]), cvtpk(x[4], x[5]), cvtpk(x[6], x[7])}; qr[d0] = *reinterpret_cast<bf16x8*>(&w); }
  }
  const bool onl = !BND || !(bnd <= 60.f);
  { float nb = (BND && !onl) ? -bnd : 0.f; asm volatile("" : "+v"(nb));
    for (int r = 0; r < 16; ++r) negm[r] = nb; asm volatile("" : "+v"(negm)); }
  const int vb0 = (int)(uintptr_t)V_lds + v_rd_base(lane);
#define RESC(a) do { if ((!BND || onl) && __any((a) < 1.f)) { if constexpr (OT) { for (int d = 0; d < 4; ++d) for (int r = 0; r < 16; ++r) o[d][r] *= (a); } else { \
    if (hi == 0) al_l[r32] = (a); asm volatile("s_waitcnt lgkmcnt(0)" ::: "memory"); \
    for (int d = 0; d < 4; ++d) for (int r = 0; r < 16; ++r) o[d][r] *= al_l[crow(r, hi)]; } } } while (0)
  f32x16 pA0, pA1, pB0, pB1; float alA, alB; bf16x8 pa0, pa1, pa2, pa3;
  int s0 = 2 * ASLOT, s1 = 0, s2 = ASLOT;
#define ROT() do { const int t_ = s0; s0 = s1; s1 = s2; s2 = t_; } while (0)
  AWAIT_BAR(0);
  if (wid >= 4) __builtin_amdgcn_s_setprio(1);
  DMA_K(2, s0); DMA_V(1, s2);
  qkt_n(pA0, pA1, (const bf16*)(K_lds + s1), qr, negm, r32, hi); if (BND && !onl) partialSM_b(pA0, alA); else partialSM_n<true>(pA0, pA1, mhat, negm, alA);
  AWAIT_BAR(4); ROT();
  if constexpr (HS) {
    const lds_cp kb_l = (lds_cp)ldsl + r32 * 256, vb_l = (lds_cp)ldsl + 3 * ASLOT + v_rd_base(lane);
    const int ksw = (r32 & 7) << 4, khi = hi * 16;
    bf16x8 kf[3][2]; s16x4 vl[4], vh[4];
#define H_KRD(kp, i) do { const unsigned a_ = (unsigned)(uintptr_t)(kp) + (unsigned)((((i) * 32 + khi) ^ ksw)); \
      asm volatile("ds_read_b128 %0, %2\n\tds_read_b128 %1, %2 offset:8192" : "=&v"(kf[(i) % 3][0]), "=&v"(kf[(i) % 3][1]) : "v"(a_) : "memory"); } while (0)
#define H_KWAIT(N, i) asm volatile("s_waitcnt lgkmcnt(" #N ")" : "+v"(kf[(i) % 3][0]), "+v"(kf[(i) % 3][1]) :: "memory")
#define H_VRD(vp, j) do { const unsigned a_ = (unsigned)(uintptr_t)(vp); \
      asm volatile("ds_read_b64_tr_b16 %0, %2 offset:%3\n\tds_read_b64_tr_b16 %1, %2 offset:%4" : "=&v"(vl[(j) & 3]), "=&v"(vh[(j) & 3]) : "v"(a_), "i"(v_rd_off((j) >> 2, (j) & 3, 0)), "i"(v_rd_off((j) >> 2, (j) & 3, 1)) : "memory"); } while (0)
#define H_VWAIT(N, j) asm volatile("s_waitcnt lgkmcnt(" #N ")" : "+v"(vl[(j) & 3]), "+v"(vh[(j) & 3]) :: "memory")
#define H_PIN(x) asm volatile("" : "+v"(x))
#define H_VF(j) (bf16x8){vl[(j) & 3][0], vl[(j) & 3][1], vl[(j) & 3][2], vl[(j) & 3][3], vh[(j) & 3][0], vh[(j) & 3][1], vh[(j) & 3][2], vh[(j) & 3][3]}
#define H_PA(j) (((j) & 3) == 0 ? pa0 : ((j) & 3) == 1 ? pa1 : ((j) & 3) == 2 ? pa2 : pa3)
#define H_GA(i, C0, C1, P0, P1, kp) do { \
      if (((i) & 1) == 0 && ((i) >> 1) + 2 < 8) H_KRD(kp, ((i) >> 1) + 2); \
      if (((i) & 1) == 0) { if ((i) < 12) H_KWAIT(4, (i) >> 1); else if ((i) == 12) H_KWAIT(2, 6); else H_KWAIT(0, 7); } \
      if ((i) == 8) DMA_K1(tkk, s0, 0); else if ((i) == 10) DMA_K1(tkk, s0, 1); else if ((i) == 12) DMA_V1(tvv, s2, 0); else if ((i) == 14) DMA_V1(tvv, s2, 1); \
      if (((i) & 1) == 0) C0 = __builtin_amdgcn_mfma_f32_32x32x16_bf16(kf[((i) >> 1) % 3][0], qr[(i) >> 1], (i) < 2 ? negm : C0, 0, 0, 0); \
      else C1 = __builtin_amdgcn_mfma_f32_32x32x16_bf16(kf[((i) >> 1) % 3][1], qr[(i) >> 1], (i) < 2 ? negm : C1, 0, 0, 0); \
      if ((i) < 8) { P1[2 * (i)] = __builtin_amdgcn_exp2f(P1[2 * (i)]); P1[2 * (i) + 1] = __builtin_amdgcn_exp2f(P1[2 * (i) + 1]); sacc += P0[2 * (i)]; sacc += P0[2 * (i) + 1]; H_PIN(P1); H_PIN(sacc); } \
      else { sacc += P1[2 * ((i) - 8)]; sacc += P1[2 * ((i) - 8) + 1]; H_PIN(sacc); \
        if (((i) & 1) == 0) { if ((i) < 12) { ca0 = cvtpk(P0[((i) - 8) * 4 + 0], P0[((i) - 8) * 4 + 1]); ca1 = cvtpk(P0[((i) - 8) * 4 + 2], P0[((i) - 8) * 4 + 3]); } \
                              else { ca0 = cvtpk(P1[((i) - 12) * 4 + 0], P1[((i) - 12) * 4 + 1]); ca1 = cvtpk(P1[((i) - 12) * 4 + 2], P1[((i) - 12) * 4 + 3]); } H_PIN(ca0); H_PIN(ca1); } \
        else { unsigned cb0, cb1; if ((i) < 12) { cb0 = cvtpk(P0[((i) - 9) * 4 + 4], P0[((i) - 9) * 4 + 5]); cb1 = cvtpk(P0[((i) - 9) * 4 + 6], P0[((i) - 9) * 4 + 7]); } \
                              else { cb0 = cvtpk(P1[((i) - 13) * 4 + 4], P1[((i) - 13) * 4 + 5]); cb1 = cvtpk(P1[((i) - 13) * 4 + 6], P1[((i) - 13) * 4 + 7]); } \
          u32x4 w_ = {ca0, ca1, cb0, cb1};     \
          if ((i) == 9) { pa0 = *reinterpret_cast<bf16x8*>(&w_); H_PIN(pa0); } else if ((i) == 11) { pa1 = *reinterpret_cast<bf16x8*>(&w_); H_PIN(pa1); } \
          else if ((i) == 13) { pa2 = *reinterpret_cast<bf16x8*>(&w_); H_PIN(pa2); } else { pa3 = *reinterpret_cast<bf16x8*>(&w_); H_PIN(pa3); } } } \
      SBAR(); } while (0)
#define H_GB(j, C0, vp) do { if ((j) + 3 < 16) H_VRD(vp, (j) + 3); \
      if ((j) < 13) H_VWAIT(6, j); else if ((j) == 13) H_VWAIT(4, 13); else if ((j) == 14) H_VWAIT(2, 14); else H_VWAIT(0, 15); \
      o[(j) >> 2] = __builtin_amdgcn_mfma_f32_32x32x16_bf16(H_VF(j), H_PA(j), o[(j) >> 2], 0, 0, 0);     \
      C0[j] = __builtin_amdgcn_exp2f(C0[j]); H_PIN(C0); SBAR(); } while (0)
#define H_STEP(C0, C1, P0, P1, alP, alC, tk_, tv_) do { \
      const lds_cp kp_ = kb_l + s1, vp_ = vb_l + s0; float sacc = 0.f; unsigned ca0 = 0, ca1 = 0; const int tkk = (tk_), tvv = (tv_); \
      SBAR(); H_KRD(kp_, 0); H_KRD(kp_, 1); SBAR(); \
      H_GA(0, C0, C1, P0, P1, kp_); H_GA(1, C0, C1, P0, P1, kp_); H_GA(2, C0, C1, P0, P1, kp_); H_GA(3, C0, C1, P0, P1, kp_); \
      H_GA(4, C0, C1, P0, P1, kp_); H_GA(5, C0, C1, P0, P1, kp_); H_GA(6, C0, C1, P0, P1, kp_); H_GA(7, C0, C1, P0, P1, kp_); \
      H_GA(8, C0, C1, P0, P1, kp_); H_GA(9, C0, C1, P0, P1, kp_); H_GA(10, C0, C1, P0, P1, kp_); H_GA(11, C0, C1, P0, P1, kp_); \
      H_GA(12, C0, C1, P0, P1, kp_); H_GA(13, C0, C1, P0, P1, kp_); H_GA(14, C0, C1, P0, P1, kp_); H_GA(15, C0, C1, P0, P1, kp_); \
      { auto rr_ = __builtin_amdgcn_permlane32_swap(__float_as_uint(sacc), __float_as_uint(sacc), false, false); l_reg = l_reg * (alP) + (__uint_as_float(rr_[0]) + __uint_as_float(rr_[1])); } \
      if (onl) decide_n(C0, C1, mhat, negm, alC); else alC = 1.f; \
      H_VRD(vp_, 0); H_VRD(vp_, 1); H_VRD(vp_, 2); SBAR(); \
      H_GB(0, C0, vp_); H_GB(1, C0, vp_); H_GB(2, C0, vp_); H_GB(3, C0, vp_); H_GB(4, C0, vp_); H_GB(5, C0, vp_); H_GB(6, C0, vp_); H_GB(7, C0, vp_); \
      H_GB(8, C0, vp_); H_GB(9, C0, vp_); H_GB(10, C0, vp_); H_GB(11, C0, vp_); H_GB(12, C0, vp_); H_GB(13, C0, vp_); H_GB(14, C0, vp_); H_GB(15, C0, vp_); \
    } while (0)
    for (int j = 1; j + 1 < NT; j += 2) {
      { const int tk = j + 2 < NT ? j + 2 : NT - 1, tv = j + 1;
      H_STEP(pB0, pB1, pA0, pA1, alA, alB, tk, tv); }
      RESC(alB); AWAIT_BAR(4); ROT();
      { const int tk = j + 3 < NT ? j + 3 : NT - 1, tv = j + 2 < NT ? j + 2 : NT - 1;
      H_STEP(pA0, pA1, pB0, pB1, alB, alA, tk, tv); }
      RESC(alA); AWAIT_BAR(4); ROT();
    }
#undef H_KRD
#undef H_VRD
#undef H_KWAIT
#undef H_VWAIT
#undef H_PIN
#undef H_VF
#undef H_PA
#undef H_GA
#undef H_GB
#undef H_STEP
  } else {
  for (int j = 1; j + 1 < NT; j += 2) {
    { const int tk = j + 2 < NT ? j + 2 : NT - 1, tv = j + 1; DMA_K(tk, s0); DMA_V(tv, s2); }
    SBAR(); qkt_n(pB0, pB1, (const bf16*)(K_lds + s1), qr, negm, r32, hi);
    finishSM(pA0, pA1, alA, l_reg, pa0, pa1, pa2, pa3); SBAR();
    pv_d0(o, vb0 + s0, pa0, pa1, pa2, pa3); if (BND && !onl) partialSM_b(pB0, alB); else partialSM_n<false>(pB0, pB1, mhat, negm, alB);
    RESC(alB); AWAIT_BAR(4); ROT();
    { const int tk = j + 3 < NT ? j + 3 : NT - 1, tv = j + 2 < NT ? j + 2 : NT - 1; DMA_K(tk, s0); DMA_V(tv, s2); }
    SBAR(); qkt_n(pA0, pA1, (const bf16*)(K_lds + s1), qr, negm, r32, hi);
    finishSM(pB0, pB1, alB, l_reg, pa0, pa1, pa2, pa3); SBAR();
    pv_d0(o, vb0 + s0, pa0, pa1, pa2, pa3); if (BND && !onl) partialSM_b(pA0, alA); else partialSM_n<false>(pA0, pA1, mhat, negm, alA);
    RESC(alA); AWAIT_BAR(4); ROT();
  }
  }
  { DMA_K(NT - 1, s0); DMA_V(NT - 1, s2); }
  SBAR(); qkt_n(pB0, pB1, (const bf16*)(K_lds + s1), qr, negm, r32, hi);
  if constexpr (OT) finishSM_ot(pA0, pA1, alA, l_reg, pa0, pa1, pa2, pa3); else finishSM(pA0, pA1, alA, l_reg, pa0, pa1, pa2, pa3);
  SBAR();
  if constexpr (OT) pv_ot(o, vb0 + s0, pa0, pa1, pa2, pa3); else pv_d0(o, vb0 + s0, pa0, pa1, pa2, pa3);
  if (BND && !onl) partialSM_b(pB0, alB); else partialSM_n<false>(pB0, pB1, mhat, negm, alB);
  RESC(alB); AWAIT_BAR(4); ROT();
  if constexpr (OT) finishSM_ot(pB0, pB1, alB, l_reg, pa0, pa1, pa2, pa3); else finishSM(pB0, pB1, alB, l_reg, pa0, pa1, pa2, pa3);
  SBAR();
  if constexpr (OT) pv_ot(o, vb0 + s0, pa0, pa1, pa2, pa3); else pv_d0(o, vb0 + s0, pa0, pa1, pa2, pa3);
  __builtin_amdgcn_s_setprio(0);
  int lane2; asm volatile("v_mbcnt_lo_u32_b32 %0, -1, 0\n\tv_mbcnt_hi_u32_b32 %0, -1, %0" : "=v"(lane2));
  const int r32b = lane2 & 31, hib = lane2 >> 5;
  if constexpr (OT) {
    const float rl = __builtin_amdgcn_rcpf(l_reg);
    bf16* Ow = Ob + (long)(wid * QBLK + r32b) * LDO + 4 * hib;
#pragma unroll
    for (int d0 = 0; d0 < 4; ++d0)
#pragma unroll
      for (int g = 0; g < 4; ++g) { const unsigned long long w = (unsigned long long)cvtpk(o[d0][4 * g] * rl, o[d0][4 * g + 1] * rl) | ((unsigned long long)cvtpk(o[d0][4 * g + 2] * rl, o[d0][4 * g + 3] * rl) << 32);
        *(unsigned long long*)(Ow + d0 * 32 + g * 8) = w; }
  } else {
  if (hi == 0) li_l[r32] = l_reg; asm volatile("s_waitcnt lgkmcnt(0)" ::: "memory");
  float rli[16];
#pragma unroll
  for (int r = 0; r < 16; ++r) rli[r] = __builtin_amdgcn_rcpf(li_l[crow(r, hib)]);
  bf16* Ow = Ob + (long)(wid * QBLK) * LDO + r32b;
#pragma unroll
  for (int r = 0; r < 16; ++r) { int orow = crow(r, hib);
    for (int d0 = 0; d0 < 4; ++d0) Ow[(long)orow * LDO + d0 * 32] = (bf16)(cvtpk(o[d0][r] * rli[r], 0.f) & 0xffffu); }
  }
  AWAIT_BAR(0);
#undef DMA_K
#undef DMA_V
#undef DMA_K1
#undef DMA_V1
#undef RESC
#undef ROT
}
template <int LDQ, int LDK, int LDO>
__device__ __forceinline__ void attn_dense_stg(const bf16* Qb, const bf16* __restrict__ Kh, const bf16* __restrict__ Vh, bf16* Ob, int seq, char* lds,
                                                __attribute__((address_space(3))) unsigned char* ldsl, const int wave_s, const float* qg = nullptr, const float* axt = nullptr, int tok0 = 0, float bnd = 0.f) {
  constexpr bool OT = true, QN = true, BND = true;
  int lane; asm volatile("v_mbcnt_lo_u32_b32 %0, -1, 0\n\tv_mbcnt_hi_u32_b32 %0, -1, %0" : "=v"(lane));
  const int wid = wave_s, r32 = lane & 31, hi = lane >> 5;
  float mhat = 0.f, l_reg = 0; f32x16 o[4] = {}; bf16x8 qr[8]; f32x16 negm;
  unsigned ksrc[2], vsrc[2];
#pragma unroll
  for (int i = 0; i < 2; ++i) { const int p = 2 * wid + i;
    const int krow = 4 * p + (lane >> 4), kch = (lane & 15) ^ (krow & 15); ksrc[i] = (unsigned)(krow * LDK + kch * 8) * 2u;
    const int sub = 2 * p + (lane >> 5), kk = ((sub >> 2) << 3) | ((lane & 31) >> 2), key = OT ? kk : ((kk & ~0xC) | ((kk & 4) << 1) | ((kk & 8) >> 1)), vc = ((sub & 3) << 5) | ((lane & 3) << 3);
    vsrc[i] = (unsigned)(key * LDK + vc) * 2u; }
#define DMA_K1(t, sl, i_) __builtin_amdgcn_global_load_lds((const unsigned*)((const char*)Kh + (ksrc[i_] + (unsigned)(t) * (unsigned)(KVBLK * LDK * 2))), (__attribute__((address_space(3))) unsigned*)(ldsl + (sl) + (2 * wid + (i_)) * 1024), 16, 0, 0)
#define DMA_V1(t, sl, i_) __builtin_amdgcn_global_load_lds((const unsigned*)((const char*)Vh + (vsrc[i_] + (unsigned)(t) * (unsigned)(KVBLK * LDK * 2))), (__attribute__((address_space(3))) unsigned*)(ldsl + 4 * ASLOT + (sl) + (2 * wid + (i_)) * 1024), 16, 0, 0)
#define DMA_K(t, sl) do { DMA_K1(t, sl, 0); DMA_K1(t, sl, 1); } while (0)
#define DMA_V(t, sl) do { DMA_V1(t, sl, 0); DMA_V1(t, sl, 1); } while (0)
  const int NT = seq / KVBLK;
  DMA_K(0, 0); DMA_V(0, 0); DMA_K(1, ASLOT); DMA_K(2, 2 * ASLOT);
  const bf16* Qw = Qb + (long)(wid * QBLK + r32) * LDQ + hi * 8;
#pragma unroll
  for (int d0 = 0; d0 < 8; ++d0) qr[d0] = ld8(Qw + d0 * 16);
  if constexpr (QN) {
    const int t = tok0 + wid * QBLK + r32, prow = t >> 6, pcol = t & 63;
    float x[8][8]; float ss = 0.f;
#pragma unroll
    for (int d0 = 0; d0 < 8; ++d0)
#pragma unroll
      for (int e = 0; e < 8; ++e) { x[d0][e] = __builtin_bit_cast(float, (unsigned)(unsigned short)qr[d0][e] << 16); ss += x[d0][e] * x[d0][e]; }
    { auto rr = __builtin_amdgcn_permlane32_swap(__float_as_uint(ss), __float_as_uint(ss), false, false); ss = __uint_as_float(rr[0]) + __uint_as_float(rr[1]); }
    const float rstd = CQ / sqrtf(ss * (1.f / 128.f) + 1e-6f);
#pragma unroll
    for (int d0 = 0; d0 < 8; ++d0) { const float* gp = qg + d0 * 16 + hi * 8; const f32x4v g0 = *(const f32x4v*)gp, g1 = *(const f32x4v*)(gp + 4);
#pragma unroll
      for (int e = 0; e < 8; ++e) x[d0][e] *= rstd * (e < 4 ? g0[e] : g1[e - 4]); }
#pragma unroll
    for (int half = 0; half < 2; ++half) { const float* ct = half == 0 ? axt + prow * 32 : axt + 16384 + pcol * 32; const float* st = ct + (half == 0 ? 8192 : 2048);
#pragma unroll
      for (int dd = 0; dd < 2; ++dd) { const int ix = dd * 16 + hi * 8;
        const f32x4v c0 = *(const f32x4v*)(ct + ix), c1 = *(const f32x4v*)(ct + ix + 4), s0 = *(const f32x4v*)(st + ix), s1 = *(const f32x4v*)(st + ix + 4);
#pragma unroll
        for (int e = 0; e < 8; ++e) { const float c = e < 4 ? c0[e] : c1[e - 4], sn = e < 4 ? s0[e] : s1[e - 4];
          const float a = x[half * 4 + dd][e], b = x[half * 4 + 2 + dd][e]; x[half * 4 + dd][e] = a * c - b * sn; x[half * 4 + 2 + dd][e] = b * c + a * sn; } } }
#pragma unroll
    for (int d0 = 0; d0 < 8; ++d0) { u32x4 w = {cvtpk(x[d0][0], x[d0][1]), cvtpk(x[d0][2], x[d0][3]), cvtpk(x[d0][4], x[d0][5]), cvtpk(x[d0][6], x[d0][7])}; qr[d0] = *reinterpret_cast<bf16x8*>(&w); }
  }
  if constexpr (!QN) {
#pragma unroll
    for (int d0 = 0; d0 < 8; ++d0) { float x[8];
#pragma unroll
      for (int e = 0; e < 8; ++e) x[e] = __builtin_bit_cast(float, (unsigned)(unsigned short)qr[d0][e] << 16) * CQ;
      u32x4 w = {cvtpk(x[0], x[1]), cvtpk(x[2], x[3]), cvtpk(x[4], x[5]), cvtpk(x[6], x[7])}; qr[d0] = *reinterpret_cast<bf16x8*>(&w); }
  }
  const bool onl = !BND || !(bnd <= 60.f);
  { float nb = (BND && !onl) ? -bnd : 0.f; asm volatile("" : "+v"(nb));
    for (int r = 0; r < 16; ++r) negm[r] = nb; asm volatile("" : "+v"(negm)); }
  f32x16 S0, S1; float al = 1.f; bf16x8 pa0, pa1, pa2, pa3;
  int s0 = 2 * ASLOT, s1 = 0, s2 = ASLOT;
#define ROT() do { const int t_ = s0; s0 = s1; s1 = s2; s2 = t_; } while (0)
#define VBAR() asm volatile("s_waitcnt lgkmcnt(0)\n\ts_barrier" ::: "memory")
  const lds_cp kb_l = (lds_cp)ldsl + r32 * 256, vb_l = (lds_cp)ldsl + 4 * ASLOT + v_rd_base(lane);
  const int ksw = (r32 & 15) << 4, khi = hi * 16;
  bf16x8 kf[4][2]; s16x4 vl[8], vh[8];
#define G_KRD(kp, i) do { const unsigned a_ = (unsigned)(uintptr_t)(kp) + (unsigned)((((i) * 32 + khi) ^ ksw)); \
    asm volatile("ds_read_b128 %0, %2\n\tds_read_b128 %1, %2 offset:8192" : "=&v"(kf[(i) & 3][0]), "=&v"(kf[(i) & 3][1]) : "v"(a_) : "memory"); } while (0)
#define G_KWAIT(N, i) do { asm volatile("s_waitcnt lgkmcnt(" #N ")" ::: "memory"); SBAR(); } while (0)
#define G_VRD(vp, j) do { const unsigned a_ = (unsigned)(uintptr_t)(vp); \
    asm volatile("ds_read_b64_tr_b16 %0, %2 offset:%3\n\tds_read_b64_tr_b16 %1, %2 offset:%4" : "=&v"(vl[(j) & 7]), "=&v"(vh[(j) & 7]) : "v"(a_), "i"(v_rd_off((j) & 3, (j) >> 2, 0)), "i"(v_rd_off((j) & 3, (j) >> 2, 1)) : "memory"); } while (0)
#define G_VWAIT(N, j) do { asm volatile("s_waitcnt lgkmcnt(" #N ")" ::: "memory"); SBAR(); } while (0)
#define G_VF(j) (bf16x8){vl[(j) & 7][0], vl[(j) & 7][1], vl[(j) & 7][2], vl[(j) & 7][3], vh[(j) & 7][0], vh[(j) & 7][1], vh[(j) & 7][2], vh[(j) & 7][3]}
#define G_PA(j) (((j) >> 2) == 0 ? pa0 : ((j) >> 2) == 1 ? pa1 : ((j) >> 2) == 2 ? pa2 : pa3)
#define G_QK(i, HASPV, kp, vp, tk, tv) do { \
    if (((i) & 1) == 0 && ((i) >> 1) + 3 < 8) G_KRD(kp, ((i) >> 1) + 3); \
    if ((HASPV) && (i) >= 10) G_VRD(vp, (i) - 10); \
    if (((i) & 1) == 0) { if ((i) < 10) G_KWAIT(6, (i) >> 1); \
      else if ((i) == 10) { if (HASPV) G_KWAIT(6, 5); else G_KWAIT(4, 5); } \
      else if ((i) == 12) { if (HASPV) G_KWAIT(8, 6); else G_KWAIT(2, 6); } \
      else { if (HASPV) G_KWAIT(10, 7); else G_KWAIT(0, 7); } } \
    if (((i) & 1) == 0) S0 = __builtin_amdgcn_mfma_f32_32x32x16_bf16(kf[((i) >> 1) & 3][0], qr[(i) >> 1], (i) < 2 ? negm : S0, 0, 0, 0); \
    else S1 = __builtin_amdgcn_mfma_f32_32x32x16_bf16(kf[((i) >> 1) & 3][1], qr[(i) >> 1], (i) < 2 ? negm : S1, 0, 0, 0); \
    SBAR(); } while (0)
#define G_PV(j, vp) do { if ((j) + 6 < 16) G_VRD(vp, (j) + 6); \
    if ((j) < 10) G_VWAIT(12, j); else if ((j) == 10) G_VWAIT(10, 10); else if ((j) == 11) G_VWAIT(8, 11); else if ((j) == 12) G_VWAIT(6, 12); \
    else if ((j) == 13) G_VWAIT(4, 13); else if ((j) == 14) G_VWAIT(2, 14); else G_VWAIT(0, 15); \
    o[(j) & 3] = __builtin_amdgcn_mfma_f32_32x32x16_bf16(G_VF(j), G_PA(j), o[(j) & 3], 0, 0, 0); SBAR(); } while (0)
#define G_KPRE(kp) do { SBAR(); G_KRD(kp, 0); G_KRD(kp, 1); G_KRD(kp, 2); SBAR(); } while (0)
#define G_QK16(HASPV, kp, vp, tk, tv) do { \
    G_QK(0, HASPV, kp, vp, tk, tv); G_QK(1, HASPV, kp, vp, tk, tv); G_QK(2, HASPV, kp, vp, tk, tv); G_QK(3, HASPV, kp, vp, tk, tv); \
    G_QK(4, HASPV, kp, vp, tk, tv); G_QK(5, HASPV, kp, vp, tk, tv); G_QK(6, HASPV, kp, vp, tk, tv); G_QK(7, HASPV, kp, vp, tk, tv); \
    G_QK(8, HASPV, kp, vp, tk, tv); G_QK(9, HASPV, kp, vp, tk, tv); G_QK(10, HASPV, kp, vp, tk, tv); G_QK(11, HASPV, kp, vp, tk, tv); \
    G_QK(12, HASPV, kp, vp, tk, tv); G_QK(13, HASPV, kp, vp, tk, tv); G_QK(14, HASPV, kp, vp, tk, tv); G_QK(15, HASPV, kp, vp, tk, tv); } while (0)
#define G_PV16(vp) do { G_PV(0, vp); G_PV(1, vp); G_PV(2, vp); G_PV(3, vp); G_PV(4, vp); G_PV(5, vp); G_PV(6, vp); G_PV(7, vp); \
    G_PV(8, vp); G_PV(9, vp); G_PV(10, vp); G_PV(11, vp); G_PV(12, vp); G_PV(13, vp); G_PV(14, vp); G_PV(15, vp); } while (0)
#define G_SOFTMAX(FIRST) do { al = 1.f; \
    if (onl) { float pmax = S0[0]; for (int r = 1; r < 16; ++r) pmax = fmaxf(pmax, S0[r]); for (int r = 0; r < 16; ++r) pmax = fmaxf(pmax, S1[r]); \
      { auto rr = __builtin_amdgcn_permlane32_swap(__float_as_uint(pmax), __float_as_uint(pmax), false, false); pmax = fmaxf(__uint_as_float(rr[0]), __uint_as_float(rr[1])); } \
      if ((FIRST) || !__all(pmax <= THR2)) { const float dl = (FIRST) ? pmax : fmaxf(pmax, 0.f); mhat += dl; \
        for (int r = 0; r < 16; ++r) { S0[r] -= dl; S1[r] -= dl; } for (int r = 0; r < 16; ++r) negm[r] = -mhat; asm volatile("" : "+v"(negm)); \
        if (!(FIRST)) { al = __builtin_amdgcn_exp2f(-dl); for (int d = 0; d < 4; ++d) for (int r = 0; r < 16; ++r) o[d][r] *= al; } } } \
    for (int r = 0; r < 16; ++r) S0[r] = __builtin_amdgcn_exp2f(S0[r]); for (int r = 0; r < 16; ++r) S1[r] = __builtin_amdgcn_exp2f(S1[r]); \
    { float ps = 0.f; for (int r = 0; r < 16; ++r) ps += S0[r]; for (int r = 0; r < 16; ++r) ps += S1[r]; \
      auto rr = __builtin_amdgcn_permlane32_swap(__float_as_uint(ps), __float_as_uint(ps), false, false); l_reg = l_reg * al + (__uint_as_float(rr[0]) + __uint_as_float(rr[1])); } \
    pa0 = pack8(S0, 0); pa1 = pack8(S0, 8); pa2 = pack8(S1, 0); pa3 = pack8(S1, 8); } while (0)
  AWAIT_BAR(0);
  const bool grpB = wid >= 4;
  G_KPRE(kb_l);
  if (grpB) VBAR();
  { const lds_cp kp_ = kb_l, vp_ = vb_l + s0; __builtin_amdgcn_s_setprio(1);
    G_QK16(false, kp_, vp_, 2, 1);
    __builtin_amdgcn_s_setprio(0); AWAIT_BAR(0); ROT(); }
  DMA_K(3, 3 * ASLOT); DMA_V(1, s1);
  G_SOFTMAX(true); G_KPRE(kb_l + ASLOT); VBAR();
#pragma unroll 1
  for (int t = 1; t < NT; ++t) {
    { const int tk = t + 3 < NT ? t + 3 : NT - 1, tv = t + 1 < NT ? t + 1 : NT - 1;
      const lds_cp kp_ = kb_l + ((t & 3) << 14), vp_ = vb_l + s0; __builtin_amdgcn_s_setprio(1);
      G_QK16(true, kp_, vp_, tk, tv);
      G_PV16(vp_);
      __builtin_amdgcn_s_setprio(0); AWAIT_BAR(0); ROT(); }
    G_SOFTMAX(false);
    { const lds_cp kn_ = kb_l + (((t + 1) & 3) << 14); G_KPRE(kn_); }
    { const int tk = t + 3 < NT ? t + 3 : NT - 1, tv = t + 1 < NT ? t + 1 : NT - 1; SBAR();
      DMA_K(tk, ((t + 3) & 3) << 14); DMA_V(tv, s1); }
    VBAR();
  }
  { const lds_cp vp_ = vb_l + s0; __builtin_amdgcn_s_setprio(1);
    SBAR(); G_VRD(vp_, 0); G_VRD(vp_, 1); G_VRD(vp_, 2); G_VRD(vp_, 3); G_VRD(vp_, 4); G_VRD(vp_, 5); SBAR();
    G_PV16(vp_);
    __builtin_amdgcn_s_setprio(0); }
  if (!grpB) VBAR();
#undef G_KRD
#undef G_KWAIT
#undef G_VRD
#undef G_VWAIT
#undef G_VF
#undef G_PA
#undef G_QK
#undef G_PV
#undef G_QK16
#undef G_KPRE
#undef G_PV16
#undef G_SOFTMAX
  int lane2; asm volatile("v_mbcnt_lo_u32_b32 %0, -1, 0\n\tv_mbcnt_hi_u32_b32 %0, -1, %0" : "=v"(lane2));
  const int r32b = lane2 & 31, hib = lane2 >> 5;
  { const float rl = __builtin_amdgcn_rcpf(l_reg);
    bf16* Ow = Ob + (long)(wid * QBLK + r32b) * LDO + 4 * hib;
#pragma unroll
    for (int d0 = 0; d0 < 4; ++d0)
#pragma unroll
      for (int g = 0; g < 4; ++g) { const unsigned long long w = (unsigned long long)cvtpk(o[d0][4 * g] * rl, o[d0][4 * g + 1] * rl) | ((unsigned long long)cvtpk(o[d0][4 * g + 2] * rl, o[d0][4 * g + 3] * rl) << 32);
        *(unsigned long long*)(Ow + d0 * 32 + g * 8) = w; } }
  AWAIT_BAR(0);
#undef DMA_K
#undef DMA_V
#undef DMA_K1
#undef DMA_V1
#undef ROT
#undef VBAR
}
}

namespace ba {
using namespace da;
constexpr float C2 = SCALE * 1.4426950408889634f;
__device__ __forceinline__ void battn_wg_unit(const bf16* __restrict__ Q, const bf16* __restrict__ K, const bf16* __restrict__ V, bf16* __restrict__ OG, float* __restrict__ LSE,
                                              int q0, int seg_lo, int seg_hi, int h, char* lds, __attribute__((address_space(3))) unsigned char* ldsl, const int wave_s,
                                              const bool preloaded = false, const bool has_next = false, const bf16* __restrict__ Kn = nullptr, const bf16* __restrict__ Vn = nullptr, int q0n = 0, int seg_lon = 0, int seg_hin = 0, int hn = 0) {
  constexpr int LD = 1024;
  int lane; asm volatile("v_mbcnt_lo_u32_b32 %0, -1, 0\n\tv_mbcnt_hi_u32_b32 %0, -1, %0" : "=v"(lane));
  const int wid = wave_s, r32 = lane & 31, hi = lane >> 5;
  char* K_lds = lds; char* V_lds = lds + 3 * ASLOT;
  float* ws = (float*)(lds + 6 * ASLOT) + wid * 64; float* li_l = ws; float* al_l = ws + 32;
  float mhat = 0.f, l_reg = 0; f32x16 o[4] = {}; bf16x8 qr[8]; f32x16 negm = {}; asm volatile("" : "+v"(negm));
  const int kb0 = q0 - 64;
  int krow[2], kcol[2], vrow[2], vcol[2];
#pragma unroll
  for (int i = 0; i < 2; ++i) { const int p = 2 * wid + i;
    krow[i] = 4 * p + (lane >> 4); kcol[i] = ((lane & 15) ^ (krow[i] & 7)) * 8;
    const int sub = 2 * p + (lane >> 5), kk = ((sub >> 2) << 3) | ((lane & 31) >> 2); vrow[i] = (kk & ~0xC) | ((kk & 4) << 1) | ((kk & 8) >> 1); vcol[i] = ((sub & 3) << 5) | ((lane & 3) << 3); }
  const bf16* Kh = K + h * 128; const bf16* Vh = V + h * 128;
#define BDMA(t, sl) BDMAX(Kh, Vh, kb0, seg_lo, seg_hi, t, sl)
#define BDMAX(Kh_, Vh_, kb0_, slo_, shi_, t, sl) do { const int kb_ = (kb0_) + 64 * (t); _Pragma("unroll") for (int i_ = 0; i_ < 2; ++i_) { \
    int rk_ = kb_ + krow[i_]; rk_ = rk_ < (slo_) ? (slo_) : (rk_ >= (shi_) ? (shi_) - 1 : rk_); int rv_ = kb_ + vrow[i_]; rv_ = rv_ < (slo_) ? (slo_) : (rv_ >= (shi_) ? (shi_) - 1 : rv_); \
    __builtin_amdgcn_global_load_lds((const unsigned*)((Kh_) + (long)rk_ * LD + kcol[i_]), (__attribute__((address_space(3))) unsigned*)(ldsl + (sl) + (2 * wid + i_) * 1024), 16, 0, 0); \
    __builtin_amdgcn_global_load_lds((const unsigned*)((Vh_) + (long)rv_ * LD + vcol[i_]), (__attribute__((address_space(3))) unsigned*)(ldsl + 3 * ASLOT + (sl) + (2 * wid + i_) * 1024), 16, 0, 0); } } while (0)
  if (!preloaded) { BDMA(0, 0); BDMA(1, ASLOT); }
  const bf16* Khn = Kn + hn * 128; const bf16* Vhn = Vn + hn * 128; const int kb0n = q0n - 64;
  { const bf16* Qw = Q + (long)(q0 + wid * QBLK + r32) * LD + h * 128 + hi * 8;
#pragma unroll
    for (int d0 = 0; d0 < 8; ++d0) { const bf16x8 raw = ld8(Qw + d0 * 16); float x[8];
#pragma unroll
      for (int e = 0; e < 8; ++e) x[e] = __builtin_bit_cast(float, (unsigned)(unsigned short)raw[e] << 16) * CQ;
      u32x4 w = {cvtpk(x[0], x[1]), cvtpk(x[2], x[3]), cvtpk(x[4], x[5]), cvtpk(x[6], x[7])}; qr[d0] = *reinterpret_cast<bf16x8*>(&w); } }
  const int vb0 = (int)(uintptr_t)V_lds + v_rd_base(lane);
  const int qi = q0 + wid * QBLK + r32, t_lo = wid >> 1;
  int s0 = 2 * ASLOT, s1 = 0, s2 = ASLOT;
  bool started = false;
  AWAIT_BAR(0);
#pragma unroll 1
  for (int t = 0; t < 6; ++t) {
    if (t >= 4 && has_next) BDMAX(Khn, Vhn, kb0n, seg_lon, seg_hin, t - 4, s0);
    else { const int tn = t + 2 < 6 ? t + 2 : 5; BDMA(tn, s0); }
    const int kb = kb0 + 64 * t;
    const bool active = (t >= t_lo) && (t <= t_lo + 2) && (kb + 64 > seg_lo) && (kb < seg_hi);
    if (active) {
      f32x16 S0, S1; float al; bf16x8 pa0, pa1, pa2, pa3;
      qkt_n(S0, S1, (const bf16*)(K_lds + s1), qr, negm, r32, hi);
#pragma unroll
      for (int r = 0; r < 16; ++r) { const int ka = kb + crow(r, hi), kc = ka + 32;
        const bool oka = (ka - qi <= 64) & (qi - ka <= 64), okc = (kc - qi <= 64) & (qi - kc <= 64);
        S0[r] = oka ? S0[r] : -1e30f; S1[r] = okc ? S1[r] : -1e30f; }
      float pmax = S0[0];
#pragma unroll
      for (int r = 1; r < 16; ++r) pmax = fmaxf(pmax, S0[r]);
#pragma unroll
      for (int r = 0; r < 16; ++r) pmax = fmaxf(pmax, S1[r]);
      { auto rr = __builtin_amdgcn_permlane32_swap(__float_as_uint(pmax), __float_as_uint(pmax), false, false); pmax = fmaxf(__uint_as_float(rr[0]), __uint_as_float(rr[1])); }
      al = 1.f;
      if (!started || !__all(pmax <= THR2)) {
        const float dl = !started ? pmax : fmaxf(pmax, 0.f); mhat += dl;
#pragma unroll
        for (int r = 0; r < 16; ++r) { S0[r] -= dl; S1[r] -= dl; }
#pragma unroll
        for (int r = 0; r < 16; ++r) negm[r] = -mhat;
        asm volatile("" : "+v"(negm));
        if (started) al = __builtin_amdgcn_exp2f(-dl);
      }
      started = true;
      float ps = 0.f;
#pragma unroll
      for (int r = 0; r < 16; ++r) { S0[r] = __builtin_amdgcn_exp2f(S0[r]); S1[r] = __builtin_amdgcn_exp2f(S1[r]); ps += S0[r] + S1[r]; }
      { auto rr = __builtin_amdgcn_permlane32_swap(__float_as_uint(ps), __float_as_uint(ps), false, false); ps = __uint_as_float(rr[0]) + __uint_as_float(rr[1]); }
      l_reg = l_reg * al + ps;
      PK4(S0, 0, pa0); PK4(S0, 8, pa1); PK4(S1, 0, pa2); PK4(S1, 8, pa3);
      if (__any(al < 1.f)) { if (hi == 0) al_l[r32] = al; asm volatile("s_waitcnt lgkmcnt(0)" ::: "memory");
#pragma unroll
        for (int d = 0; d < 4; ++d)
#pragma unroll
          for (int r = 0; r < 16; ++r) o[d][r] *= al_l[crow(r, hi)]; }
      pv_d0(o, vb0 + s1, pa0, pa1, pa2, pa3);
    }
    AWAIT_BAR(4); { const int t_ = s0; s0 = s1; s1 = s2; s2 = t_; }
  }
  if (hi == 0) li_l[r32] = l_reg; asm volatile("s_waitcnt lgkmcnt(0)" ::: "memory");
  int lane2; asm volatile("v_mbcnt_lo_u32_b32 %0, -1, 0\n\tv_mbcnt_hi_u32_b32 %0, -1, %0" : "=v"(lane2));
  const int r32b = lane2 & 31, hib = lane2 >> 5;
  float rli[16];
#pragma unroll
  for (int r = 0; r < 16; ++r) rli[r] = __builtin_amdgcn_rcpf(li_l[crow(r, hib)]);
  bf16* Ow = OG + (long)(q0 + wid * QBLK) * LD + h * 128 + r32b;
#pragma unroll
  for (int r = 0; r < 16; ++r) { const int orow = crow(r, hib);
#pragma unroll
    for (int d0 = 0; d0 < 4; ++d0) Ow[(long)orow * LD + d0 * 32] = (bf16)(cvtpk(o[d0][r] * rli[r], 0.f) & 0xffffu); }
  if (hib == 0) LSE[(size_t)(q0 + wid * QBLK + r32b) * 8 + h] = (mhat + __builtin_amdgcn_logf(l_reg)) * 0.6931471805599453f;
  if (has_next) asm volatile("s_waitcnt lgkmcnt(0)\n\ts_barrier" ::: "memory"); else AWAIT_BAR(0);
#undef BDMA
#undef BDMAX
}
}
#define GAS __attribute__((address_space(1)))
#define LAS __attribute__((address_space(3)))
typedef unsigned short bf16;
typedef unsigned v4u __attribute__((ext_vector_type(4)));
typedef float f32x4 __attribute__((ext_vector_type(4)));
typedef short bf16x8 __attribute__((ext_vector_type(8)));
typedef GAS unsigned gu32;
typedef GAS unsigned long long gu64;
#define RLX_AGENT __ATOMIC_RELAXED, __HIP_MEMORY_SCOPE_AGENT
#define LDS_WAIT() asm volatile("s_waitcnt lgkmcnt(0)" ::: "memory")
#define VM_WAIT() asm volatile("s_waitcnt vmcnt(0)" ::: "memory")
__device__ __forceinline__ unsigned long long rt() { return __builtin_amdgcn_s_memrealtime(); }
__device__ __forceinline__ unsigned f2bf(float f) { unsigned u = __builtin_bit_cast(unsigned, f); return (u + 0x7fffu + ((u >> 16) & 1u)) >> 16; }
__device__ __forceinline__ unsigned pk2(float lo, float hi) { return f2bf(lo) | (f2bf(hi) << 16); }

#define XB_TMO      128
#define XB_XCNT(j)  (256  + 64 * (j))
#define XB_XSUB(j)  (1280 + 64 * (j))
#define XB_XGEN(j)  (2304 + 64 * (j))
#define XB_TOP      3328
#define XB_TOPGEN   3392
#define XCD_BAR_WORDS 3456
#define XB_SPIN_CAP (1u << 18)

__device__ __forceinline__ unsigned xb_ld(unsigned* p)              { return __hip_atomic_load(p, __ATOMIC_RELAXED, __HIP_MEMORY_SCOPE_AGENT); }
__device__ __forceinline__ unsigned xb_add(unsigned* p, unsigned v) { return __hip_atomic_fetch_add(p, v, __ATOMIC_RELAXED, __HIP_MEMORY_SCOPE_AGENT); }
__device__ __forceinline__ unsigned xb_xcc_id() { return (unsigned)__builtin_amdgcn_s_getreg((3 << 11) | 20) & 0xFu; }
#define XB_SPIN(cond, bar) do { unsigned _sp = 0; while (cond) { __builtin_amdgcn_s_sleep(1); \
    if ((++_sp & 255u) == 0u) { if (xb_ld(&(bar)[XB_TMO])) break; if (_sp > XB_SPIN_CAP) { atomicAdd(&(bar)[XB_TMO], 1u); break; } } } } while (0)

struct XcdBarrier {
    unsigned* bar; unsigned x;
    volatile LAS unsigned* st;
};

__device__ __forceinline__ XcdBarrier xcd_barrier_post(unsigned* bar, volatile LAS unsigned* st) {
    XcdBarrier b; b.bar = bar; b.x = xb_xcc_id(); b.st = st;
    if (threadIdx.x == 0) (void)xb_add(&bar[XB_XCNT(b.x)], 1u);
    return b;
}
__device__ __forceinline__ void xcd_barrier_complete(unsigned* bar, unsigned x, unsigned& nloc, unsigned& nx) {
    const unsigned G = gridDim.x * gridDim.y * gridDim.z;
    unsigned sum, cnt, mine, sp = 0u;
    for (;;) {
        sum = 0u; cnt = 0u; mine = 0u;
#pragma unroll
        for (unsigned j = 0; j < 16; ++j) { const unsigned c = xb_ld(&bar[XB_XCNT(j)]); sum += c; cnt += (c > 0u) ? 1u : 0u; mine = (j == x) ? c : mine; }
        if (sum == G) break;
        __builtin_amdgcn_s_sleep(1);
        if ((++sp & 255u) == 0u) { if (xb_ld(&bar[XB_TMO])) break; if (sp > XB_SPIN_CAP) { atomicAdd(&bar[XB_TMO], 1u); break; } }
    }
    nloc = mine > 0u ? mine : 1u; nx = cnt > 0u ? cnt : 1u;
}

__device__ __forceinline__ void xcd_barrier(const XcdBarrier& b) {
    asm volatile("s_waitcnt vmcnt(0)" ::: "memory");
    __syncthreads();
    if (threadIdx.x == 0) {
        unsigned* bar = b.bar;
        __builtin_amdgcn_s_waitcnt(0);
        unsigned nloc = b.st[0], nx = b.st[1];
        if (nloc == 0u) { xcd_barrier_complete(bar, b.x, nloc, nx); b.st[0] = nloc; b.st[1] = nx; }
        const unsigned old = xb_add(&bar[XB_XSUB(b.x)], 1u);
        const unsigned gen = old / nloc;
        if (old + 1u == (gen + 1u) * nloc) {
            __builtin_amdgcn_fence(__ATOMIC_RELEASE, "agent");
            asm volatile("s_waitcnt vmcnt(0)" ::: "memory");
            const unsigned og = xb_add(&bar[XB_TOP], 1u);
            const unsigned tg = og / nx;
            if (og + 1u == (tg + 1u) * nx) xb_add(&bar[XB_TOPGEN], 1u);
            else XB_SPIN(xb_ld(&bar[XB_TOPGEN]) == tg, bar);
            __builtin_amdgcn_fence(__ATOMIC_ACQUIRE, "agent");
            xb_add(&bar[XB_XGEN(b.x)], 1u);
            asm volatile("s_waitcnt vmcnt(0)" ::: "memory");
        } else {
            XB_SPIN(xb_ld(&bar[XB_XGEN(b.x)]) == gen, bar);
            __builtin_amdgcn_fence(__ATOMIC_ACQUIRE, "agent");
            asm volatile("s_waitcnt vmcnt(0)" ::: "memory");
        }
    }
    __syncthreads();
}

constexpr int DM = 2048, SEQ = 16384, NSEQ = 3, MTOK = NSEQ * SEQ, HD = 128, DFF = 8192, MEMR = 768, DEPTH = 4;
constexpr float EPS = 1e-6f;
constexpr int NWAVES = 8;
#ifndef GM_ALIGN
#define GM_ALIGN true
#endif
#ifndef GM_SP2
#define GM_SP2 true
#endif
constexpr int MLPC = 8192;
#ifndef PHMASK
#define PHMASK 0xFFFFFFu
#endif
#define PH(n) (((PHMASK) >> (n)) & 1u)
#ifndef WGM_QKVB
#define WGM_QKVB 8
#define WGM_QKVA 8
#endif
#ifndef EXPN
#define EXPN 0
#endif
#define REPS(k) for (int rep_ = 0; rep_ < (((EXPN) == (k) || ((EXPN) == 9 && ((k) == 2 || (k) == 3 || (k) == 7))) ? 2 : 1); ++rep_)
constexpr size_t MiB = 1u << 20;
constexpr size_t WS_CTL = 0, CTL_ZERO_BYTES = 8 * MiB;
constexpr size_t WS_SS = 1 * MiB;
constexpr size_t WS_COS1 = 8 * MiB, WS_SIN1 = 12 * MiB;
constexpr size_t WS_AXT = 16 * MiB;
constexpr size_t WS_MEMN = 17 * MiB;
constexpr size_t WS_CKVT = 29 * MiB;
constexpr size_t WS_CKV = 45 * MiB;
constexpr size_t WS_WQKV = 51 * MiB;
constexpr size_t WS_WO = 87 * MiB;
constexpr size_t WS_CWQ = 95 * MiB, WS_CWO = 97 * MiB;
constexpr size_t WS_WUP = 99 * MiB, WS_WDN = 131 * MiB;
constexpr size_t WS_HN = 163 * MiB;
constexpr size_t WS_QKV = 355 * MiB;
constexpr size_t WS_BIG = 643 * MiB;
constexpr size_t WS_END = 899 * MiB;
constexpr size_t BIG_OB = 0, BIG_OG = 96 * MiB, BIG_LSE = 192 * MiB;
constexpr int CW_BAR = 4096;
constexpr int RING_BYTES = 131072;
constexpr int LDSCTL_OFF = RING_BYTES, MISC_OFF = LDSCTL_OFF + 320;
constexpr int PTAB_OFF = RING_BYTES + 512;
constexpr int BSCR_OFF = RING_BYTES + 1024;
constexpr int LDS_BYTES = 147456;

__device__ __forceinline__ float shflx(float v, int mask, int lane) { return __builtin_bit_cast(float, __builtin_amdgcn_ds_bpermute((lane ^ mask) << 2, __builtin_bit_cast(int, v))); }
__device__ __forceinline__ float wave_sum(float v, int lane) {
#pragma unroll
    for (int o = 1; o < 64; o <<= 1) v += shflx(v, o, lane);
    return v;
}
__device__ __forceinline__ int pair_row(int L) { const int w = L & 255, d = w & 127; return (L & ~255) + (d >> 6) * 128 + (w >> 7) * 64 + (d & 63); }
typedef _Float16 half2k __attribute__((ext_vector_type(2)));
__device__ __forceinline__ unsigned pkh(float lo, float hi) { const half2k v = {(_Float16)lo, (_Float16)hi}; return __builtin_bit_cast(unsigned, v); }
__device__ __forceinline__ unsigned pkhb(float lo, float hi) { const unsigned t = pk2(lo, hi); return pkh(__builtin_bit_cast(float, t << 16), __builtin_bit_cast(float, t & 0xFFFF0000u)); }
__device__ __forceinline__ void transpose_item(const float* W, const float* gain, int K, int N, bf16* WT, LAS float* scr, int item, int lane, int nperm = 0, bool f16 = false) {
    const int nblk = N / 32, kb = item / nblk, nb = item % nblk, k0 = 64 * kb, n0 = 32 * nb;
    float wv[32];
#pragma unroll
    for (int i = 0; i < 32; ++i) { const int kk = 2 * i + (lane >> 5); wv[i] = W[(size_t)(k0 + kk) * N + n0 + (lane & 31)]; }
    if (gain) {
#pragma unroll
        for (int i = 0; i < 32; ++i) wv[i] *= gain[k0 + 2 * i + (lane >> 5)];
    }
#pragma unroll
    for (int i = 0; i < 32; ++i) { const int kk = 2 * i + (lane >> 5); scr[kk * 33 + (lane & 31)] = wv[i]; }
    LDS_WAIT(); asm volatile("" ::: "memory");
    const int c = lane & 7;
#pragma unroll
    for (int j = 0; j < 4; ++j) { const int n = (lane >> 3) + 8 * j; const LAS float* s = scr + (8 * c) * 33 + n;
        v4u o;
        if (f16) { o.x = pkhb(s[0 * 33], s[1 * 33]); o.y = pkhb(s[2 * 33], s[3 * 33]); o.z = pkhb(s[4 * 33], s[5 * 33]); o.w = pkhb(s[6 * 33], s[7 * 33]); }
        else { o.x = pk2(s[0 * 33], s[1 * 33]); o.y = pk2(s[2 * 33], s[3 * 33]); o.z = pk2(s[4 * 33], s[5 * 33]); o.w = pk2(s[6 * 33], s[7 * 33]); }
        const int nr = (n0 + n) < nperm ? pair_row(n0 + n) : (n0 + n);
        *(GAS v4u*)(WT + (size_t)nr * K + k0 + 8 * c) = o; }
    LDS_WAIT(); asm volatile("" ::: "memory");
}
__device__ __forceinline__ void transpose_all(const float* W, const float* gain, int K, int N, bf16* WT, LAS float* scr, int gw, int NGW, int lane, int nperm = 0, bool f16 = false) {
    const int nitems = (K / 64) * (N / 32);
    for (int it = gw; it < nitems; it += NGW) transpose_item(W, gain, K, N, WT, scr, it, lane, nperm, f16);
}
__device__ __forceinline__ void rms_row_bf16(const float* xrow, const float* gain, bf16* orow, float* copy, int lane) {
    const GAS f32x4* xr = (const GAS f32x4*)xrow + lane; const GAS f32x4* gr = (const GAS f32x4*)gain + lane;
    f32x4 v[8]; float s = 0.f;
#pragma unroll
    for (int j = 0; j < 8; ++j) { v[j] = xr[64 * j]; s += (v[j].x * v[j].x + v[j].y * v[j].y) + (v[j].z * v[j].z + v[j].w * v[j].w); }
    const float rstd = 1.0f / sqrtf(wave_sum(s, lane) * (1.f / DM) + EPS);
    if (copy) { GAS f32x4* c4 = (GAS f32x4*)copy + lane;
#pragma unroll
        for (int j = 0; j < 8; ++j) c4[64 * j] = v[j]; }
    GAS unsigned long long* o8 = (GAS unsigned long long*)orow + lane;
#pragma unroll
    for (int j = 0; j < 8; ++j) { const f32x4 g = gr[64 * j];
        o8[64 * j] = (unsigned long long)pk2(v[j].x * rstd * g.x, v[j].y * rstd * g.y) | ((unsigned long long)pk2(v[j].z * rstd * g.z, v[j].w * rstd * g.w) << 32); }
}
__device__ __forceinline__ void prep_row(const float* xrow, bf16* brow, unsigned long long* ss, int lane) {
    const GAS f32x4* xr = (const GAS f32x4*)xrow + lane; GAS unsigned long long* o8 = (GAS unsigned long long*)brow + lane;
    f32x4 v[8]; float s = 0.f;
#pragma unroll
    for (int j = 0; j < 8; ++j) { v[j] = xr[64 * j]; s += (v[j].x * v[j].x + v[j].y * v[j].y) + (v[j].z * v[j].z + v[j].w * v[j].w); }
    s = wave_sum(s, lane);
#pragma unroll
    for (int j = 0; j < 8; ++j) o8[64 * j] = (unsigned long long)pkh(v[j].x, v[j].y) | ((unsigned long long)pkh(v[j].z, v[j].w) << 32);
    if (lane == 0) *ss = (unsigned long long)(s * 1048576.f + 0.5f);
}
__device__ __forceinline__ void final_row(const bf16* brow, float* orow, const float* gain, const unsigned long long* ss, int lane) {
    const GAS unsigned long long* b8 = (const GAS unsigned long long*)brow + lane; GAS f32x4* xr = (GAS f32x4*)orow + lane; const GAS f32x4* gr = (const GAS f32x4*)gain + lane;
    const float rstd = 1.0f / sqrtf((float)*ss * (1.0f / (1048576.f * 2048.f)) + EPS);
#pragma unroll
    for (int j = 0; j < 8; ++j) { const f32x4 g = gr[64 * j]; const unsigned long long w = b8[64 * j];
        const half2k lo = __builtin_bit_cast(half2k, (unsigned)w), hi = __builtin_bit_cast(half2k, (unsigned)(w >> 32));
        f32x4 v; v.x = (float)lo[0]; v.y = (float)lo[1]; v.z = (float)hi[0]; v.w = (float)hi[1];
        xr[64 * j] = v * rstd * g; }
}
__device__ __forceinline__ float bf2f(unsigned short b) { return __builtin_bit_cast(float, (unsigned)b << 16); }
typedef unsigned short us8 __attribute__((ext_vector_type(8)));

typedef const __attribute__((address_space(4))) unsigned long long* kargp_t;
#define P_IN(i) ((const float*)(const GAS float*)kp[(i)])
#define PHASE_PTRS kargp_t kp = (kargp_t)__builtin_amdgcn_kernarg_segment_ptr(); asm volatile("" : "+s"(kp)); unsigned char* ws = (unsigned char*)(GAS unsigned char*)kp[21]; \
    const float* x_prompt = P_IN(0); const float* x_sample = P_IN(1); const float* mem_prompt = P_IN(2); const float* mem_sample = P_IN(3); \
    const float* norm_mix = P_IN(4); const float* a_wqkv = P_IN(5); const float* a_q_gain = P_IN(6); const float* a_k_gain = P_IN(7); const float* a_wo = P_IN(8); \
    const float* b_wqkv = P_IN(9); const float* b_wo = P_IN(10); const float* norm_cross = P_IN(11); const float* norm_mem = P_IN(12); \
    const float* c_wq = P_IN(13); const float* c_wkv = P_IN(14); const float* c_wo = P_IN(15); const float* norm_mlp = P_IN(16); \
    const float* w_up = P_IN(17); const float* w_down = P_IN(18); const float* final_norm = P_IN(19); \
    float* X = (float*)(GAS float*)kp[20]; \
    unsigned long long* SS = (unsigned long long*)(ws + WS_SS); float* COS1 = (float*)(ws + WS_COS1); float* SIN1 = (float*)(ws + WS_SIN1); float* AXT = (float*)(ws + WS_AXT); \
    bf16* MEMN = (bf16*)(ws + WS_MEMN); bf16* CKVT = (bf16*)(ws + WS_CKVT); bf16* CKV = (bf16*)(ws + WS_CKV); \
    bf16* WQKV = (bf16*)(ws + WS_WQKV); bf16* WO = (bf16*)(ws + WS_WO); bf16* CWQ = (bf16*)(ws + WS_CWQ); bf16* CWO = (bf16*)(ws + WS_CWO); \
    bf16* WUP = (bf16*)(ws + WS_WUP); bf16* WDN = (bf16*)(ws + WS_WDN); bf16* HN = (bf16*)(ws + WS_HN); \
    bf16* QKV = (bf16*)(ws + WS_QKV); bf16* HB = (bf16*)(ws + WS_BIG); \
    bf16* OB = (bf16*)(ws + WS_BIG + BIG_OB); bf16* OG = (bf16*)(ws + WS_BIG + BIG_OG); float* LSE = (float*)(ws + WS_BIG + BIG_LSE); \
    bf16* QA = QKV; bf16* KA = QKV + (size_t)MTOK * 2048; bf16* VA = KA + (size_t)MTOK * 512;
struct Args { const float* in[20]; float* out; unsigned char* ws; };
__global__ void __launch_bounds__(NWAVES * 64, 2) fwd_kernel(Args args) {
    extern __shared__ __attribute__((aligned(16))) unsigned char lds[];
    LAS unsigned char* ldsl = (LAS unsigned char*)lds;
    volatile LAS unsigned* MISC = (volatile LAS unsigned*)(ldsl + MISC_OFF);
    const int wave = __builtin_amdgcn_readfirstlane(threadIdx.x >> 6);
#define OPQ_LANE int lane, G = G_k, bx = bx_k; asm volatile("v_mbcnt_lo_u32_b32 %0, -1, 0\n\tv_mbcnt_hi_u32_b32 %0, -1, %0" : "=v"(lane)); asm volatile("" : "+s"(G), "+s"(bx)); const int tid = wave * 64 + lane; const int gw = bx * NWAVES + wave, NGW = G * NWAVES; LAS float* tscr = (LAS float*)(ldsl + wave * 16384)
    const int G_k = gridDim.x, bx_k = blockIdx.x;
    for (int u = threadIdx.x; u < (LDS_BYTES - LDSCTL_OFF) / 4; u += NWAVES * 64) ((LAS unsigned*)(ldsl + LDSCTL_OFF))[u] = 0u;
    __syncthreads();
    XcdBarrier bar = xcd_barrier_post((unsigned*)(args.ws + WS_CTL) + CW_BAR, MISC + 8);
#define GRID_BAR() do { XcdBarrier b2_ = bar; unsigned long long bp_ = (unsigned long long)bar.bar; asm volatile("" : "+s"(bp_), "+s"(b2_.x)); b2_.bar = (unsigned*)(GAS unsigned*)bp_; xcd_barrier(b2_); } while (0)


    if constexpr (PH(0))
    { OPQ_LANE; PHASE_PTRS;
        for (int e = bx * 512 + tid; e < SEQ * 64; e += G * 512) {
            const int t = e >> 6, i = e & 63;
            const double inv = exp2(-(double)i * (13.287712379549449 / 64.0));
            const double a = (double)t * inv, rev = a * 0.15915494309189535; const float fr = (float)(rev - floor(rev));
            COS1[e] = __builtin_amdgcn_cosf(fr); SIN1[e] = __builtin_amdgcn_sinf(fr);
        }
        for (int e = bx * 512 + tid; e < 320 * 32; e += G * 512) {
            const int p = e >> 5, i = e & 31; const int pos = p < 256 ? p : p - 256;
            const double inv = exp2(-(double)i * (13.287712379549449 / 32.0));
            const double a = (double)pos * inv, rev = a * 0.15915494309189535; const float fr = (float)(rev - floor(rev));
            const float c = __builtin_amdgcn_cosf(fr), s = __builtin_amdgcn_sinf(fr);
            if (p < 256) { AXT[p * 32 + i] = c; AXT[8192 + p * 32 + i] = s; } else { AXT[16384 + pos * 32 + i] = c; AXT[16384 + 2048 + pos * 32 + i] = s; }
        }
        for (int r = gw; r < DEPTH * MEMR; r += NGW) { const int l = r / MEMR, m = r % MEMR;
            const float* src = m < 256 ? mem_prompt + (size_t)m * DM : mem_sample + (size_t)(m - 256) * DM;
            rms_row_bf16(src, norm_mem + l * DM, MEMN + (size_t)r * DM, nullptr, lane); }
        for (int l = 0; l < DEPTH; ++l) transpose_all(c_wkv + (size_t)l * DM * 1024, nullptr, DM, 1024, CKVT + (size_t)l * 1024 * DM, tscr, gw, NGW, lane);
    }

    for (int layer = 0; layer < DEPTH; ++layer) {
        const int j = layer >> 1; const bool isA = (layer & 1) == 0;
        if constexpr (PH(1))
        { OPQ_LANE; PHASE_PTRS;
            REPS(3) {
            const float* gmix = norm_mix + layer * DM;
            if (isA) { transpose_all(a_wqkv + (size_t)j * DM * 3072, gmix, DM, 3072, WQKV, tscr, gw, NGW, lane, 0, true); transpose_all(a_wo + (size_t)j * DM * DM, nullptr, DM, DM, WO, tscr, gw, NGW, lane); }
            else { transpose_all(b_wqkv + (size_t)j * DM * 9216, gmix, DM, 9216, WQKV, tscr, gw, NGW, lane, 6144, true); transpose_all(b_wo + (size_t)j * 1024 * DM, nullptr, 1024, DM, WO, tscr, gw, NGW, lane); }
            transpose_all(c_wq + (size_t)layer * DM * 512, norm_cross + layer * DM, DM, 512, CWQ, tscr, gw, NGW, lane, 0, true);
            transpose_all(c_wo + (size_t)layer * 512 * DM, nullptr, 512, DM, CWO, tscr, gw, NGW, lane);
            transpose_all(w_up + (size_t)layer * DM * DFF, norm_mlp + layer * DM, DM, DFF, WUP, tscr, gw, NGW, lane, 0, true);
            transpose_all(w_down + (size_t)layer * DFF * DM, nullptr, DFF, DM, WDN, tscr, gw, NGW, lane);
            if (layer == 0) {
                for (int m = gw; m < MTOK; m += NGW) { const float* src = m < SEQ ? x_prompt + (size_t)m * DM : x_sample + (size_t)(m - SEQ) * DM;
                    prep_row(src, HN + (size_t)m * DM, SS + m, lane); }
            }
            GRID_BAR(); }
        }
        if (isA) {
            if constexpr (PH(3))
            { OPQ_LANE; PHASE_PTRS; pg8::Gemm g{HN, WQKV, MTOK, 3072, DM}; pg8::RepOrder S; S.init(MTOK, 3072, G, bx, WGM_QKVA); S.reps = (EXPN == 11) ? 2 : 1;
              pg8::EpiB<1> E{QA, 2048, 1, KA, VA, SS + (size_t)(3 * layer) * MTOK, nullptr, nullptr};
              pg8::gemm_phase<pg8::EpiB<1>, pg8::RepOrder, GM_ALIGN, GM_SP2, true>(ldsl, g, S, E, tid); GRID_BAR(); }
            if constexpr (PH(4))
            { OPQ_LANE; PHASE_PTRS;
                const float* qg = a_q_gain + j * HD; const float* kg = a_k_gain + j * HD;
                const int jl = lane & 15, sub = lane >> 4;
                const long nq = (long)MTOK * 16, nk = (long)MTOK * 4;
                for (long hr4 = nq / 4 + gw; hr4 < (nq + nk) / 4; hr4 += NGW) {
                    long hr = hr4 * 4 + sub; const bool isq = hr < nq; bf16* p; int tok; const float* gp;
                    if (isq) { p = QA + hr * 128; tok = (int)(hr >> 4); gp = qg; } else { hr -= nq; p = KA + hr * 128; tok = (int)(hr >> 2); gp = kg; }
                    const int t = tok & (SEQ - 1), prow = t >> 6, pcol = t & 63;
                    const us8 raw = *(const GAS us8*)(p + jl * 8);
                    float v[8]; float ss = 0.f;
#pragma unroll
                    for (int e = 0; e < 8; ++e) { v[e] = bf2f(raw[e]); ss += v[e] * v[e]; }
                    ss += shflx(ss, 1, lane); ss += shflx(ss, 2, lane); ss += shflx(ss, 4, lane); ss += shflx(ss, 8, lane);
                    const float rstd = 1.0f / sqrtf(ss * (1.f / 128.f) + EPS);
                    const float* ct = (jl < 8) ? AXT + prow * 32 + (jl & 3) * 8 : AXT + 16384 + pcol * 32 + (jl & 3) * 8;
                    const float* st = ct + ((jl < 8) ? 8192 : 2048);
                    const f32x4 g0 = *(const GAS f32x4*)(gp + jl * 8), g1 = *(const GAS f32x4*)(gp + jl * 8 + 4);
                    const f32x4 c0 = *(const GAS f32x4*)ct, c1 = *(const GAS f32x4*)(ct + 4), s0 = *(const GAS f32x4*)st, s1 = *(const GAS f32x4*)(st + 4);
                    const float sgn = (jl & 4) ? 1.f : -1.f;
                    float o[8];
#pragma unroll
                    for (int e = 0; e < 8; ++e) { const float y = v[e] * rstd * (e < 4 ? g0[e] : g1[e - 4]); const float pr = shflx(y, 4, lane);
                        const float c = e < 4 ? c0[e] : c1[e - 4], s = e < 4 ? s0[e] : s1[e - 4]; o[e] = y * c + sgn * pr * s; }
                    v4u w; w.x = pk2(o[0], o[1]); w.y = pk2(o[2], o[3]); w.z = pk2(o[4], o[5]); w.w = pk2(o[6], o[7]);
                    *(GAS v4u*)(p + jl * 8) = w;
                }
                GRID_BAR();
            }
            if constexpr (PH(5))
            { OPQ_LANE; PHASE_PTRS;
                float gqm = 0.f, gkm = 0.f;
                for (int d = 0; d < HD; ++d) { gqm = fmaxf(gqm, fabsf(a_q_gain[j * HD + d])); gkm = fmaxf(gkm, fabsf(a_k_gain[j * HD + d])); }
                const float bnd = gqm * gkm * (128.f * da::CQ * 1.02f) + 0.5f;
                REPS(1) {
                for (int u = bx; u < NSEQ * 16 * 64; u += G) {
                    const int qb = u & 63, hg = (u >> 6) & 3, kvh = (u >> 8) & 3, b = u >> 10, h = kvh * 4 + hg;
                    const size_t qoff = ((size_t)b * SEQ + (size_t)qb * 256) * 2048 + h * 128;
                    const bf16* Kh = KA + (size_t)b * SEQ * 512 + kvh * 128; const bf16* Vh = VA + (size_t)b * SEQ * 512 + kvh * 128;
                    da::attn_dense_stg<2048, 512, 2048>(QA + qoff, Kh, Vh, HB + qoff, SEQ, (char*)lds, ldsl, wave, a_q_gain + j * HD, AXT, qb * 256, bnd);
                }
                GRID_BAR(); }
            }
            if constexpr (PH(6))
            { OPQ_LANE; PHASE_PTRS; pg8::Gemm g{HB, WO, MTOK, DM, DM}; pg8::StaticOrder S; S.init(MTOK, DM, G, bx);
              pg8::EpiRes E{HN, SS + (size_t)(3 * layer + 1) * MTOK, DM, 0};
              pg8::gemm_phase<pg8::EpiRes, pg8::StaticOrder, GM_ALIGN, GM_SP2>(ldsl, g, S, E, tid); GRID_BAR(); }
        } else {
            for (int sq = 0; sq <= NSEQ; ++sq) {
                if constexpr (PH(7)) if (sq < NSEQ)
                { OPQ_LANE; PHASE_PTRS; pg8::Gemm g{HN + (size_t)sq * SEQ * DM, WQKV, SEQ, 9216, DM}; pg8::RepOrder S; S.init(SEQ, 9216, G, bx, WGM_QKVB); S.reps = (EXPN == 10) ? 2 : 1;
                  pg8::EpiB<2> E{QKV, 1024, 1, nullptr, nullptr, SS + (size_t)(3 * layer) * MTOK + (size_t)sq * SEQ, COS1, SIN1};
                  pg8::gemm_phase<pg8::EpiB<2>, pg8::RepOrder, GM_ALIGN, GM_SP2, true>(ldsl, g, S, E, tid); }
                if constexpr (PH(10)) if (sq > 0)
                { OPQ_LANE; PHASE_PTRS;
                    const int jl = lane & 15, sub = lane >> 4;
                    REPS(7) {
                    for (int r4 = gw; r4 < SEQ * 8 / 4; r4 += NGW) {
                        const int rr = r4 * 4 + sub, t = rr >> 3, h = rr & 7;
                        float ls[3]; us8 ov[3];
#pragma unroll
                        for (int g = 0; g < 3; ++g) { const int shift = 2 * g; const int pp = ((t & ((1 << shift) - 1)) << (14 - shift)) + (t >> shift);
                            ls[g] = LSE[(size_t)g * SEQ * 8 + (size_t)pp * 8 + h]; ov[g] = *(const GAS us8*)(OG + (size_t)g * SEQ * 1024 + (size_t)pp * 1024 + h * 128 + jl * 8); }
                        const float mx = fmaxf(ls[0], fmaxf(ls[1], ls[2]));
                        float w0 = __expf(ls[0] - mx), w1 = __expf(ls[1] - mx), w2 = __expf(ls[2] - mx); const float inv = 1.f / (w0 + w1 + w2); w0 *= inv; w1 *= inv; w2 *= inv;
                        float o[8];
#pragma unroll
                        for (int e = 0; e < 8; ++e) o[e] = w0 * bf2f(ov[0][e]) + w1 * bf2f(ov[1][e]) + w2 * bf2f(ov[2][e]);
                        v4u w; w.x = pk2(o[0], o[1]); w.y = pk2(o[2], o[3]); w.z = pk2(o[4], o[5]); w.w = pk2(o[6], o[7]);
                        *(GAS v4u*)(OB + ((size_t)(sq - 1) * SEQ + t) * 1024 + h * 128 + jl * 8) = w;
                    }
                    }
                }
                { OPQ_LANE; GRID_BAR(); }
                if constexpr (PH(9)) if (sq < NSEQ)
                { OPQ_LANE; PHASE_PTRS;
                    REPS(4) {
                    for (int u = bx; u < 3 * 8 * (SEQ / 256); u += G) {
                        const int blkq = u & 63, gh = u >> 6, g = gh >> 3, h = gh & 7, q0 = blkq * 256;
                        const int seglen = SEQ >> (2 * g), seg_lo = q0 & ~(seglen - 1), seg_hi = seg_lo + seglen;
                        const size_t blk = (size_t)SEQ * 1024;
                        const int u2 = u + G; const bool hasn = u2 < 3 * 8 * (SEQ / 256);
                        const int blkq2 = u2 & 63, gh2 = u2 >> 6, g2 = hasn ? (gh2 >> 3) : g, h2 = gh2 & 7, q02 = blkq2 * 256;
                        const int seglen2 = SEQ >> (2 * g2), seg_lo2 = q02 & ~(seglen2 - 1), seg_hi2 = seg_lo2 + seglen2;
                        ba::battn_wg_unit(QKV + (size_t)g * blk, QKV + (size_t)(3 + g) * blk, QKV + (size_t)(6 + g) * blk, OG + (size_t)g * blk, LSE + (size_t)g * SEQ * 8,
                                          q0, seg_lo, seg_hi, h, (char*)lds, ldsl, wave, u != bx, hasn, QKV + (size_t)(3 + g2) * blk, QKV + (size_t)(6 + g2) * blk, q02, seg_lo2, seg_hi2, h2);
                    }
                    GRID_BAR(); }
                }
            }
            if constexpr (PH(11))
            { OPQ_LANE; PHASE_PTRS; pg8::Gemm g{OB, WO, MTOK, DM, 1024}; pg8::StaticOrder S; S.init(MTOK, DM, G, bx);
              pg8::EpiRes E{HN, SS + (size_t)(3 * layer + 1) * MTOK, DM, 0};
              pg8::gemm_phase<pg8::EpiRes, pg8::StaticOrder, GM_ALIGN, GM_SP2>(ldsl, g, S, E, tid); GRID_BAR(); }
        }
        if constexpr (PH(13))
        { OPQ_LANE; PHASE_PTRS; pg8::Gemm g{HN, CWQ, MTOK, 512, DM}; pg8::StaticOrder S; S.init(MTOK, 512, G, bx);
          pg8::EpiB<0> E{QKV, 512, 1 << 20, nullptr, nullptr, SS + (size_t)(3 * layer + 1) * MTOK, nullptr, nullptr};
          pg8::gemm_phase<pg8::EpiB<0>, pg8::StaticOrder, GM_ALIGN, GM_SP2, true>(ldsl, g, S, E, tid);
          if (PH(2) && layer == 0 && bx >= 128) {
            pg8::Gemm g2{MEMN, CKVT, DEPTH * MEMR, DEPTH * 1024, DM}; pg8::GroupedOrder S2; S2.init(128, bx - 128);
            pg8::EpiB<0> E2{CKV, 1024, 4, nullptr, nullptr, nullptr, nullptr, nullptr};
            pg8::gemm_phase<pg8::EpiB<0>, pg8::GroupedOrder, GM_ALIGN, GM_SP2>(ldsl, g2, S2, E2, tid); }
          GRID_BAR(); }
        if constexpr (PH(14))
        { OPQ_LANE; PHASE_PTRS;
            const bf16* ckv = CKV + (size_t)layer * MEMR * 1024;
            REPS(2) {
            for (int u = bx; u < NSEQ * 4 * 64; u += G) {
                const int qb = u & 63, h = (u >> 6) & 3, b = u >> 8;
                const size_t qoff = ((size_t)b * SEQ + (size_t)qb * 256) * 512 + h * 128;
                const bf16* Kh = ckv + (size_t)b * 256 * 1024 + h * 128; const bf16* Vh = Kh + 512;
                da::attn_dense_body<512, 1024, 512, false>(QKV + qoff, Kh, Vh, HB + qoff, 256, (char*)lds, ldsl, wave);
            }
            GRID_BAR(); }
        }
        if constexpr (PH(15))
        { OPQ_LANE; PHASE_PTRS; pg8::Gemm g{HB, CWO, MTOK, DM, 512}; pg8::StaticOrder S; S.init(MTOK, DM, G, bx);
          pg8::EpiRes E{HN, SS + (size_t)(3 * layer + 2) * MTOK, DM, 0};
          pg8::gemm_phase<pg8::EpiRes, pg8::StaticOrder, GM_ALIGN, GM_SP2>(ldsl, g, S, E, tid); GRID_BAR(); }
        for (int ch = 0; ch <= MTOK / MLPC; ++ch) {
            if constexpr (PH(18)) if (ch > 0)
            { OPQ_LANE; PHASE_PTRS; const int c = ch - 1; pg8::Gemm g{HB + (size_t)(c & 1) * MLPC * DFF, WDN, MLPC, DM, DFF}; pg8::StaticOrder S; S.init(MLPC, DM, G, bx);
              if (EXPN == 6) {
                  pg8::EpiRes E2{(bf16*)(ws + WS_END + 64 * MiB), (unsigned long long*)(ws + WS_END + 96 * MiB), DM, 0};
                  pg8::gemm_phase<pg8::EpiRes, pg8::StaticOrder, GM_ALIGN, GM_SP2>(ldsl, g, S, E2, tid); }
              pg8::EpiRes E{HN, SS + (size_t)(3 * layer + 3) * MTOK, DM, c * MLPC};
              pg8::gemm_phase<pg8::EpiRes, pg8::StaticOrder, GM_ALIGN, GM_SP2>(ldsl, g, S, E, tid); }
            if constexpr (PH(17)) if (ch < MTOK / MLPC)
            { OPQ_LANE; PHASE_PTRS; pg8::Gemm g{HN + (size_t)ch * MLPC * DM, WUP, MLPC, DFF, DM}; pg8::RepOrder S; S.init(MLPC, DFF, G, bx); S.reps = (EXPN == 5) ? 2 : 1;
              pg8::EpiB<3> E{HB + (size_t)(ch & 1) * MLPC * DFF, DFF, 1 << 20, nullptr, nullptr, SS + (size_t)(3 * layer + 2) * MTOK + (size_t)ch * MLPC, nullptr, nullptr};
              pg8::gemm_phase<pg8::EpiB<3>, pg8::RepOrder, GM_ALIGN, GM_SP2, true>(ldsl, g, S, E, tid); }
            GRID_BAR();
        }
    }
    if constexpr (PH(19)) { OPQ_LANE; PHASE_PTRS;
    for (int m = gw; m < MTOK; m += NGW) final_row(HN + (size_t)m * DM, X + (size_t)m * DM, final_norm, SS + (size_t)12 * MTOK + m, lane); }
}

extern "C" void kernel_launch(void* const* d_in, const int* in_sizes, int n_in, void* d_out, int out_size, void* d_ws, size_t ws_size, hipStream_t stream) {
    static int grid = 0;
    if (grid == 0) {
        if (n_in != 20 || out_size != MTOK * DM || ws_size < WS_END) { fprintf(stderr, "kernel_launch: unexpected shapes: n_in %d out %d ws %zu (need %zu)\n", n_in, out_size, ws_size, (size_t)WS_END); grid = -1; return; }
        int dev = 0, cus = 0, per_cu = 0;
        if (hipGetDevice(&dev) != hipSuccess || hipDeviceGetAttribute(&cus, hipDeviceAttributeMultiprocessorCount, dev) != hipSuccess) { grid = -1; return; }
        if (hipFuncSetAttribute((const void*)fwd_kernel, hipFuncAttributeMaxDynamicSharedMemorySize, LDS_BYTES) != hipSuccess) { fprintf(stderr, "kernel_launch: hipFuncSetAttribute failed\n"); grid = -1; return; }
        if (hipOccupancyMaxActiveBlocksPerMultiprocessor(&per_cu, (const void*)fwd_kernel, NWAVES * 64, LDS_BYTES) != hipSuccess || per_cu < 1)
            fprintf(stderr, "kernel_launch: note: occupancy query reports %d workgroups per CU\n", per_cu);
        (void)hipGetLastError();
        grid = cus;
    }
    if (grid < 0) return;
    if (hipMemsetAsync((char*)d_ws + WS_CTL, 0, CTL_ZERO_BYTES, stream) != hipSuccess) { fprintf(stderr, "kernel_launch: memset failed\n"); return; }
    Args a{};
    for (int i = 0; i < 20; ++i) a.in[i] = (const float*)d_in[i];
    a.out = (float*)d_out; a.ws = (unsigned char*)d_ws;
    hipLaunchKernelGGL(fwd_kernel, dim3(grid), dim3(NWAVES * 64), LDS_BYTES, stream, a);
    const hipError_t le = hipPeekAtLastError();
    if (le != hipSuccess) fprintf(stderr, "kernel_launch: launch failed: %s\n", hipGetErrorName(le));
}
```
